# Optimizing an MI355X kernel written in HIP

```python
import jax
import jax.numpy as jnp
from jax import lax
import numpy as np

D_MODEL = 1024
BATCH = 8
SEQ = 4096
DEPTH = 2

GRID_W = 64
CTX_LEN = 256
NORM_EPS = 1e-6
ROPE_THETA = 10000.0
Q_BLOCK = 128

GDN_HEADS = 8
GDN_DK = 64
GDN_DV = 64
GDN_CONV = 5
GDN_CHUNK = 64
GDN_QK_W = GDN_HEADS * GDN_DK
GDN_V_W = GDN_HEADS * GDN_DV

MLA_HEADS = 8
MLA_NOPE = 64
MLA_ROPE = 32
MLA_V = 64
MLA_Q_LORA = 256
MLA_KV_LORA = 128

NA_HEADS = 8
NA_DIM = 64
NA_WIN_H = 8
NA_WIN_W = 16
NA_W = NA_HEADS * NA_DIM

GQA_HEADS = 8
GQA_KV_HEADS = 2
GQA_DIM = 64

D_FF = -(-(8 * D_MODEL) // (3 * 256)) * 256

EVEN_SPLITS = (2 * GDN_QK_W + GDN_V_W, GDN_V_W, 2 * GDN_HEADS, 2 * GDN_HEADS, MLA_Q_LORA, MLA_KV_LORA, MLA_ROPE)
ODD_SPLITS = (NA_W, NA_W, NA_W, GQA_HEADS * GQA_DIM, GQA_KV_HEADS * GQA_DIM, GQA_KV_HEADS * GQA_DIM)
IN_EVEN = sum(EVEN_SPLITS)
IN_ODD = sum(ODD_SPLITS)
MIX_EVEN = GDN_V_W + MLA_HEADS * MLA_V
MIX_ODD = NA_W + GQA_HEADS * GQA_DIM
N_EVEN = (DEPTH + 1) // 2
N_ODD = DEPTH // 2

kernel_name = 'hybrid_gdn_mla_natten_gqa_prefix_dit'


def split_cols(z, sizes):
    offs = [int(o) for o in np.cumsum(sizes)[:-1]]
    return jnp.split(z, offs, axis=-1)


def to_heads(t, n):
    return t.reshape(t.shape[0], t.shape[1], n, -1)


def rms_norm(x, g):
    xf = x.astype(jnp.float32)
    y = xf * lax.rsqrt(jnp.mean(xf * xf, -1, keepdims=True) + NORM_EPS)
    return (y * g.astype(jnp.float32)).astype(x.dtype)


def l2_normalize(x):
    xf = x.astype(jnp.float32)
    return (xf * lax.rsqrt(jnp.sum(xf * xf, -1, keepdims=True) + NORM_EPS)).astype(x.dtype)


def modulate(h, shift, scale):
    return h * (1.0 + scale) + shift


def swiglu(u, w_gate, w_up, w_down):
    return (jax.nn.silu(u @ w_gate) * (u @ w_up)) @ w_down


def axial_rope(n_tokens, rot_dim):
    t = jnp.arange(n_tokens, dtype=jnp.int32)
    row = (t // GRID_W).astype(jnp.float32)
    col = (t % GRID_W).astype(jnp.float32)
    n_freq = rot_dim // 4
    inv_freq = ROPE_THETA ** (-jnp.arange(n_freq, dtype=jnp.float32) / n_freq)
    ang = jnp.concatenate([row[:, None] * inv_freq, col[:, None] * inv_freq], -1)
    return jnp.cos(ang), jnp.sin(ang)


def apply_rope(x, cos, sin):
    half = x.shape[-1] // 2
    x1, x2 = x[..., :half], x[..., half:]
    cs, sn = cos[None, :, None, :], sin[None, :, None, :]
    return jnp.concatenate([x1 * cs - x2 * sn, x2 * cs + x1 * sn], -1).astype(x.dtype)


def short_conv(x, w):
    n_tap = w.shape[0]
    pad = n_tap // 2
    t_len = x.shape[1]
    xp = jnp.pad(x, ((0, 0), (pad, pad), (0, 0)))
    out = xp[:, 0:t_len] * w[0]
    for j in range(1, n_tap):
        out = out + xp[:, j:j + t_len] * w[j]
    return out


def blocked_attention(q, k, v, scale):
    b, tq, h, d = q.shape
    hk = k.shape[2]
    grp = h // hk
    nb = tq // Q_BLOCK
    qb = q.reshape(b, nb, Q_BLOCK, hk, grp, d).transpose(1, 0, 2, 3, 4, 5)

    def one_block(q_i):
        s = jnp.einsum('bqkgd,bskd->bkgqs', q_i, k).astype(jnp.float32) * scale
        p = jax.nn.softmax(s, axis=-1).astype(v.dtype)
        return jnp.einsum('bkgqs,bskd->bqkgd', p, v)

    o = lax.map(one_block, qb)
    return o.transpose(1, 0, 2, 3, 4, 5).reshape(b, tq, h, v.shape[-1])


def delta_rule_chunked(q, k, v, g, beta, s0):
    f32 = jnp.float32
    b, t_len, h, dk = q.shape
    dv = v.shape[-1]
    n = t_len // GDN_CHUNK
    cl = GDN_CHUNK

    def chunks(t):
        return jnp.moveaxis(t.astype(f32).reshape(b, n, cl, h, *t.shape[3:]), 3, 1)

    qc, kc, vc, gch, bc = chunks(q), chunks(k), chunks(v), chunks(g), chunks(beta)
    gc = jnp.cumsum(gch, -1)
    tril = jnp.tril(jnp.ones((cl, cl), bool))
    strict = jnp.tril(jnp.ones((cl, cl), bool), -1)
    decay = jnp.exp(jnp.where(tril, gc[..., :, None] - gc[..., None, :], -jnp.inf))
    kb = kc * bc[..., None]
    vb = vc * bc[..., None]
    m = jnp.where(strict, jnp.einsum('bhncd,bhnsd->bhncs', kb, kc) * decay, 0.0)
    eye = jnp.eye(cl, dtype=f32)
    tmat = lax.linalg.triangular_solve(m + eye, jnp.broadcast_to(eye, m.shape), left_side=True,
                                       lower=True, unit_diagonal=True)
    u = jnp.einsum('bhncs,bhnsv->bhncv', tmat, vb)
    w = jnp.einsum('bhncs,bhnsk->bhnck', tmat, kb * jnp.exp(gc)[..., None])
    qk = jnp.einsum('bhncd,bhnsd->bhncs', qc, kc) * decay
    q_dec = qc * jnp.exp(gc)[..., None]
    k_dec = kc * jnp.exp(gc[..., -1:] - gc)[..., None]
    g_last = jnp.exp(gc[..., -1])
    xs = tuple(jnp.moveaxis(t, 2, 0) for t in (u, w, qk, q_dec, k_dec, g_last))

    def step(s, inp):
        u_i, w_i, qk_i, qd_i, kd_i, gl_i = inp
        v_new = u_i - jnp.einsum('bhck,bhkv->bhcv', w_i, s)
        o_i = jnp.einsum('bhck,bhkv->bhcv', qd_i, s) + jnp.einsum('bhcs,bhsv->bhcv', qk_i, v_new)
        s = s * gl_i[..., None, None] + jnp.einsum('bhck,bhcv->bhkv', kd_i, v_new)
        return s, o_i

    s_fin, o = lax.scan(step, s0.astype(f32), xs)
    return s_fin, o.transpose(1, 0, 3, 2, 4).reshape(b, t_len, h, dv)


def gdn_prepare(qkv, a, bt, conv_w, a_log, dt_bias):
    b, t_len, _ = qkv.shape
    qkv = jax.nn.silu(short_conv(qkv, conv_w))
    q, k, v = jnp.split(qkv, [GDN_QK_W, 2 * GDN_QK_W], axis=-1)
    q = l2_normalize(q.reshape(b, t_len, GDN_HEADS, GDN_DK)) * (GDN_DK ** -0.5)
    k = l2_normalize(k.reshape(b, t_len, GDN_HEADS, GDN_DK))
    v = v.reshape(b, t_len, GDN_HEADS, GDN_DV)
    a = a.reshape(b, t_len, 2, GDN_HEADS).astype(jnp.float32)
    bt = bt.reshape(b, t_len, 2, GDN_HEADS).astype(jnp.float32)
    g = -jnp.exp(a_log.astype(jnp.float32)) * jax.nn.softplus(a + dt_bias.astype(jnp.float32))
    return q, k, v, g, jax.nn.sigmoid(bt)


def gdn_bidirectional(lat, ctx):
    q_l, k_l, v_l, g_l, b_l = lat
    q_c, k_c, v_c, g_c, b_c = ctx
    s0 = jnp.zeros((q_l.shape[0], GDN_HEADS, GDN_DK, GDN_DV), jnp.float32)
    s_cf, oc_f = delta_rule_chunked(q_c, k_c, v_c, g_c[:, :, 0], b_c[:, :, 0], s0)
    _, ol_f = delta_rule_chunked(q_l, k_l, v_l, g_l[:, :, 0], b_l[:, :, 0], s_cf)
    fl = lambda t: jnp.flip(t, 1)
    s_cb, oc_b = delta_rule_chunked(fl(q_c), fl(k_c), fl(v_c), fl(g_c[:, :, 1]), fl(b_c[:, :, 1]), s0)
    _, ol_b = delta_rule_chunked(fl(q_l), fl(k_l), fl(v_l), fl(g_l[:, :, 1]), fl(b_l[:, :, 1]), s_cb)
    return ol_f + fl(ol_b), oc_f + fl(oc_b)


def gdn_output(o, gate, out_norm):
    b, t_len, h, dv = o.shape
    o = rms_norm(o.astype(gate.dtype), out_norm)
    return (o * jax.nn.silu(gate.reshape(b, t_len, h, dv))).reshape(b, t_len, h * dv)


def mla_q(q_down, q_norm, w_q_up, rope):
    b, t_len, _ = q_down.shape
    q = (rms_norm(q_down, q_norm) @ w_q_up).reshape(b, t_len, MLA_HEADS, MLA_NOPE + MLA_ROPE)
    if rope is None:
        return q
    return jnp.concatenate([q[..., :MLA_NOPE], apply_rope(q[..., MLA_NOPE:], *rope)], -1)


def mla_kv(kv_down, k_pe, kv_norm, w_kv_up, rope):
    b, t_len, _ = kv_down.shape
    kv = (rms_norm(kv_down, kv_norm) @ w_kv_up).reshape(b, t_len, MLA_HEADS, MLA_NOPE + MLA_V)
    k_pe = k_pe[:, :, None, :]
    if rope is not None:
        k_pe = apply_rope(k_pe, *rope)
    k = jnp.concatenate([kv[..., :MLA_NOPE], jnp.broadcast_to(k_pe, (b, t_len, MLA_HEADS, MLA_ROPE))], -1)
    return k, kv[..., MLA_NOPE:]


def neighbourhood_attention(q, k, v, k_ctx, v_ctx, rpb):
    b, s_len, h, d = q.shape
    rows = s_len // GRID_W
    kh = min(NA_WIN_H, rows)
    kw = NA_WIN_W
    nk = kh * kw
    r = jnp.arange(rows)
    col = jnp.arange(GRID_W)
    rs = jnp.clip(r - kh // 2, 0, rows - kh)
    cs = jnp.clip(col - kw // 2, 0, GRID_W - kw)
    kr = rs[:, None] + jnp.arange(kh)
    kc = cs[:, None] + jnp.arange(kw)
    idx = (kr[:, None, :, None] * GRID_W + kc[None, :, None, :]).reshape(rows, GRID_W * nk)
    dr = kr - r[:, None] + (NA_WIN_H - 1)
    dc = kc - col[:, None] + (NA_WIN_W - 1)
    bias = rpb[:, dr[:, None, :, None], dc[None, :, None, :]]
    bias = bias.reshape(h, rows, GRID_W, nk).transpose(1, 0, 2, 3).astype(jnp.float32)
    qr = q.reshape(b, rows, GRID_W, h, d).transpose(1, 0, 2, 3, 4)
    scale = d ** -0.5

    def row_block(inp):
        q_i, idx_i, b_i = inp
        kg = jnp.take(k, idx_i, axis=1).reshape(b, GRID_W, nk, h, d)
        vg = jnp.take(v, idx_i, axis=1).reshape(b, GRID_W, nk, h, d)
        s_loc = jnp.einsum('bqhd,bqnhd->bhqn', q_i, kg).astype(jnp.float32) * scale + b_i[None]
        s_ctx = jnp.einsum('bqhd,bshd->bhqs', q_i, k_ctx).astype(jnp.float32) * scale
        p = jax.nn.softmax(jnp.concatenate([s_loc, s_ctx], -1), axis=-1).astype(v.dtype)
        return (jnp.einsum('bhqn,bqnhd->bqhd', p[..., :nk], vg)
                + jnp.einsum('bhqs,bshd->bqhd', p[..., nk:], v_ctx))

    o = lax.map(row_block, (qr, idx, bias))
    return o.transpose(1, 0, 2, 3, 4).reshape(b, s_len, h, d)


def even_mixer(u_lat, u_ctx, need_ctx, w_in, w_out, conv_w, a_log, dt_bias, out_norm,
               q_norm, w_q_up, kv_norm, w_kv_up, rope):
    b, s_len, _ = u_lat.shape
    lat = split_cols(u_lat @ w_in, EVEN_SPLITS)
    ctx = split_cols(u_ctx @ w_in, EVEN_SPLITS)
    o_lat, o_ctx = gdn_bidirectional(gdn_prepare(lat[0], lat[2], lat[3], conv_w, a_log, dt_bias),
                                     gdn_prepare(ctx[0], ctx[2], ctx[3], conv_w, a_log, dt_bias))
    a_lat = gdn_output(o_lat, lat[1], out_norm)
    k_c, v_c = mla_kv(ctx[5], ctx[6], kv_norm, w_kv_up, None)
    k_l, v_l = mla_kv(lat[5], lat[6], kv_norm, w_kv_up, rope)
    q_l = mla_q(lat[4], q_norm, w_q_up, rope)
    scale = (MLA_NOPE + MLA_ROPE) ** -0.5
    b_lat = blocked_attention(q_l, jnp.concatenate([k_c, k_l], 1), jnp.concatenate([v_c, v_l], 1), scale)
    y_lat = jnp.concatenate([a_lat, b_lat.reshape(b, s_len, -1)], -1) @ w_out
    if not need_ctx:
        return y_lat, None
    l_len = u_ctx.shape[1]
    a_ctx = gdn_output(o_ctx, ctx[1], out_norm)
    b_ctx = blocked_attention(mla_q(ctx[4], q_norm, w_q_up, None), k_c, v_c, scale)
    y_ctx = jnp.concatenate([a_ctx, b_ctx.reshape(b, l_len, -1)], -1) @ w_out
    return y_lat, y_ctx


def odd_mixer(u_lat, u_ctx, need_ctx, w_in, w_out, rpb, q_norm, k_norm, rope):
    b, s_len, _ = u_lat.shape
    lat = split_cols(u_lat @ w_in, ODD_SPLITS)
    ctx = split_cols(u_ctx @ w_in, ODD_SPLITS)
    kn_c, vn_c = to_heads(ctx[1], NA_HEADS), to_heads(ctx[2], NA_HEADS)
    c_lat = neighbourhood_attention(to_heads(lat[0], NA_HEADS), to_heads(lat[1], NA_HEADS),
                                    to_heads(lat[2], NA_HEADS), kn_c, vn_c, rpb)
    kd_c = rms_norm(to_heads(ctx[4], GQA_KV_HEADS), k_norm)
    vd_c = to_heads(ctx[5], GQA_KV_HEADS)
    qd_l = apply_rope(rms_norm(to_heads(lat[3], GQA_HEADS), q_norm), *rope)
    kd_l = apply_rope(rms_norm(to_heads(lat[4], GQA_KV_HEADS), k_norm), *rope)
    scale = GQA_DIM ** -0.5
    d_lat = blocked_attention(qd_l, jnp.concatenate([kd_c, kd_l], 1),
                              jnp.concatenate([vd_c, to_heads(lat[5], GQA_KV_HEADS)], 1), scale)
    y_lat = jnp.concatenate([c_lat.reshape(b, s_len, -1), d_lat.reshape(b, s_len, -1)], -1) @ w_out
    if not need_ctx:
        return y_lat, None
    l_len = u_ctx.shape[1]
    c_ctx_o = blocked_attention(to_heads(ctx[0], NA_HEADS), kn_c, vn_c, NA_DIM ** -0.5)
    d_ctx = blocked_attention(rms_norm(to_heads(ctx[3], GQA_HEADS), q_norm), kd_c, vd_c, scale)
    y_ctx = jnp.concatenate([c_ctx_o.reshape(b, l_len, -1), d_ctx.reshape(b, l_len, -1)], -1) @ w_out
    return y_lat, y_ctx


def setup_inputs(seed: int = 0) -> dict:
    key = jax.random.key(seed)
    ks = iter(jax.random.split(key, 40))
    f32 = jnp.float32

    def nrm(shape, scale):
        return jax.random.normal(next(ks), shape, f32) * scale

    def gain(shape):
        return 1.0 + 0.05 * jax.random.normal(next(ks), shape, f32)

    d = D_MODEL
    x = nrm((BATCH, SEQ, d), 1.0)
    c = nrm((BATCH, d), 1.0)
    ctx = nrm((BATCH, CTX_LEN, d), 1.0)
    c_ctx = nrm((d,), 1.0)
    w_mod = nrm((DEPTH, d, 6 * d), 0.5 * d ** -0.5)
    b_mod = nrm((DEPTH, 6 * d), 0.01)
    g_pre_mix = gain((DEPTH, d))
    g_post_mix = gain((DEPTH, d))
    g_pre_ffn = gain((DEPTH, d))
    g_post_ffn = gain((DEPTH, d))
    w_ffn_gate = nrm((DEPTH, d, D_FF), d ** -0.5)
    w_ffn_up = nrm((DEPTH, d, D_FF), d ** -0.5)
    w_ffn_down = nrm((DEPTH, D_FF, d), D_FF ** -0.5)
    w_in_even = nrm((N_EVEN, d, IN_EVEN), d ** -0.5)
    w_out_even = nrm((N_EVEN, MIX_EVEN, d), MIX_EVEN ** -0.5)
    gdn_conv = nrm((N_EVEN, GDN_CONV, 2 * GDN_QK_W + GDN_V_W), GDN_CONV ** -0.5)
    gdn_a_log = jnp.log(jax.random.uniform(next(ks), (N_EVEN, 2, GDN_HEADS), f32, 1.0, 16.0))
    dt = jnp.exp(jax.random.uniform(next(ks), (N_EVEN, 2, GDN_HEADS), f32,
                                    float(np.log(1e-3)), float(np.log(1e-1))))
    gdn_dt_bias = dt + jnp.log(-jnp.expm1(-dt))
    gdn_out_norm = gain((N_EVEN, GDN_DV))
    mla_q_norm = gain((N_EVEN, MLA_Q_LORA))
    mla_w_q_up = nrm((N_EVEN, MLA_Q_LORA, MLA_HEADS * (MLA_NOPE + MLA_ROPE)), MLA_Q_LORA ** -0.5)
    mla_kv_norm = gain((N_EVEN, MLA_KV_LORA))
    mla_w_kv_up = nrm((N_EVEN, MLA_KV_LORA, MLA_HEADS * (MLA_NOPE + MLA_V)), MLA_KV_LORA ** -0.5)
    w_in_odd = nrm((N_ODD, d, IN_ODD), d ** -0.5)
    w_out_odd = nrm((N_ODD, MIX_ODD, d), MIX_ODD ** -0.5)
    na_rpb = nrm((N_ODD, NA_HEADS, 2 * NA_WIN_H - 1, 2 * NA_WIN_W - 1), 0.1)
    gqa_q_norm = gain((N_ODD, GQA_DIM))
    gqa_k_norm = gain((N_ODD, GQA_DIM))
    return {'x': x, 'c': c, 'ctx': ctx, 'c_ctx': c_ctx, 'w_mod': w_mod, 'b_mod': b_mod,
            'g_pre_mix': g_pre_mix, 'g_post_mix': g_post_mix, 'g_pre_ffn': g_pre_ffn,
            'g_post_ffn': g_post_ffn, 'w_ffn_gate': w_ffn_gate, 'w_ffn_up': w_ffn_up,
            'w_ffn_down': w_ffn_down, 'w_in_even': w_in_even, 'w_out_even': w_out_even,
            'gdn_conv': gdn_conv, 'gdn_a_log': gdn_a_log, 'gdn_dt_bias': gdn_dt_bias,
            'gdn_out_norm': gdn_out_norm, 'mla_q_norm': mla_q_norm, 'mla_w_q_up': mla_w_q_up,
            'mla_kv_norm': mla_kv_norm, 'mla_w_kv_up': mla_w_kv_up, 'w_in_odd': w_in_odd,
            'w_out_odd': w_out_odd, 'na_rpb': na_rpb, 'gqa_q_norm': gqa_q_norm, 'gqa_k_norm': gqa_k_norm}


def reference(x, c, ctx, c_ctx, w_mod, b_mod, g_pre_mix, g_post_mix, g_pre_ffn, g_post_ffn,
              w_ffn_gate, w_ffn_up, w_ffn_down, w_in_even, w_out_even, gdn_conv, gdn_a_log,
              gdn_dt_bias, gdn_out_norm, mla_q_norm, mla_w_q_up, mla_kv_norm, mla_w_kv_up,
              w_in_odd, w_out_odd, na_rpb, gqa_q_norm, gqa_k_norm):
    s_len = x.shape[1]
    rope_mla = axial_rope(s_len, MLA_ROPE)
    rope_gqa = axial_rope(s_len, GQA_DIM)
    h, hc = x, ctx
    for i in range(DEPTH):
        last = i == DEPTH - 1
        mod = (jax.nn.silu(c) @ w_mod[i] + b_mod[i])[:, None, :]
        mod_c = (jax.nn.silu(c_ctx) @ w_mod[i] + b_mod[i])[None, None, :]
        sh_m, sc_m, gt_m, sh_f, sc_f, gt_f = jnp.split(mod, 6, axis=-1)
        csh_m, csc_m, cgt_m, csh_f, csc_f, cgt_f = jnp.split(mod_c, 6, axis=-1)
        u = modulate(rms_norm(h, g_pre_mix[i]), sh_m, sc_m)
        uc = modulate(rms_norm(hc, g_pre_mix[i]), csh_m, csc_m)
        j = i // 2
        if i % 2 == 0:
            y, yc = even_mixer(u, uc, not last, w_in_even[j], w_out_even[j], gdn_conv[j], gdn_a_log[j],
                               gdn_dt_bias[j], gdn_out_norm[j], mla_q_norm[j], mla_w_q_up[j],
                               mla_kv_norm[j], mla_w_kv_up[j], rope_mla)
        else:
            y, yc = odd_mixer(u, uc, not last, w_in_odd[j], w_out_odd[j], na_rpb[j],
                              gqa_q_norm[j], gqa_k_norm[j], rope_gqa)
        h = h + gt_m * rms_norm(y, g_post_mix[i])
        f = swiglu(modulate(rms_norm(h, g_pre_ffn[i]), sh_f, sc_f), w_ffn_gate[i], w_ffn_up[i], w_ffn_down[i])
        h = h + gt_f * rms_norm(f, g_post_ffn[i])
        if not last:
            hc = hc + cgt_m * rms_norm(yc, g_post_mix[i])
            fc = swiglu(modulate(rms_norm(hc, g_pre_ffn[i]), csh_f, csc_f), w_ffn_gate[i], w_ffn_up[i], w_ffn_down[i])
            hc = hc + cgt_f * rms_norm(fc, g_post_ffn[i])
    return h
```

```cpp
#include <hip/hip_runtime.h>
#include <hip/hip_cooperative_groups.h>
#include <cstdio>
#include <cstdint>
namespace cg = cooperative_groups;
__device__ __forceinline__ int tid_fresh() { int t = threadIdx.x; asm volatile("" : "+v"(t)); return t; }
namespace pg8 {
#define PG8_LAS __attribute__((address_space(3)))
typedef unsigned short bf16_t;
typedef short bf16x8 __attribute__((ext_vector_type(8)));
typedef float f32x4 __attribute__((ext_vector_type(4)));
typedef unsigned u32x4 __attribute__((ext_vector_type(4)));
constexpr int BM = 256, BK = 64, HALF = 128, HTB = HALF * BK * 2  , STAGE_BYTES = 8 * HTB, NXCD = 8, WGM = 8;

__host__ __device__ __forceinline__ int lds_byte(int r, int c) { const int st = (r >> 4) * 2 + (c >> 5), rr = r & 15, cc = c & 31, ob = rr * 64 + cc * 2; return st * 1024 + (ob ^ (((ob >> 9) & 1) << 5)); }
__host__ __device__ __forceinline__ void stage_rc(int b, int& R, int& C) { const int st = b / 1024, sb = b % 1024, swz = sb ^ (((sb >> 9) & 1) << 5); R = (st >> 1) * 16 + swz / 64; C = (st & 1) * 32 + (swz % 64) / 2; }
__host__ __device__ __forceinline__ int perm32(int rho) { const int n = rho >> 4, i = rho & 15; return 8 * (i >> 2) + 4 * n + (i & 3); }

struct Unit { int pm, pn; };
struct Gemm { const bf16_t* A; const bf16_t* Bt; int M, N, K; };

struct StaticOrder {
    int nM, nN, nwg, G, c;
    __host__ __device__ void init(int M, int N, int G_, int c_) { nM = M / BM; nN = N / BM; nwg = nM * nN; G = G_; c = c_; }
    __host__ __device__ bool next(int i, Unit& u) const {
        const long L = (long)i * G + c; if (L >= nwg) return false;
        int wgid = (int)L; { const int q = nwg / NXCD, r = nwg % NXCD, xcd = wgid % NXCD, off = wgid / NXCD; wgid = (xcd < r ? xcd * (q + 1) : r * (q + 1) + (xcd - r) * q) + off; }
        const int nig = WGM * nN, gid = wgid / nig, fm = gid * WGM, gsz = (nM - fm) < WGM ? (nM - fm) : WGM;
        u.pm = fm + ((wgid % nig) % gsz); u.pn = (wgid % nig) / gsz; return true;
    }
    __device__ __forceinline__ void a_ready(const Unit&) const {}
    __device__ __forceinline__ void done(const Unit&) const {}
};

__device__ __forceinline__ unsigned cvt_pk_bf16(float lo, float hi) { unsigned r; asm volatile("v_cvt_pk_bf16_f32 %0, %1, %2" : "=v"(r) : "v"(lo), "v"(hi)); return r; }
typedef float f32x2 __attribute__((ext_vector_type(2)));
__device__ __forceinline__ f32x2 gelu_pk(f32x2 v) {
    const f32x2 av = __builtin_elementwise_abs(v), d = av * 0.2316418882f + 1.0f;
    f32x2 t; t.x = __builtin_amdgcn_rcpf(d.x); t.y = __builtin_amdgcn_rcpf(d.y);
    f32x2 q = t * 0.5307027145f + (-0.7265760135f); q = q * t + 0.7107068705f; q = q * t + (-0.142248368f); q = q * t + 0.127414796f; q = q * t;
    const f32x2 s = (v * v) * (-0.72134752044f);
    f32x2 e; e.x = __builtin_amdgcn_exp2f(s.x); e.y = __builtin_amdgcn_exp2f(s.y);
    const f32x2 m = v * (q * e), r = v - m;
    f32x2 o; o.x = v.x < 0.f ? m.x : r.x; o.y = v.y < 0.f ? m.y : r.y; return o;
}

template <int ACT  > struct EpiBf16 {
    static constexpr bool PERM = true, AFTER_DRAIN = false; static_assert(ACT == 0 || ACT == 1, "EpiBf16: ACT is 0 (none) or 1 (gelu_pk)");
    bf16_t* O; int ldc; const float* bias; int split_cols; size_t split_stride; float scale0;
    __device__ __forceinline__ void operator()(const f32x4 (&acc)[2][2][4][2], const Unit& u, int wr, int wc, int fr, int fq) const {
        const int row0 = u.pm * BM + wr * 64 + fr; int colt = u.pn * BM; bf16_t* base = O;
        float sc = 1.f; if (split_cols) { const int t = colt / split_cols; base += (size_t)t * split_stride; colt -= t * split_cols; if (t == 0) sc = scale0; }
        const int col0 = colt + wc * 32 + 8 * fq, bcol0 = u.pn * BM + wc * 32 + 8 * fq;
        f32x4 bv[2][2];
#pragma unroll
        for (int bj = 0; bj < 2; ++bj)
#pragma unroll
            for (int n = 0; n < 2; ++n) bv[bj][n] = bias ? *(const f32x4*)(bias + bcol0 + bj * HALF + 4 * n) : (f32x4){0.f, 0.f, 0.f, 0.f};
#pragma unroll
        for (int ai = 0; ai < 2; ++ai)
#pragma unroll
            for (int m = 0; m < 4; ++m) { bf16_t* rowp = base + (size_t)(row0 + ai * HALF + m * 16) * ldc + col0;
#pragma unroll
                for (int bj = 0; bj < 2; ++bj) { f32x4 v0 = acc[ai][bj][m][0] + bv[bj][0], v1 = acc[ai][bj][m][1] + bv[bj][1];
                    if (ACT == 1) { f32x2 a = gelu_pk((f32x2){v0[0], v0[1]}), b = gelu_pk((f32x2){v0[2], v0[3]}), c = gelu_pk((f32x2){v1[0], v1[1]}), d = gelu_pk((f32x2){v1[2], v1[3]});
                        v0 = (f32x4){a.x, a.y, b.x, b.y}; v1 = (f32x4){c.x, c.y, d.x, d.y}; }
                    v0 = v0 * sc; v1 = v1 * sc; u32x4 w; w.x = cvt_pk_bf16(v0[0], v0[1]); w.y = cvt_pk_bf16(v0[2], v0[3]); w.z = cvt_pk_bf16(v1[0], v1[1]); w.w = cvt_pk_bf16(v1[2], v1[3]);
                    *(u32x4*)(rowp + bj * HALF) = w; } }
    }
};

struct PanelStats {
    unsigned* xbuf;
    unsigned* cnt;
    unsigned* tmo;
    int ntn; float eps;
    unsigned code;
    __device__ __forceinline__ bool run(const f32x4 (&v)[2][2][4][2], const Unit& u, int wr, int wc, int fr, int fq, PG8_LAS unsigned char* lds, int wid, int lane) const {
        typedef float f32x2v __attribute__((ext_vector_type(2)));
        PG8_LAS f32x2v* P = (PG8_LAS f32x2v*)lds;
        PG8_LAS f32x2v* S = (PG8_LAS f32x2v*)(lds + 8192);
        PG8_LAS unsigned* flag = (PG8_LAS unsigned*)(lds + 8192 + 2048);
#pragma unroll
        for (int ai = 0; ai < 2; ++ai)
#pragma unroll
            for (int m = 0; m < 4; ++m) {
                float s = 0.f;
#pragma unroll
                for (int bj = 0; bj < 2; ++bj)
#pragma unroll
                    for (int n = 0; n < 2; ++n) { const f32x4 x = v[ai][bj][m][n]; s += (x[0] + x[1]) + (x[2] + x[3]); }
                s += __shfl_xor(s, 16); s += __shfl_xor(s, 32);
                const float mw = s * (1.0f / 64.0f); float q = 0.f;
#pragma unroll
                for (int bj = 0; bj < 2; ++bj)
#pragma unroll
                    for (int n = 0; n < 2; ++n) { const f32x4 d = v[ai][bj][m][n] - mw; q += (d[0] * d[0] + d[1] * d[1]) + (d[2] * d[2] + d[3] * d[3]); }
                q += __shfl_xor(q, 16); q += __shfl_xor(q, 32);
                if (fq == 0) P[(ai * HALF + wr * 64 + m * 16 + fr) * 4 + wc] = (f32x2v){mw, q};
            }
        asm volatile("s_waitcnt lgkmcnt(0)" ::: "memory"); __builtin_amdgcn_s_barrier(); asm volatile("" ::: "memory");
#if defined(BROKEN_EXCHANGE_NO_WAIT)
#warning BROKEN CONTROL BUILD: the row-statistics exchange does not wait; results are wrong by design
        if (blockIdx.x >= 64) { const long long t0_ = clock64(); while (clock64() - t0_ < 60000) __builtin_amdgcn_s_sleep(8); }
#endif
        const int row = wid * 32 + (lane & 31);
        if (lane < 32) {
            const f32x2v a = P[row * 4 + 0], b = P[row * 4 + 1], c = P[row * 4 + 2], d = P[row * 4 + 3];
            const float mt = (a.x + b.x + c.x + d.x) * 0.25f;
            const float da = a.x - mt, db = b.x - mt, dc = c.x - mt, dd = d.x - mt;
            const float m2 = (a.y + b.y) + (c.y + d.y) + 64.0f * ((da * da + db * db) + (dc * dc + dd * dd));
            unsigned long long* slot = (unsigned long long*)xbuf + ((size_t)(u.pm * BM + row) * 4 + u.pn);
            __hip_atomic_store(slot, ((unsigned long long)__float_as_uint(m2) << 32) | __float_as_uint(mt), __ATOMIC_RELAXED, __HIP_MEMORY_SCOPE_AGENT);
        }
        asm volatile("s_waitcnt vmcnt(0)" ::: "memory");
        if (lane == 0) __hip_atomic_fetch_add(cnt + 64 * u.pm, 1u, __ATOMIC_RELAXED, __HIP_MEMORY_SCOPE_AGENT);
        if (wid == 0) {
            bool dead = false; const unsigned long long t0 = __builtin_amdgcn_s_memrealtime(); const unsigned want = 8u * (unsigned)ntn;
            for (;;) {
#if defined(BROKEN_EXCHANGE_NO_WAIT)
                break;
#endif
                if ((unsigned)__builtin_amdgcn_readfirstlane(__hip_atomic_load(cnt + 64 * u.pm, __ATOMIC_RELAXED, __HIP_MEMORY_SCOPE_AGENT)) >= want) break;
                if (__builtin_amdgcn_s_memrealtime() - t0 > 2000000ull) {
                    if (lane == 0) { unsigned expect = 0u; __hip_atomic_compare_exchange_strong(tmo + 1, &expect, code | (unsigned)(u.pm & 0xff), __ATOMIC_RELAXED, __ATOMIC_RELAXED, __HIP_MEMORY_SCOPE_AGENT);
                                     __hip_atomic_store(tmo, 1u, __ATOMIC_RELAXED, __HIP_MEMORY_SCOPE_AGENT); }
                    dead = true; break; }
                __builtin_amdgcn_s_sleep(2);
            }
            __builtin_amdgcn_fence(__ATOMIC_ACQUIRE, "agent");
            if (lane == 0) flag[0] = dead ? 1u : 0u;
        }
        asm volatile("s_waitcnt vmcnt(0) lgkmcnt(0)" ::: "memory"); __builtin_amdgcn_s_barrier(); asm volatile("" ::: "memory");
        const bool bad = flag[0] != 0u;
        if (lane < 32) {
            const unsigned long long* slot = (const unsigned long long*)xbuf + (size_t)(u.pm * BM + row) * 4; float mt[4], m2[4]; float ms = 0.f;
#pragma unroll
            for (int t = 0; t < 4; ++t) { if (t < ntn) { const unsigned long long w = __hip_atomic_load(slot + t, __ATOMIC_RELAXED, __HIP_MEMORY_SCOPE_AGENT); mt[t] = __uint_as_float((unsigned)w); m2[t] = __uint_as_float((unsigned)(w >> 32)); } else { mt[t] = 0.f; m2[t] = 0.f; } ms += mt[t]; }
            const float mean = ms / (float)ntn; float q = 0.f;
#pragma unroll
            for (int t = 0; t < 4; ++t) if (t < ntn) { const float dm = mt[t] - mean; q += m2[t] + 256.0f * dm * dm; }
            S[row] = (f32x2v){mean, 1.0f / sqrtf(q / (256.0f * (float)ntn) + eps)};
        }
        asm volatile("s_waitcnt lgkmcnt(0)" ::: "memory"); __builtin_amdgcn_s_barrier(); asm volatile("" ::: "memory");
        return bad;
    }
};
struct EpiLnRes {
    static constexpr bool PERM = false, AFTER_DRAIN = true;
    const float* base; float* out; int ldc; const float* bias; PanelStats st; unsigned poison;
    __device__ __forceinline__ void fused(f32x4 (&acc)[2][2][4][2], const Unit& u, int wr, int wc, int fr, int fq, PG8_LAS unsigned char* lds, int wid, int lane) const {
        typedef float f32x2v __attribute__((ext_vector_type(2)));
        const PG8_LAS f32x2v* S = (const PG8_LAS f32x2v*)(lds + 8192);
        const int col0 = u.pn * BM + wc * 32 + 4 * fq;
#pragma unroll
        for (int bj = 0; bj < 2; ++bj)
#pragma unroll
            for (int n = 0; n < 2; ++n) { const f32x4 bv = bias ? *(const f32x4*)(bias + col0 + bj * HALF + n * 16) : (f32x4){0.f, 0.f, 0.f, 0.f};
#pragma unroll
                for (int ai = 0; ai < 2; ++ai)
#pragma unroll
                    for (int m = 0; m < 4; ++m) acc[ai][bj][m][n] += bv; }
        f32x4 pre[4][2][2];
#pragma unroll
        for (int m = 0; m < 4; ++m) { const size_t off = (size_t)(u.pm * BM + wr * 64 + m * 16 + fr) * ldc + col0;
#pragma unroll
            for (int bj = 0; bj < 2; ++bj)
#pragma unroll
                for (int n = 0; n < 2; ++n) pre[m][bj][n] = *(const f32x4*)(base + off + bj * HALF + n * 16); }
        const bool bad = st.run(acc, u, wr, wc, fr, fq, lds, wid, lane) || poison != 0u;
        const float qnan = __builtin_nanf("");
#pragma unroll
        for (int ai = 0; ai < 2; ++ai)
#pragma unroll
            for (int m = 0; m < 4; ++m) { const int r = ai * HALF + wr * 64 + m * 16 + fr; const f32x2v sr = S[r]; const size_t off = (size_t)(u.pm * BM + r) * ldc + col0;
#pragma unroll
                for (int bj = 0; bj < 2; ++bj)
#pragma unroll
                    for (int n = 0; n < 2; ++n) { const f32x4 bs = ai == 0 ? pre[m][bj][n] : *(const f32x4*)(base + off + bj * HALF + n * 16); f32x4 o = bs + (acc[ai][bj][m][n] - sr.x) * sr.y;
                        if (bad) o = (f32x4){qnan, qnan, qnan, qnan}; *(f32x4*)(out + off + bj * HALF + n * 16) = o; }
                if (m & 1) asm volatile("" ::: "memory"); }
    }
};
struct EpiLnResLn {
    static constexpr bool PERM = false, AFTER_DRAIN = true;
    const float* base; float* out; bf16_t* xn; int ldc; const float* bias; PanelStats st1, st2; unsigned poison;
    __device__ __forceinline__ void fused(f32x4 (&acc)[2][2][4][2], const Unit& u, int wr, int wc, int fr, int fq, PG8_LAS unsigned char* lds, int wid, int lane) const {
        typedef float f32x2v __attribute__((ext_vector_type(2))); typedef unsigned u32x2v __attribute__((ext_vector_type(2)));
        const PG8_LAS f32x2v* S = (const PG8_LAS f32x2v*)(lds + 8192);
        const int col0 = u.pn * BM + wc * 32 + 4 * fq;
#pragma unroll
        for (int bj = 0; bj < 2; ++bj)
#pragma unroll
            for (int n = 0; n < 2; ++n) { const f32x4 bv = bias ? *(const f32x4*)(bias + col0 + bj * HALF + n * 16) : (f32x4){0.f, 0.f, 0.f, 0.f};
#pragma unroll
                for (int ai = 0; ai < 2; ++ai)
#pragma unroll
                    for (int m = 0; m < 4; ++m) acc[ai][bj][m][n] += bv; }
        bool bad = st1.run(acc, u, wr, wc, fr, fq, lds, wid, lane) || poison != 0u;
        const float qnan = __builtin_nanf("");
#pragma unroll
        for (int ai = 0; ai < 2; ++ai)
#pragma unroll
            for (int m = 0; m < 4; ++m) { const int r = ai * HALF + wr * 64 + m * 16 + fr; const f32x2v sr = S[r]; const size_t off = (size_t)(u.pm * BM + r) * ldc + col0;
#pragma unroll
                for (int bj = 0; bj < 2; ++bj)
#pragma unroll
                    for (int n = 0; n < 2; ++n) { const f32x4 bs = *(const f32x4*)(base + off + bj * HALF + n * 16); acc[ai][bj][m][n] = bs + (acc[ai][bj][m][n] - sr.x) * sr.y; }
                asm volatile("" : "+v"(acc[ai][0][m][0]), "+v"(acc[ai][0][m][1]), "+v"(acc[ai][1][m][0]), "+v"(acc[ai][1][m][1]));
                if (m & 1) asm volatile("" ::: "memory"); }
        const bool bad1 = bad;
        bad = st2.run(acc, u, wr, wc, fr, fq, lds, wid, lane) || bad;
#pragma unroll
        for (int ai = 0; ai < 2; ++ai)
#pragma unroll
            for (int m = 0; m < 4; ++m) { const int r = ai * HALF + wr * 64 + m * 16 + fr; const f32x2v sr = S[r]; const size_t off = (size_t)(u.pm * BM + r) * ldc + col0;
#pragma unroll
                for (int bj = 0; bj < 2; ++bj)
#pragma unroll
                    for (int n = 0; n < 2; ++n) { const f32x4 x1 = acc[ai][bj][m][n]; *(f32x4*)(out + off + bj * HALF + n * 16) = bad1 ? (f32x4){qnan, qnan, qnan, qnan} : x1;
                        const f32x4 o = (x1 - sr.x) * sr.y; u32x2v w; w.x = cvt_pk_bf16(o[0], o[1]); w.y = cvt_pk_bf16(o[2], o[3]);
                        if (bad) { w.x = 0x7fc07fc0u; w.y = 0x7fc07fc0u; } *(u32x2v*)(xn + off + bj * HALF + n * 16) = w; }
                asm volatile("" ::: "memory"); }
    }
};

template <class Epi, class Sched, bool ALIGN_EPI = false, bool SP2 = false>
__device__ __forceinline__ void gemm_phase(PG8_LAS unsigned char* lds, const Gemm g, const Sched& S, const Epi& E) {
    const int tid = ::tid_fresh(), wid = __builtin_amdgcn_readfirstlane(tid >> 6), lane = tid & 63, wr = wid >> 2, wc = wid & 3, fr = lane & 15, fq = lane >> 4;
    const int K = g.K, nt = K / BK;
    unsigned voffA[2], voffB[2];
#pragma unroll
    for (int i = 0; i < 2; ++i) { int R, C; stage_rc(tid * 16 + i * 8192, R, C); const int Rb = Epi::PERM ? ((R & ~31) + perm32(R & 31)) : R;
        voffA[i] = (unsigned)(R * K + C) * 2u; voffB[i] = (unsigned)(Rb * K + C) * 2u; }
    const size_t kstep = (size_t)(BK * 2);
    const size_t hstep = (size_t)HALF * K * 2;
    const size_t tstep = 2 * hstep;
    const unsigned ldsw = (unsigned)wid * 1024u;
    const int aoff = lds_byte(wr * 64 + fr, fq * 8), boff = lds_byte(wc * 32 + fr, fq * 8);
#define PG8_SA(b, h) (((b) * 2 + (h)) * HTB)
#define PG8_SB(b, h) ((4 + (b) * 2 + (h)) * HTB)
#define PG8_STAGE(bufoff, gbase, voff) do { _Pragma("unroll") for (int _i = 0; _i < 2; ++_i) \
        __builtin_amdgcn_global_load_lds((const unsigned*)((const char*)(gbase) + (voff)[_i]), (PG8_LAS unsigned*)(lds + (bufoff) + ldsw + _i * 8192), 16, 0, 0); } while (0)
#define PG8_LDA(dst, b, h) do { _Pragma("unroll") for (int m = 0; m < 4; ++m) _Pragma("unroll") for (int k = 0; k < 2; ++k) dst[m][k] = *(const PG8_LAS bf16x8*)(lds + PG8_SA(b, h) + aoff + m * 2048 + k * 1024); } while (0)
#define PG8_LDB(dst, b, h) do { _Pragma("unroll") for (int n = 0; n < 2; ++n) _Pragma("unroll") for (int k = 0; k < 2; ++k) dst[n][k] = *(const PG8_LAS bf16x8*)(lds + PG8_SB(b, h) + boff + n * 2048 + k * 1024); } while (0)
#define PG8_MMA(ai, bj, At, Bt) do { __builtin_amdgcn_s_setprio(1); _Pragma("unroll") for (int m = 0; m < 4; ++m) _Pragma("unroll") for (int n = 0; n < 2; ++n) _Pragma("unroll") for (int k = 0; k < 2; ++k) \
        acc[ai][bj][m][n] = __builtin_amdgcn_mfma_f32_16x16x32_bf16(Bt[n][k], At[m][k], acc[ai][bj][m][n], 0, 0, 0); __builtin_amdgcn_s_setprio(0); } while (0)
#define PG8_WAIT_V(n) asm volatile("s_waitcnt vmcnt(" #n ")" ::: "memory")
#define PG8_WAIT_L(n) asm volatile("s_waitcnt lgkmcnt(" #n ")" ::: "memory")
#define PG8_BAR __builtin_amdgcn_s_barrier()
#define PG8_SCHED __builtin_amdgcn_sched_barrier(0)
    Unit cur, nxt; int ui = 0;
    if (!S.next(0, cur)) return;
    f32x4 acc[2][2][4][2];
#pragma unroll
    for (int a = 0; a < 2; ++a)
#pragma unroll
        for (int b = 0; b < 2; ++b)
#pragma unroll
            for (int m = 0; m < 4; ++m)
#pragma unroll
                for (int n = 0; n < 2; ++n) acc[a][b][m][n] = (f32x4){0.f, 0.f, 0.f, 0.f};
    bf16x8 At[4][2], B0[2][2], B1[2][2];
    const char* cA = (const char*)g.A + (size_t)cur.pm * tstep; const char* cB = (const char*)g.Bt + (size_t)cur.pn * tstep;
    S.a_ready(cur);
    if constexpr (SP2) {
        PG8_STAGE(PG8_SB(0, 0), cB, voffB); PG8_STAGE(PG8_SB(0, 1), cB + hstep, voffB); PG8_STAGE(PG8_SA(0, 0), cA, voffA); PG8_STAGE(PG8_SA(0, 1), cA + hstep, voffA);
        if (wr == 1) PG8_BAR;
        PG8_WAIT_V(2); PG8_BAR;
        PG8_STAGE(PG8_SB(1, 0), cB + kstep, voffB); PG8_STAGE(PG8_SA(1, 0), cA + kstep, voffA); PG8_STAGE(PG8_SB(1, 1), cB + hstep + kstep, voffB);
        PG8_WAIT_V(6); PG8_BAR;
    } else {
        PG8_STAGE(PG8_SB(0, 0), cB, voffB); PG8_STAGE(PG8_SA(0, 0), cA, voffA); PG8_STAGE(PG8_SB(0, 1), cB + hstep, voffB); PG8_STAGE(PG8_SA(0, 1), cA + hstep, voffA);
        if (wr == 1) PG8_BAR;
        PG8_WAIT_V(4); PG8_BAR;
        PG8_STAGE(PG8_SB(1, 0), cB + kstep, voffB); PG8_STAGE(PG8_SA(1, 0), cA + kstep, voffA); PG8_STAGE(PG8_SB(1, 1), cB + hstep + kstep, voffB);
        PG8_WAIT_V(6); PG8_BAR;
    }
    for (;;) {
        const bool has_next = S.next(ui + 1, nxt);
        const char* nA = has_next ? (const char*)g.A + (size_t)nxt.pm * tstep : cA; const char* nB = has_next ? (const char*)g.Bt + (size_t)nxt.pn * tstep : cB;
        for (int t = 0; t < nt; t += 2) {
            const bool last = (t == nt - 2);
            const char* a1 = cA + (size_t)(t + 1) * kstep;
            const char* a2 = last ? nA : cA + (size_t)(t + 2) * kstep; const char* b2 = last ? nB : cB + (size_t)(t + 2) * kstep;
            const char* a3 = a2 + kstep; const char* b3 = b2 + kstep;
            if (last && has_next) S.a_ready(nxt);
            if constexpr (SP2) {
            PG8_LDB(B0, 0, 0); PG8_LDB(B1, 0, 1); PG8_SCHED; PG8_LDA(At, 0, 0); PG8_STAGE(PG8_SA(1, 1), a1 + hstep, voffA);
            PG8_WAIT_V(8); PG8_WAIT_L(0); PG8_BAR; PG8_MMA(0, 0, At, B0); PG8_MMA(0, 1, At, B1); PG8_BAR; PG8_SCHED;
            PG8_LDA(At, 0, 1); PG8_STAGE(PG8_SB(0, 0), b2, voffB); PG8_STAGE(PG8_SB(0, 1), b2 + hstep, voffB); PG8_STAGE(PG8_SA(0, 0), a2, voffA);
            PG8_WAIT_V(8); PG8_WAIT_L(0); PG8_BAR; PG8_MMA(1, 0, At, B0); PG8_MMA(1, 1, At, B1); PG8_BAR; PG8_SCHED;
            PG8_LDB(B0, 1, 0); PG8_LDB(B1, 1, 1); PG8_SCHED; PG8_LDA(At, 1, 0); PG8_STAGE(PG8_SA(0, 1), a2 + hstep, voffA);
            PG8_WAIT_V(8); PG8_WAIT_L(0); PG8_BAR; PG8_MMA(0, 0, At, B0); PG8_MMA(0, 1, At, B1); PG8_BAR; PG8_SCHED;
            PG8_LDA(At, 1, 1); PG8_STAGE(PG8_SB(1, 0), b3, voffB); PG8_STAGE(PG8_SB(1, 1), b3 + hstep, voffB); PG8_STAGE(PG8_SA(1, 0), a3, voffA);
            PG8_WAIT_V(8); PG8_WAIT_L(0); PG8_BAR; PG8_MMA(1, 0, At, B0); PG8_MMA(1, 1, At, B1); PG8_BAR; PG8_SCHED;
            } else {
            PG8_LDB(B0, 0, 0); PG8_SCHED; PG8_LDA(At, 0, 0); PG8_STAGE(PG8_SA(1, 1), a1 + hstep, voffA);
            PG8_WAIT_L(8); PG8_BAR; PG8_WAIT_L(0); PG8_MMA(0, 0, At, B0); PG8_BAR; PG8_SCHED;
            PG8_LDB(B1, 0, 1); PG8_STAGE(PG8_SB(0, 0), b2, voffB);
            PG8_BAR; PG8_WAIT_L(0); PG8_MMA(0, 1, At, B1); PG8_BAR;
            PG8_LDA(At, 0, 1); PG8_STAGE(PG8_SA(0, 0), a2, voffA);
            PG8_BAR; PG8_WAIT_L(0); PG8_MMA(1, 0, At, B0); PG8_BAR; PG8_SCHED;
            PG8_STAGE(PG8_SB(0, 1), b2 + hstep, voffB);
            PG8_WAIT_V(6); PG8_BAR; PG8_MMA(1, 1, At, B1); PG8_BAR;
            PG8_LDB(B0, 1, 0); PG8_SCHED; PG8_LDA(At, 1, 0); PG8_STAGE(PG8_SA(0, 1), a2 + hstep, voffA);
            PG8_WAIT_L(8); PG8_BAR; PG8_WAIT_L(0); PG8_MMA(0, 0, At, B0); PG8_BAR; PG8_SCHED;
            PG8_LDB(B1, 1, 1); PG8_STAGE(PG8_SB(1, 0), b3, voffB);
            PG8_BAR; PG8_WAIT_L(0); PG8_MMA(0, 1, At, B1); PG8_BAR;
            PG8_LDA(At, 1, 1); PG8_STAGE(PG8_SA(1, 0), a3, voffA);
            PG8_BAR; PG8_WAIT_L(0); PG8_MMA(1, 0, At, B0); PG8_BAR; PG8_SCHED;
            PG8_STAGE(PG8_SB(1, 1), b3 + hstep, voffB);
            PG8_WAIT_V(6); PG8_BAR; PG8_MMA(1, 1, At, B1); PG8_BAR;
            }
        }
        if constexpr (ALIGN_EPI) { if (wr == 0) PG8_BAR; }
        if constexpr (!Epi::AFTER_DRAIN) { E(acc, cur, wr, wc, fr, fq); S.done(cur); }
        if (!has_next) break;
#pragma unroll
        for (int a = 0; a < 2; ++a)
#pragma unroll
            for (int b = 0; b < 2; ++b)
#pragma unroll
                for (int m = 0; m < 4; ++m)
#pragma unroll
                    for (int n = 0; n < 2; ++n) acc[a][b][m][n] = (f32x4){0.f, 0.f, 0.f, 0.f};
        cur = nxt; cA = nA; cB = nB; ++ui;
        if constexpr (ALIGN_EPI) { if (wr == 1) PG8_BAR; }
    }
    PG8_WAIT_V(0);
    if constexpr (!ALIGN_EPI) { if (wr == 0) PG8_BAR; }
    PG8_BAR;
    if constexpr (Epi::AFTER_DRAIN) { E.fused(acc, cur, wr, wc, fr, fq, lds, wid, lane); S.done(cur); }
#undef PG8_SA
#undef PG8_SB
#undef PG8_STAGE
#undef PG8_LDA
#undef PG8_LDB
#undef PG8_MMA
#undef PG8_WAIT_V
#undef PG8_WAIT_L
#undef PG8_BAR
#undef PG8_SCHED
}
}

#define DI __device__ __forceinline__
typedef unsigned short bf16;
typedef short bf16x8 __attribute__((ext_vector_type(8)));
typedef short s16x4 __attribute__((ext_vector_type(4)));
typedef float f32x4 __attribute__((ext_vector_type(4)));
typedef float f32x16 __attribute__((ext_vector_type(16)));
typedef unsigned u32x4 __attribute__((ext_vector_type(4)));
typedef unsigned u32x2 __attribute__((ext_vector_type(2)));
typedef float f32x2_t __attribute__((ext_vector_type(2)));
typedef __bf16 bf16x2_t __attribute__((ext_vector_type(2)));

constexpr int DM = 1024, NB = 8, SEQ = 4096, CTXL = 256;
constexpr int ML = NB * SEQ;
constexpr int MC = NB * CTXL;
constexpr int MT = ML + MC;
constexpr int DFF = 2816;
constexpr int NZ0 = 2560;
constexpr int NZ1 = 2304;
constexpr int ZQKV = 0, ZGATE = 1536, ZA = 2048, ZBT = 2064, ZQD = 2080, ZKVD = 2336, ZKPE = 2464;
constexpr int Z1_NAQ = 0, Z1_NAK = 512, Z1_NAV = 1024, Z1_GQ = 1536, Z1_GK = 2048, Z1_GV = 2176;
constexpr float EPS = 1e-6f;
constexpr float LOG2E = 1.4426950408889634f;
constexpr int NTHREADS = 512, NWAVES = 8;
constexpr int LDS_BYTES = 147456;

constexpr size_t MiB = 1048576;
constexpr size_t WS_WIN0 = 0;
constexpr size_t WS_WOUT0 = 5 * MiB;
constexpr size_t WS_WGU0 = 7 * MiB;
constexpr size_t WS_WDN0 = 18 * MiB;
constexpr size_t WS_WQUP = 24 * MiB;
constexpr size_t WS_WKVUP = 24 * MiB + 512 * 1024;
constexpr size_t WS_WIN1 = 25 * MiB;
constexpr size_t WS_WOUT1 = 30 * MiB;
constexpr size_t WS_WGU1 = 32 * MiB;
constexpr size_t WS_WDN1 = 43 * MiB;
constexpr size_t WS_MOD = 49 * MiB;
constexpr size_t WS_HC = 50 * MiB;
constexpr size_t WS_U = 64 * MiB;
constexpr size_t WS_Z = 132 * MiB;
constexpr size_t WS_S = 320 * MiB;
constexpr size_t WS_QN = WS_S;
constexpr size_t WS_KVN = WS_S + 17 * MiB;
constexpr size_t WS_KPE = WS_S + 26 * MiB;
constexpr size_t WS_QMLA = WS_S + 29 * MiB;
constexpr size_t WS_KVMLA = WS_S + 80 * MiB;
constexpr size_t WS_GB = WS_S + 148 * MiB;
constexpr size_t WS_TINV = WS_S;
constexpr size_t WS_OF = WS_S + 68 * MiB;
constexpr size_t WS_OB = WS_S + 102 * MiB;
constexpr size_t WS_Y = WS_S;
constexpr size_t WS_GQ = WS_S + 70 * MiB;
constexpr size_t WS_GKK = WS_S + 104 * MiB;
constexpr size_t WS_END = WS_S + 153 * MiB;

struct KParams {
    const float* in[28];
    float* out;
    unsigned char* ws;
};

DI float bflo(unsigned w) { return __uint_as_float(w << 16); }
DI float bfhi(unsigned w) { return __uint_as_float(w & 0xffff0000u); }
DI float bf2f(bf16 b) { return __uint_as_float(((unsigned)b) << 16); }
DI unsigned pk2(float lo, float hi) { f32x2_t v = {lo, hi}; bf16x2_t b = __builtin_convertvector(v, bf16x2_t); return __builtin_bit_cast(unsigned, b); }
DI bf16 f2bf(float x) { return (bf16)(pk2(x, 0.f) & 0xffffu); }
DI void unpack8(const u32x4 w, float* f) {
    f[0] = bflo(w.x); f[1] = bfhi(w.x); f[2] = bflo(w.y); f[3] = bfhi(w.y); f[4] = bflo(w.z); f[5] = bfhi(w.z); f[6] = bflo(w.w); f[7] = bfhi(w.w);
}
DI u32x4 pack8(const float* f) { u32x4 w; w.x = pk2(f[0], f[1]); w.y = pk2(f[2], f[3]); w.z = pk2(f[4], f[5]); w.w = pk2(f[6], f[7]); return w; }
DI float wave_sum(float v) {
#pragma unroll
    for (int o = 1; o < 64; o <<= 1) v += __shfl_xor(v, o);
    return v;
}
DI float silu_f(float x) { return x * __builtin_amdgcn_rcpf(1.f + __expf(-x)); }
DI float sigmoid_f(float x) { return 1.f / (1.f + __expf(-x)); }
DI float softplus_f(float x) { return x > 20.f ? x : log1pf(expf(x)); }
DI int crow(int r, int hi) { return (r & 3) + 8 * (r >> 2) + 4 * hi; }
DI int batch_of(int m) { return m < ML ? (m >> 12) : 8; }
DI const float* modp(const KParams& p, int layer, int m) { return (const float*)(p.ws + WS_MOD) + (size_t)(layer * 9 + batch_of(m)) * 6144; }

struct TDesc { int src, src_off, K, N, ldw; unsigned dst_off_kb; int grp, gstride, goff; int nitems; };
constexpr int NTD = 14;
static constexpr TDesc g_td[NTD] = {
    {13, 0, 1024, 2496, 2496, (unsigned)(WS_WIN0 / 1024), 1 << 20, 0, 0, 16 * 78},
    {14, 0, 1024, 1024, 1024, (unsigned)(WS_WOUT0 / 1024), 1 << 20, 0, 0, 16 * 32},
    {10, 0, 1024, 2816, 2816, (unsigned)(WS_WGU0 / 1024), 128, 256, 0, 16 * 88},
    {11, 0, 1024, 2816, 2816, (unsigned)(WS_WGU0 / 1024), 128, 256, 128, 16 * 88},
    {12, 0, 2816, 1024, 1024, (unsigned)(WS_WDN0 / 1024), 1 << 20, 0, 0, 44 * 32},
    {20, 0, 256, 768, 768, (unsigned)(WS_WQUP / 1024), 1 << 20, 0, 0, 4 * 24},
    {22, 0, 128, 1024, 1024, (unsigned)(WS_WKVUP / 1024), 1 << 20, 0, 0, 2 * 32},
    {23, 0, 1024, 2304, 2304, (unsigned)(WS_WIN1 / 1024), 1 << 20, 0, 0, 16 * 72},
    {24, 0, 1024, 1024, 1024, (unsigned)(WS_WOUT1 / 1024), 1 << 20, 0, 0, 16 * 32},
    {10, 1024 * 2816, 1024, 2816, 2816, (unsigned)(WS_WGU1 / 1024), 128, 256, 0, 16 * 88},
    {11, 1024 * 2816, 1024, 2816, 2816, (unsigned)(WS_WGU1 / 1024), 128, 256, 128, 16 * 88},
    {12, 2816 * 1024, 2816, 1024, 1024, (unsigned)(WS_WDN1 / 1024), 1 << 20, 0, 0, 44 * 32},
    {0, 0, 0, 0, 0, 0, 1, 0, 0, 0},
    {0, 0, 0, 0, 0, 0, 1, 0, 0, 0},
};
constexpr int NTD_USED = 12;

DI void transpose_item(const float* W, int K, int N, bf16* WT, int grp, int gstride, int goff, float* scr, int item, int lane) {
    const int nblk = N / 32, kb = item / nblk, nb = item % nblk, k0 = 64 * kb, n0 = 32 * nb;
#pragma unroll 8
    for (int i = 0; i < 32; ++i) { const int kk = 2 * i + (lane >> 5); scr[kk * 33 + (lane & 31)] = W[(size_t)(k0 + kk) * N + n0 + (lane & 31)]; }
    asm volatile("s_waitcnt lgkmcnt(0)" ::: "memory");
    asm volatile("" ::: "memory");
    const int c = lane & 7;
#pragma unroll
    for (int j = 0; j < 4; ++j) {
        const int n = (lane >> 3) + 8 * j; const float* s = scr + (8 * c) * 33 + n;
        u32x4 o; o.x = pk2(s[0 * 33], s[1 * 33]); o.y = pk2(s[2 * 33], s[3 * 33]); o.z = pk2(s[4 * 33], s[5 * 33]); o.w = pk2(s[6 * 33], s[7 * 33]);
        const int nn = n0 + n; const int drow = (nn / grp) * gstride + (nn % grp) + goff;
        *(u32x4*)(WT + (size_t)drow * K + k0 + 8 * c) = o;
    }
    asm volatile("s_waitcnt lgkmcnt(0)" ::: "memory");
}

DI void phase_prologue(const KParams& p, unsigned char* lds) {
    const int tid = tid_fresh(), lane = tid & 63, wave = tid >> 6;
    const int G = gridDim.x;
    float* sc = (float*)lds;
    float* red = (float*)(lds + 36864);
    bool have_sc = false;
    for (int it = blockIdx.x; it < 192; it += G) {
        if (!have_sc) {
            for (int i = tid; i < 9 * 1024; i += NTHREADS) {
                const int bb = i >> 10, k = i & 1023;
                const float cv = bb < 8 ? p.in[1][bb * 1024 + k] : p.in[3][k];
                sc[i] = cv / (1.f + expf(-cv));
            }
            have_sc = true;
        }
        __syncthreads();
        const int layer = it / 96, n0 = (it % 96) * 64;
        const int col = tid & 63, ks = tid >> 6;
        const float* W = p.in[4] + (size_t)layer * 1024 * 6144 + n0 + col;
        float acc[9];
#pragma unroll
        for (int b = 0; b < 9; ++b) acc[b] = 0.f;
        for (int k = ks * 128; k < ks * 128 + 128; ++k) {
            const float w = W[(size_t)k * 6144];
#pragma unroll
            for (int b = 0; b < 9; ++b) acc[b] += sc[b * 1024 + k] * w;
        }
#pragma unroll
        for (int b = 0; b < 9; ++b) red[(ks * 9 + b) * 64 + col] = acc[b];
        __syncthreads();
        for (int i = tid; i < 576; i += NTHREADS) {
            const int b = i >> 6, c2 = i & 63; float s = 0.f;
#pragma unroll
            for (int k2 = 0; k2 < 8; ++k2) s += red[(k2 * 9 + b) * 64 + c2];
            s += p.in[5][layer * 6144 + n0 + c2];
            ((float*)(p.ws + WS_MOD))[(size_t)(layer * 9 + b) * 6144 + n0 + c2] = s;
        }
        __syncthreads();
    }
    __syncthreads();
    float* scr = (float*)(lds + 57344 + wave * 8448);
    const int gw = blockIdx.x * NWAVES + wave, NGW = G * NWAVES;
    int total = 0;
#pragma unroll
    for (int d = 0; d < NTD_USED; ++d) total += g_td[d].nitems;
    for (int it = gw; it < total; it += NGW) {
        int r = it;
#pragma unroll
        for (int d = 0; d < NTD_USED; ++d) {
            if (r >= 0 && r < g_td[d].nitems)
                transpose_item(p.in[g_td[d].src] + g_td[d].src_off, g_td[d].K, g_td[d].N, (bf16*)(p.ws + (size_t)g_td[d].dst_off_kb * 1024), g_td[d].grp, g_td[d].gstride, g_td[d].goff, scr, r, lane);
            r -= g_td[d].nitems;
        }
    }
    {
        u32x4* z = (u32x4*)(p.ws + WS_WIN0 + (size_t)2496 * 1024 * 2);
        const u32x4 zero = {0u, 0u, 0u, 0u};
        for (int i = blockIdx.x * NTHREADS + tid; i < 64 * 1024 * 2 / 16; i += G * NTHREADS) z[i] = zero;
    }
}

DI void phase_modnorm0(const KParams& p) {
    const int tid_ = tid_fresh(); const int lane = tid_ & 63, wave = tid_ >> 6;
    const int gw = blockIdx.x * NWAVES + wave, NGW = gridDim.x * NWAVES;
    const float* g = p.in[6];
    bf16* U = (bf16*)(p.ws + WS_U);
    for (int m = gw; m < MT; m += NGW) {
        const float* src = m < ML ? p.in[0] + (size_t)m * DM : p.in[2] + (size_t)(m - ML) * DM;
        const float* md = modp(p, 0, m);
        f32x4 v[4]; float ss = 0.f;
#pragma unroll
        for (int j = 0; j < 4; ++j) { v[j] = *(const f32x4*)(src + 4 * lane + 256 * j); ss += v[j].x * v[j].x + v[j].y * v[j].y + v[j].z * v[j].z + v[j].w * v[j].w; }
        const float rstd = rsqrtf(wave_sum(ss) * (1.f / DM) + EPS);
#pragma unroll
        for (int j = 0; j < 4; ++j) {
            const int c = 4 * lane + 256 * j;
            const f32x4 gg = *(const f32x4*)(g + c), sh = *(const f32x4*)(md + c), scl = *(const f32x4*)(md + 1024 + c);
            const f32x4 o = (v[j] * rstd * gg) * (1.f + scl) + sh;
            u32x2 w; w.x = pk2(o.x, o.y); w.y = pk2(o.z, o.w);
            *(u32x2*)(U + (size_t)m * DM + c) = w;
        }
    }
}

DI void phase_post(const KParams& p, int rows, const bf16* Y, int first_layer_input  , int layer, int gate_chunk,
                   const float* gpost, const float* g2, int nlayer, int nshift_chunk, bf16* Udst, bool ctx_rows_to_hc) {
    const int tid_ = tid_fresh(); const int lane = tid_ & 63, wave = tid_ >> 6;
    const int gw = blockIdx.x * NWAVES + wave, NGW = gridDim.x * NWAVES;
    float* HC = (float*)(p.ws + WS_HC);
    for (int m = gw; m < rows; m += NGW) {
        const float* hsrc; float* hdst;
        if (m < ML) { hsrc = first_layer_input ? p.in[0] + (size_t)m * DM : p.out + (size_t)m * DM; hdst = p.out + (size_t)m * DM; }
        else { hsrc = first_layer_input ? p.in[2] + (size_t)(m - ML) * DM : HC + (size_t)(m - ML) * DM; hdst = HC + (size_t)(m - ML) * DM; }
        const float* md = modp(p, layer, m);
        float y[16]; float ss = 0.f;
#pragma unroll
        for (int j = 0; j < 4; ++j) {
            const u32x2 w = *(const u32x2*)(Y + (size_t)m * DM + 4 * lane + 256 * j);
            y[4 * j] = bflo(w.x); y[4 * j + 1] = bfhi(w.x); y[4 * j + 2] = bflo(w.y); y[4 * j + 3] = bfhi(w.y);
            ss += y[4 * j] * y[4 * j] + y[4 * j + 1] * y[4 * j + 1] + y[4 * j + 2] * y[4 * j + 2] + y[4 * j + 3] * y[4 * j + 3];
        }
        const float rstd = rsqrtf(wave_sum(ss) * (1.f / DM) + EPS);
        f32x4 hn[4]; float ss2 = 0.f;
#pragma unroll
        for (int j = 0; j < 4; ++j) {
            const int c = 4 * lane + 256 * j;
            const f32x4 h = *(const f32x4*)(hsrc + c), gp = *(const f32x4*)(gpost + c), gt = *(const f32x4*)(md + gate_chunk * 1024 + c);
            const f32x4 yy = {y[4 * j], y[4 * j + 1], y[4 * j + 2], y[4 * j + 3]};
            hn[j] = h + gt * (yy * rstd * gp);
            *(f32x4*)(hdst + c) = hn[j];
            ss2 += hn[j].x * hn[j].x + hn[j].y * hn[j].y + hn[j].z * hn[j].z + hn[j].w * hn[j].w;
        }
        if (Udst) {
            const float rstd2 = rsqrtf(wave_sum(ss2) * (1.f / DM) + EPS);
            const float* md2 = modp(p, nlayer, m);
#pragma unroll
            for (int j = 0; j < 4; ++j) {
                const int c = 4 * lane + 256 * j;
                const f32x4 gg = *(const f32x4*)(g2 + c), sh = *(const f32x4*)(md2 + nshift_chunk * 1024 + c), scl = *(const f32x4*)(md2 + (nshift_chunk + 1) * 1024 + c);
                const f32x4 o = (hn[j] * rstd2 * gg) * (1.f + scl) + sh;
                u32x2 w; w.x = pk2(o.x, o.y); w.y = pk2(o.z, o.w);
                *(u32x2*)(Udst + (size_t)m * DM + c) = w;
            }
        }
    }
}

struct EpiSwiglu {
    static constexpr bool PERM = true, AFTER_DRAIN = false;
    bf16* O; int ldc;
    __device__ __forceinline__ void operator()(const pg8::f32x4 (&acc)[2][2][4][2], const pg8::Unit& u, int wr, int wc, int fr, int fq) const {
        const int row0 = u.pm * 256 + wr * 64 + fr; const int col0 = u.pn * 128 + wc * 32 + 8 * fq;
#pragma unroll
        for (int ai = 0; ai < 2; ++ai)
#pragma unroll
            for (int m = 0; m < 4; ++m) {
                bf16* rowp = O + (size_t)(row0 + ai * 128 + m * 16) * ldc + col0;
                const pg8::f32x4 g0 = acc[ai][0][m][0], g1 = acc[ai][0][m][1], u0 = acc[ai][1][m][0], u1 = acc[ai][1][m][1];
                u32x4 w;
                w.x = pk2(silu_f(g0[0]) * u0[0], silu_f(g0[1]) * u0[1]); w.y = pk2(silu_f(g0[2]) * u0[2], silu_f(g0[3]) * u0[3]);
                w.z = pk2(silu_f(g1[0]) * u1[0], silu_f(g1[1]) * u1[1]); w.w = pk2(silu_f(g1[2]) * u1[2], silu_f(g1[3]) * u1[3]);
                *(u32x4*)rowp = w;
            }
    }
};

DI void gemm_store(unsigned char* lds, const bf16* A, const bf16* Bt, int M, int N, int K, bf16* O, int ldc) {
    pg8::Gemm g{A, Bt, M, N, K}; pg8::StaticOrder S; S.init(M, N, (int)gridDim.x, (int)blockIdx.x);
    pg8::EpiBf16<0> E{O, ldc, nullptr, 0, 0, 1.f};
    pg8::gemm_phase<pg8::EpiBf16<0>, pg8::StaticOrder, true, true>((PG8_LAS unsigned char*)lds, g, S, E);
}
DI void gemm_swiglu(unsigned char* lds, const bf16* A, const bf16* Bt, int M, bf16* O) {
    pg8::Gemm g{A, Bt, M, 2 * DFF, DM}; pg8::StaticOrder S; S.init(M, 2 * DFF, (int)gridDim.x, (int)blockIdx.x);
    EpiSwiglu E{O, DFF};
    pg8::gemm_phase<EpiSwiglu, pg8::StaticOrder, true, true>((PG8_LAS unsigned char*)lds, g, S, E);
}

DI void phase_prep0(const KParams& p) {
    const int tid_ = tid_fresh(); const int lane = tid_ & 63, wave = tid_ >> 6;
    const int gw = blockIdx.x * NWAVES + wave, NGW = gridDim.x * NWAVES;
    const bf16* Z = (const bf16*)(p.ws + WS_Z);
    bf16* QKVC = (bf16*)p.out;
    float* GB = (float*)(p.ws + WS_GB);
    bf16* QN = (bf16*)(p.ws + WS_QN); bf16* KVN = (bf16*)(p.ws + WS_KVN); bf16* KPE = (bf16*)(p.ws + WS_KPE);
    const float* convw = p.in[15];
    float cw[3][5][8];
#pragma unroll
    for (int i = 0; i < 3; ++i)
#pragma unroll
        for (int j = 0; j < 5; ++j)
#pragma unroll
            for (int e = 0; e < 8; ++e) cw[i][j][e] = convw[j * 1536 + 8 * (lane + 64 * i) + e];
    const int rows_per_wave = (MT + NGW - 1) / NGW;
    for (int ri = 0; ri < rows_per_wave; ++ri) {
        const int m = gw * rows_per_wave + ri;
        if (m >= MT) break;
        int base, L, t;
        if (m < ML) { base = m & ~4095; L = 4096; t = m & 4095; } else { base = ML + ((m - ML) & ~255); L = 256; t = (m - ML) & 255; }
#pragma unroll
        for (int i = 0; i < 3; ++i) {
            float acc[8];
#pragma unroll
            for (int e = 0; e < 8; ++e) acc[e] = 0.f;
#pragma unroll
            for (int j = 0; j < 5; ++j) {
                const int pos = t + j - 2;
                if (pos >= 0 && pos < L) {
                    const u32x4 w = *(const u32x4*)(Z + (size_t)(base + pos) * NZ0 + ZQKV + 8 * (lane + 64 * i));
                    float f[8]; unpack8(w, f);
#pragma unroll
                    for (int e = 0; e < 8; ++e) acc[e] += cw[i][j][e] * f[e];
                }
            }
            float ss = 0.f;
#pragma unroll
            for (int e = 0; e < 8; ++e) { acc[e] = acc[e] / (1.f + __expf(-acc[e])); ss += acc[e] * acc[e]; }
            if (i < 2) {
                ss += __shfl_xor(ss, 1); ss += __shfl_xor(ss, 2); ss += __shfl_xor(ss, 4);
                const float inv = rsqrtf(ss + EPS) * (i == 0 ? 0.125f : 1.f);
#pragma unroll
                for (int e = 0; e < 8; ++e) acc[e] *= inv;
            }
            *(u32x4*)(QKVC + (size_t)m * 1536 + 8 * (lane + 64 * i)) = pack8(acc);
        }
        if (lane < 16) {
            const float a = bf2f(Z[(size_t)m * NZ0 + ZA + lane]), bt = bf2f(Z[(size_t)m * NZ0 + ZBT + lane]);
            const float g = -expf(p.in[16][lane]) * softplus_f(a + p.in[17][lane]);
            GB[(size_t)m * 32 + lane] = g;
            GB[(size_t)m * 32 + 16 + lane] = 1.f / (1.f + expf(-bt));
        }
        {
            float f[8]; float ss = 0.f;
            if (lane < 48) {
                const int col = lane < 32 ? ZQD + 8 * lane : ZKVD + 8 * (lane - 32);
                const u32x4 w = *(const u32x4*)(Z + (size_t)m * NZ0 + col);
                unpack8(w, f);
#pragma unroll
                for (int e = 0; e < 8; ++e) ss += f[e] * f[e];
            } else {
#pragma unroll
                for (int e = 0; e < 8; ++e) f[e] = 0.f;
            }
            const float sq = wave_sum(lane < 32 ? ss : 0.f), skv = wave_sum((lane >= 32 && lane < 48) ? ss : 0.f);
            if (lane < 32) {
                const float r = rsqrtf(sq * (1.f / 256.f) + EPS);
#pragma unroll
                for (int e = 0; e < 8; ++e) f[e] = f[e] * r * p.in[19][8 * lane + e];
                *(u32x4*)(QN + (size_t)m * 256 + 8 * lane) = pack8(f);
            } else if (lane < 48) {
                const float r = rsqrtf(skv * (1.f / 128.f) + EPS);
#pragma unroll
                for (int e = 0; e < 8; ++e) f[e] = f[e] * r * p.in[21][8 * (lane - 32) + e];
                *(u32x4*)(KVN + (size_t)m * 128 + 8 * (lane - 32)) = pack8(f);
            }
        }
        if (lane == 48 || lane == 49) {
            const int hh = lane - 48;
            float x1[8], x2[8];
            unpack8(*(const u32x4*)(Z + (size_t)m * NZ0 + ZKPE + 8 * hh), x1);
            unpack8(*(const u32x4*)(Z + (size_t)m * NZ0 + ZKPE + 16 + 8 * hh), x2);
            if (m < ML) {
                const float pos = (float)(hh ? (t & 63) : (t >> 6));
                const float invf[8] = {1.f, 0.31622776601683794f, 0.1f, 0.031622776601683794f, 0.01f, 0.0031622776601683794f, 0.001f, 0.00031622776601683794f};
#pragma unroll
                for (int e = 0; e < 8; ++e) {
                    float sn, cs; sincosf(pos * invf[e], &sn, &cs);
                    const float a = x1[e], b2 = x2[e];
                    x1[e] = a * cs - b2 * sn; x2[e] = b2 * cs + a * sn;
                }
            }
            *(u32x4*)(KPE + (size_t)m * 32 + 8 * hh) = pack8(x1);
            *(u32x4*)(KPE + (size_t)m * 32 + 16 + 8 * hh) = pack8(x2);
        }
    }
}

DI void phase_prep1(const KParams& p) {
    const int tid_ = tid_fresh(); const int lane = tid_ & 63, wave = tid_ >> 6;
    const int gw = blockIdx.x * NWAVES + wave, NGW = gridDim.x * NWAVES;
    const bf16* Z = (const bf16*)(p.ws + WS_Z);
    bf16* GQ = (bf16*)(p.ws + WS_GQ); bf16* GKK = (bf16*)(p.ws + WS_GKK);
    const float* qn = p.in[26]; const float* kn = p.in[27];
    const int q8 = lane & 7;
    float invf[8];
#pragma unroll
    for (int e = 0; e < 8; ++e) { const int i = (8 * (q8 & 3) + e) & 15; invf[e] = exp2f(-(float)i * (13.287712379549449f / 16.f)); }
    const bool use_col = (q8 & 3) >= 2;
    float gq[8], gk[8];
#pragma unroll
    for (int e = 0; e < 8; ++e) { gq[e] = qn[8 * q8 + e]; gk[e] = kn[8 * q8 + e]; }
    for (int m = gw; m < MT; m += NGW) {
        const bool lat = m < ML;
        const int t = m & 4095;
        float sn[8], cs[8];
        if (lat) {
            const float pos = (float)(use_col ? (t & 63) : (t >> 6));
#pragma unroll
            for (int e = 0; e < 8; ++e) sincosf(pos * invf[e], &sn[e], &cs[e]);
        }
#pragma unroll
        for (int pass = 0; pass < 2; ++pass) {
            if (pass == 0 && !lat) continue;
            const bool act = pass == 0 || lane < 16;
            float f[8]; float ss = 0.f;
            if (act) {
                const int col = pass == 0 ? Z1_GQ + 8 * lane : Z1_GK + 8 * lane;
                unpack8(*(const u32x4*)(Z + (size_t)m * NZ1 + col), f);
#pragma unroll
                for (int e = 0; e < 8; ++e) ss += f[e] * f[e];
            } else {
#pragma unroll
                for (int e = 0; e < 8; ++e) f[e] = 0.f;
            }
            ss += __shfl_xor(ss, 1); ss += __shfl_xor(ss, 2); ss += __shfl_xor(ss, 4);
            const float r = rsqrtf(ss * (1.f / 64.f) + EPS);
#pragma unroll
            for (int e = 0; e < 8; ++e) f[e] = f[e] * r * (pass == 0 ? gq[e] : gk[e]);
            if (lat) {
                float o[8];
#pragma unroll
                for (int e = 0; e < 8; ++e) {
                    const float other = __shfl_xor(f[e], 4);
                    o[e] = (q8 < 4) ? f[e] * cs[e] - other * sn[e] : f[e] * cs[e] + other * sn[e];
                }
#pragma unroll
                for (int e = 0; e < 8; ++e) f[e] = o[e];
            }
            if (act) {
                if (pass == 0) *(u32x4*)(GQ + (size_t)m * 512 + 8 * lane) = pack8(f);
                else *(u32x4*)(GKK + (size_t)m * 128 + 8 * lane) = pack8(f);
            }
        }
    }
}

DI void phase_gdn_combine(const KParams& p) {
    const int tid_ = tid_fresh(); const int lane = tid_ & 63, wave = tid_ >> 6;
    const int gw = blockIdx.x * NWAVES + wave, NGW = gridDim.x * NWAVES;
    const bf16* Z = (const bf16*)(p.ws + WS_Z);
    const bf16* OF = (const bf16*)(p.ws + WS_OF); const bf16* OB = (const bf16*)(p.ws + WS_OB);
    bf16* MIX = (bf16*)(p.ws + WS_U);
    float on[8];
#pragma unroll
    for (int e = 0; e < 8; ++e) on[e] = p.in[18][8 * (lane & 7) + e];
    for (int m = gw; m < MT; m += NGW) {
        float a[8], b2[8], g[8];
        unpack8(*(const u32x4*)(OF + (size_t)m * 512 + 8 * lane), a);
        unpack8(*(const u32x4*)(OB + (size_t)m * 512 + 8 * lane), b2);
        unpack8(*(const u32x4*)(Z + (size_t)m * NZ0 + ZGATE + 8 * lane), g);
        float ss = 0.f;
#pragma unroll
        for (int e = 0; e < 8; ++e) { a[e] += b2[e]; ss += a[e] * a[e]; }
        ss += __shfl_xor(ss, 1); ss += __shfl_xor(ss, 2); ss += __shfl_xor(ss, 4);
        const float r = rsqrtf(ss * (1.f / 64.f) + EPS);
#pragma unroll
        for (int e = 0; e < 8; ++e) a[e] = a[e] * r * on[e] * (g[e] / (1.f + __expf(-g[e])));
        *(u32x4*)(MIX + (size_t)m * DM + 8 * lane) = pack8(a);
    }
}

template <int MODE> struct AttnCfg { static constexpr int DQK = (MODE <= 1) ? 96 : 64; };

template <int MODE>
DI void attn_unit(const KParams& p, int b, int h, int qb, unsigned char* lds) {
    constexpr int DQK = AttnCfg<MODE>::DQK, NS = DQK / 16;
    constexpr int KP = DQK * 2 + 16;
    constexpr int VP = 64 * 2 + 16;
    constexpr int KBUF = 64 * KP, VBUF = 64 * VP, BUF = KBUF + VBUF;
    constexpr int KCH = DQK / 8;
    const int tid = tid_fresh(), lane = tid & 63, wid = tid >> 6, r32 = lane & 31, hi = lane >> 5;
    float* rpbL = (float*)(lds + 2 * BUF);

    int mq;
    int qr = 0, qc = 0;
    if (MODE == 0 || MODE == 2) mq = b * 4096 + qb * 256 + wid * 32 + r32;
    else if (MODE == 1) mq = ML + b * 256 + wid * 32 + r32;
    else { qr = 4 * qb + (wid >> 1); qc = 32 * (wid & 1) + r32; mq = b * 4096 + qr * 64 + qc; }
    const bf16* Qp; float sl2;
    if (MODE <= 1) { Qp = (const bf16*)(p.ws + WS_QMLA) + (size_t)mq * 768 + h * 96; sl2 = 0.10206207261596577f * LOG2E; }
    else if (MODE == 2) { Qp = (const bf16*)(p.ws + WS_GQ) + (size_t)mq * 512 + h * 64; sl2 = 0.125f * LOG2E; }
    else { Qp = (const bf16*)(p.ws + WS_Z) + (size_t)mq * NZ1 + Z1_NAQ + h * 64; sl2 = 0.125f * LOG2E; }
    bf16x8 qf[NS];
#pragma unroll
    for (int s = 0; s < NS; ++s) qf[s] = *(const bf16x8*)(Qp + 16 * s + 8 * hi);
    if (MODE == 0) {
        const int t = mq & 4095; const float pos = (float)(hi ? (t & 63) : (t >> 6));
        const float invf[8] = {1.f, 0.31622776601683794f, 0.1f, 0.031622776601683794f, 0.01f, 0.0031622776601683794f, 0.001f, 0.00031622776601683794f};
        float x1[8], x2[8];
        unpack8(__builtin_bit_cast(u32x4, qf[4]), x1); unpack8(__builtin_bit_cast(u32x4, qf[5]), x2);
#pragma unroll
        for (int e = 0; e < 8; ++e) { float sn, cs; sincosf(pos * invf[e], &sn, &cs); const float a = x1[e], c2 = x2[e]; x1[e] = a * cs - c2 * sn; x2[e] = c2 * cs + a * sn; }
        qf[4] = __builtin_bit_cast(bf16x8, pack8(x1)); qf[5] = __builtin_bit_cast(bf16x8, pack8(x2));
    }
    int NT, kr_lo = 0;
    if (MODE == 0 || MODE == 2) NT = 68; else if (MODE == 1) NT = 4;
    else { kr_lo = 4 * qb - 4; if (kr_lo < 0) kr_lo = 0; int last = 4 * qb - 1; if (last < 0) last = 0; if (last > 56) last = 56; NT = 4 + (last + 7 - kr_lo + 1); }
    int rs = 0, cs0 = 0;
    if (MODE == 3) {
        rs = qr - 4; if (rs < 0) rs = 0; if (rs > 56) rs = 56;
        cs0 = qc - 8; if (cs0 < 0) cs0 = 0; if (cs0 > 48) cs0 = 48;
        for (int i = tid; i < 15 * 31; i += NTHREADS) rpbL[i] = p.in[25][h * 465 + i] * LOG2E;
    }
    const int kkey0 = tid / KCH, kpart0 = tid % KCH;
    const int kkey1 = (tid + 512) / KCH, kpart1 = (tid + 512) % KCH;
    const bool k1act = (KCH == 12) && (tid + 512 < 64 * KCH);
    const int vkey = tid >> 3, vpart = tid & 7;
    auto keyrow = [&](int t, int i) -> int {
        if (t < 4) return ML + b * 256 + 64 * t + i;
        if (MODE == 3) return b * 4096 + (kr_lo + t - 4) * 64 + i;
        return b * 4096 + 64 * (t - 4) + i;
    };
    auto kchunk = [&](int row, int part) -> u32x4 {
        if (MODE <= 1) {
            if (part < 8) return *(const u32x4*)((const bf16*)(p.ws + WS_KVMLA) + (size_t)row * 1024 + h * 128 + 8 * part);
            return *(const u32x4*)((const bf16*)(p.ws + WS_KPE) + (size_t)row * 32 + 8 * (part - 8));
        } else if (MODE == 2) return *(const u32x4*)((const bf16*)(p.ws + WS_GKK) + (size_t)row * 128 + (h >> 2) * 64 + 8 * part);
        else return *(const u32x4*)((const bf16*)(p.ws + WS_Z) + (size_t)row * NZ1 + Z1_NAK + h * 64 + 8 * part);
    };
    auto vchunk = [&](int row, int part) -> u32x4 {
        if (MODE <= 1) return *(const u32x4*)((const bf16*)(p.ws + WS_KVMLA) + (size_t)row * 1024 + h * 128 + 64 + 8 * part);
        else if (MODE == 2) return *(const u32x4*)((const bf16*)(p.ws + WS_Z) + (size_t)row * NZ1 + Z1_GV + (h >> 2) * 64 + 8 * part);
        else return *(const u32x4*)((const bf16*)(p.ws + WS_Z) + (size_t)row * NZ1 + Z1_NAV + h * 64 + 8 * part);
    };
    u32x4 rk0, rk1 = {0u, 0u, 0u, 0u}, rv;
    auto load_tile = [&](int t) {
        rk0 = kchunk(keyrow(t, kkey0), kpart0);
        if (k1act) rk1 = kchunk(keyrow(t, kkey1), kpart1);
        rv = vchunk(keyrow(t, vkey), vpart);
    };
    auto write_tile = [&](int buf) {
        unsigned char* kb = lds + buf * BUF; unsigned char* vb = kb + KBUF;
        *(u32x4*)(kb + kkey0 * KP + kpart0 * 16) = rk0;
        if (k1act) *(u32x4*)(kb + kkey1 * KP + kpart1 * 16) = rk1;
        const unsigned w[4] = {rv.x, rv.y, rv.z, rv.w};
#pragma unroll
        for (int e = 0; e < 4; ++e) {
            *(bf16*)(vb + (8 * vpart + 2 * e) * VP + vkey * 2) = (bf16)(w[e] & 0xffffu);
            *(bf16*)(vb + (8 * vpart + 2 * e + 1) * VP + vkey * 2) = (bf16)(w[e] >> 16);
        }
    };
    f32x16 o0, o1;
#pragma unroll
    for (int r = 0; r < 16; ++r) { o0[r] = 0.f; o1[r] = 0.f; }
    float m_run = -INFINITY, l_run = 0.f;

    __syncthreads();
    load_tile(0); write_tile(0);
    __syncthreads();
    for (int t = 0; t < NT; ++t) {
        const int buf = t & 1;
        if (t + 1 < NT) load_tile(t + 1);
        bool active = true; int kr = 0;
        if (MODE == 3 && t >= 4) { kr = kr_lo + t - 4; active = (kr >= rs) && (kr <= rs + 7); }
        if (active) {
            const unsigned char* kb = lds + buf * BUF; const unsigned char* vb = kb + KBUF;
            f32x16 sa[2];
#pragma unroll
            for (int kt = 0; kt < 2; ++kt) {
#pragma unroll
                for (int r = 0; r < 16; ++r) sa[kt][r] = 0.f;
#pragma unroll
                for (int s = 0; s < NS; ++s) {
                    const bf16x8 kf = *(const bf16x8*)(kb + (32 * kt + r32) * KP + (16 * s + 8 * hi) * 2);
                    sa[kt] = __builtin_amdgcn_mfma_f32_32x32x16_bf16(kf, qf[s], sa[kt], 0, 0, 0);
                }
            }
            float mloc = -INFINITY;
#pragma unroll
            for (int kt = 0; kt < 2; ++kt)
#pragma unroll
                for (int r = 0; r < 16; ++r) {
                    float x = sa[kt][r] * sl2;
                    if (MODE == 3 && t >= 4) {
                        const int kc = 32 * kt + crow(r, hi);
                        const bool inw = (kc >= cs0) && (kc <= cs0 + 15);
                        const int bi = (kr - qr + 7) * 31 + (kc - qc + 15);
                        x = inw ? x + rpbL[inw ? bi : 0] : -INFINITY;
                    }
                    sa[kt][r] = x; mloc = fmaxf(mloc, x);
                }
            mloc = fmaxf(mloc, __shfl_xor(mloc, 32));
            const float m_new = fmaxf(m_run, mloc);
            const float alpha = __builtin_amdgcn_exp2f(m_run - m_new);
            m_run = m_new;
            float psum = 0.f;
#pragma unroll
            for (int kt = 0; kt < 2; ++kt)
#pragma unroll
                for (int r = 0; r < 16; ++r) { const float pv = __builtin_amdgcn_exp2f(sa[kt][r] - m_new); sa[kt][r] = pv; psum += pv; }
            l_run = l_run * alpha + psum;
#pragma unroll
            for (int r = 0; r < 16; ++r) { o0[r] *= alpha; o1[r] *= alpha; }
#pragma unroll
            for (int kt = 0; kt < 2; ++kt)
#pragma unroll
                for (int s = 0; s < 2; ++s) {
                    u32x4 pw;
                    pw.x = pk2(sa[kt][8 * s + 0], sa[kt][8 * s + 1]); pw.y = pk2(sa[kt][8 * s + 2], sa[kt][8 * s + 3]);
                    pw.z = pk2(sa[kt][8 * s + 4], sa[kt][8 * s + 5]); pw.w = pk2(sa[kt][8 * s + 6], sa[kt][8 * s + 7]);
                    const bf16x8 pf = __builtin_bit_cast(bf16x8, pw);
                    const int koff = (32 * kt + 16 * s + 4 * hi) * 2;
                    const u32x2 a0 = *(const u32x2*)(vb + r32 * VP + koff), a1 = *(const u32x2*)(vb + r32 * VP + koff + 16);
                    const u32x2 c0 = *(const u32x2*)(vb + (32 + r32) * VP + koff), c1 = *(const u32x2*)(vb + (32 + r32) * VP + koff + 16);
                    const u32x4 va = {a0.x, a0.y, a1.x, a1.y}, vc = {c0.x, c0.y, c1.x, c1.y};
                    o0 = __builtin_amdgcn_mfma_f32_32x32x16_bf16(__builtin_bit_cast(bf16x8, va), pf, o0, 0, 0, 0);
                    o1 = __builtin_amdgcn_mfma_f32_32x32x16_bf16(__builtin_bit_cast(bf16x8, vc), pf, o1, 0, 0, 0);
                }
        }
        if (t + 1 < NT) write_tile(buf ^ 1);
        __syncthreads();
    }
    const float l = l_run + __shfl_xor(l_run, 32);
    const float il = 1.f / l;
    bf16* Op;
    if (MODE == 3) Op = (bf16*)(p.ws + WS_U) + (size_t)mq * DM + h * 64;
    else Op = (bf16*)(p.ws + WS_U) + (size_t)mq * DM + 512 + h * 64;
#pragma unroll
    for (int g = 0; g < 4; ++g) {
        u32x2 w0, w1;
        w0.x = pk2(o0[4 * g] * il, o0[4 * g + 1] * il); w0.y = pk2(o0[4 * g + 2] * il, o0[4 * g + 3] * il);
        w1.x = pk2(o1[4 * g] * il, o1[4 * g + 1] * il); w1.y = pk2(o1[4 * g + 2] * il, o1[4 * g + 3] * il);
        *(u32x2*)(Op + 8 * g + 4 * hi) = w0;
        *(u32x2*)(Op + 32 + 8 * g + 4 * hi) = w1;
    }
}

DI void phase_attn0(const KParams& p, unsigned char* lds) {
    const int G = gridDim.x; const int vcu = (G % 8 == 0) ? (blockIdx.x % 8) * (G / 8) + blockIdx.x / 8 : blockIdx.x;
    for (int u = vcu; u < 64 * 17; u += G) {
        const int bh = u / 17, j = u % 17;
        if (j < 16) attn_unit<0>(p, bh >> 3, bh & 7, j, lds);
        else attn_unit<1>(p, bh >> 3, bh & 7, 0, lds);
    }
}
DI void phase_attn1(const KParams& p, unsigned char* lds) {
    const int G = gridDim.x; const int vcu = (G % 8 == 0) ? (blockIdx.x % 8) * (G / 8) + blockIdx.x / 8 : blockIdx.x;
    for (int u = vcu; u < 1024; u += G) { const int bh = u >> 4, j = u & 15; attn_unit<2>(p, bh >> 3, bh & 7, j, lds); }
    for (int u = vcu; u < 1024; u += G) { const int bh = u >> 4, j = u & 15; attn_unit<3>(p, bh >> 3, bh & 7, j, lds); }
}

DI int gdn_row(int b, int dir, int ci, int i) {
    if (ci < 4) { int s = 64 * ci + i; if (dir) s = 255 - s; return ML + b * 256 + s; }
    int t = 64 * (ci - 4) + i; if (dir) t = 4095 - t; return b * 4096 + t;
}
DI float wave_incl_scan(float x, int lane) {
#pragma unroll
    for (int off = 1; off < 64; off <<= 1) { const float v = __shfl_up(x, off); if (lane >= off) x += v; }
    return x;
}

DI void phase_tinv(const KParams& p, unsigned char* lds) {
    const int tid_ = tid_fresh(); const int lane = tid_ & 63, wave = tid_ >> 6, r32 = lane & 31, hi = lane >> 5;
    const int gw = blockIdx.x * NWAVES + wave, NGW = gridDim.x * NWAVES;
    float* Mw = (float*)(lds + wave * 17408);
    float* gcs = Mw + 4096; float* bts = gcs + 64;
    const bf16* QKVC = (const bf16*)p.out;
    const float* GB = (const float*)(p.ws + WS_GB);
    bf16* TINV = (bf16*)(p.ws + WS_TINV);
    for (int inst = gw; inst < 8704; inst += NGW) {
        const int ci = inst % 68, bhd = inst / 68, dir = bhd & 1, h = (bhd >> 1) & 7, b = bhd >> 4;
        const int mi = gdn_row(b, dir, ci, lane);
        const float gi = GB[(size_t)mi * 32 + dir * 8 + h], bi = GB[(size_t)mi * 32 + 16 + dir * 8 + h];
        const float gc = wave_incl_scan(gi, lane);
        gcs[lane] = gc; bts[lane] = bi;
        bf16x8 kf[2][4];
#pragma unroll
        for (int a = 0; a < 2; ++a) {
            const int mt = gdn_row(b, dir, ci, 32 * a + r32);
#pragma unroll
            for (int s = 0; s < 4; ++s) kf[a][s] = *(const bf16x8*)(QKVC + (size_t)mt * 1536 + 512 + h * 64 + 16 * s + 8 * hi);
        }
        f32x16 g00, g10, g11;
#pragma unroll
        for (int r = 0; r < 16; ++r) { g00[r] = 0.f; g10[r] = 0.f; g11[r] = 0.f; }
#pragma unroll
        for (int s = 0; s < 4; ++s) {
            g00 = __builtin_amdgcn_mfma_f32_32x32x16_bf16(kf[0][s], kf[0][s], g00, 0, 0, 0);
            g10 = __builtin_amdgcn_mfma_f32_32x32x16_bf16(kf[1][s], kf[0][s], g10, 0, 0, 0);
            g11 = __builtin_amdgcn_mfma_f32_32x32x16_bf16(kf[1][s], kf[1][s], g11, 0, 0, 0);
        }
        asm volatile("s_waitcnt lgkmcnt(0)" ::: "memory");
#pragma unroll
        for (int r = 0; r < 16; ++r) {
            const int i0 = crow(r, hi), i1 = 32 + i0;
            const int j0 = r32, j1 = 32 + r32;
            Mw[i0 * 64 + j0] = (i0 > j0) ? bts[i0] * g00[r] * __expf(gcs[i0] - gcs[j0]) : 0.f;
            Mw[i1 * 64 + j0] = bts[i1] * g10[r] * __expf(gcs[i1] - gcs[j0]);
            Mw[i1 * 64 + j1] = (i1 > j1) ? bts[i1] * g11[r] * __expf(gcs[i1] - gcs[j1]) : 0.f;
        }
        asm volatile("s_waitcnt lgkmcnt(0)" ::: "memory");
        float T[64];
#pragma unroll
        for (int i = 0; i < 64; ++i) {
            float a0 = (lane == i) ? 1.f : 0.f, a1 = 0.f, a2 = 0.f, a3 = 0.f;
#pragma unroll
            for (int jq = 0; jq < (i + 3) / 4; ++jq) {
                const f32x4 mv = *(const f32x4*)(Mw + i * 64 + 4 * jq);
                if (4 * jq + 0 < i) a0 -= mv.x * T[4 * jq + 0];
                if (4 * jq + 1 < i) a1 -= mv.y * T[4 * jq + 1];
                if (4 * jq + 2 < i) a2 -= mv.z * T[4 * jq + 2];
                if (4 * jq + 3 < i) a3 -= mv.w * T[4 * jq + 3];
            }
            T[i] = (a0 + a1) + (a2 + a3);
        }
        asm volatile("s_waitcnt lgkmcnt(0)" ::: "memory");
        bf16* Tb = (bf16*)Mw;
#pragma unroll
        for (int i = 0; i < 64; ++i) Tb[i * 64 + lane] = f2bf(T[i]);
        asm volatile("s_waitcnt lgkmcnt(0)" ::: "memory");
#pragma unroll
        for (int q = 0; q < 8; ++q) {
            const u32x4 v = *(const u32x4*)(Tb + (q * 64 + lane) * 8);
            *(u32x4*)(TINV + (size_t)inst * 4096 + (q * 64 + lane) * 8) = v;
        }
        asm volatile("s_waitcnt lgkmcnt(0)" ::: "memory");
    }
}

constexpr int GP = 144;
constexpr int GIMG = 64 * GP;
constexpr int G_Q = 0, G_K = GIMG, G_T = 2 * GIMG, G_KBGT = 3 * GIMG, G_KDT = 4 * GIMG, G_VBT = 5 * GIMG, G_W = 6 * GIMG, G_QK = 7 * GIMG;
constexpr int G_VNT = 8 * GIMG;
constexpr int G_ST = G_VNT + 4 * 2304;
constexpr int G_ARR = G_ST + 4 * 2304;

DI bf16x8 ldsfrag(const unsigned char* base, int row, int colbyte) { return *(const bf16x8*)(base + row * GP + colbyte); }

DI void gdn_scan_unit(const KParams& p, int b, int h, int dir, unsigned char* lds) {
    typedef float f32x4v __attribute__((ext_vector_type(4)));
    const int tid = tid_fresh(), lane = tid & 63, wid = tid >> 6, l15 = lane & 15, lq = lane >> 4;
    const bf16* QKVC = (const bf16*)p.out;
    const float* GB = (const float*)(p.ws + WS_GB);
    const bf16* TINV = (const bf16*)(p.ws + WS_TINV);
    bf16* OUT = (bf16*)(p.ws + (dir ? WS_OB : WS_OF));
    float* gcA = (float*)(lds + G_ARR); float* btA = gcA + 64; float* egA = btA + 64;
    const int sj = tid >> 3, sp = tid & 7;
    const size_t inst0 = (size_t)((b * 8 + h) * 2 + dir) * 68;
    if (wid < 4) { for (int i = lane; i < 2304 / 4; i += 64) ((unsigned*)(lds + G_ST + wid * 2304))[i] = 0u; }
    f32x4v sacc[4];
#pragma unroll
    for (int mt = 0; mt < 4; ++mt) sacc[mt] = (f32x4v){0.f, 0.f, 0.f, 0.f};
    u32x4 rq, rk, rv, rt; float rg, rb;
    auto prefetch = [&](int ci) {
        const int mj = gdn_row(b, dir, ci, sj);
        const bf16* src = QKVC + (size_t)mj * 1536 + h * 64 + 8 * sp;
        rq = *(const u32x4*)(src); rk = *(const u32x4*)(src + 512); rv = *(const u32x4*)(src + 1024);
        rt = *(const u32x4*)(TINV + (inst0 + ci) * 4096 + sj * 64 + 8 * sp);
        const int mi = gdn_row(b, dir, ci, lane);
        rg = GB[(size_t)mi * 32 + dir * 8 + h]; rb = GB[(size_t)mi * 32 + 16 + dir * 8 + h];
    };
    prefetch(0);
    __syncthreads();
    for (int ci = 0; ci < 68; ++ci) {
        const float gsc = wave_incl_scan(rg, lane);
        const float gcj = __shfl(gsc, sj), btj = __shfl(rb, sj), gcl = __shfl(gsc, 63);
        *(u32x4*)(lds + G_Q + sj * GP + sp * 16) = rq;
        *(u32x4*)(lds + G_K + sj * GP + sp * 16) = rk;
        *(u32x4*)(lds + G_T + sj * GP + sp * 16) = rt;
        {
            float kf8[8], vf8[8]; unpack8(rk, kf8); unpack8(rv, vf8);
            const float ekb = btj * __expf(gcj), ekd = __expf(gcl - gcj);
#pragma unroll
            for (int e = 0; e < 8; ++e) {
                *(bf16*)(lds + G_KBGT + (8 * sp + e) * GP + sj * 2) = f2bf(kf8[e] * ekb);
                *(bf16*)(lds + G_KDT + (8 * sp + e) * GP + sj * 2) = f2bf(kf8[e] * ekd);
                *(bf16*)(lds + G_VBT + (8 * sp + e) * GP + sj * 2) = f2bf(vf8[e] * btj);
            }
        }
        if (wid == 0) { gcA[lane] = gsc; btA[lane] = rb; egA[lane] = __expf(gsc); }
        const float gl = __expf(gcl);
        __syncthreads();
        if (ci + 1 < 68) prefetch(ci + 1);
        {
            const int mt = wid & 3;
            const unsigned char* Abase = lds + (wid < 4 ? G_T : G_Q);
            const unsigned char* Bbase = lds + (wid < 4 ? G_KBGT : G_K);
            const bf16x8 a0 = ldsfrag(Abase, 16 * mt + l15, 16 * lq), a1 = ldsfrag(Abase, 16 * mt + l15, 64 + 16 * lq);
#pragma unroll
            for (int nt = 0; nt < 4; ++nt) {
                f32x4v acc = {0.f, 0.f, 0.f, 0.f};
                if (wid < 4 || nt <= mt) {
                    const bf16x8 b0 = ldsfrag(Bbase, 16 * nt + l15, 16 * lq), b1 = ldsfrag(Bbase, 16 * nt + l15, 64 + 16 * lq);
                    acc = __builtin_amdgcn_mfma_f32_16x16x32_bf16(a0, b0, acc, 0, 0, 0);
                    acc = __builtin_amdgcn_mfma_f32_16x16x32_bf16(a1, b1, acc, 0, 0, 0);
                }
                const int col = 16 * nt + l15;
                if (wid < 4) {
#pragma unroll
                    for (int r = 0; r < 4; ++r) *(bf16*)(lds + G_W + (16 * mt + 4 * lq + r) * GP + col * 2) = f2bf(-acc[r]);
                } else {
#pragma unroll
                    for (int r = 0; r < 4; ++r) {
                        const int i = 16 * mt + 4 * lq + r;
                        const float v = (i >= col) ? acc[r] * __expf(gcA[i] - gcA[col]) : 0.f;
                        *(bf16*)(lds + G_QK + i * GP + col * 2) = f2bf(v);
                    }
                }
            }
        }
        __syncthreads();
        if (wid < 4) {
            unsigned char* vnT = lds + G_VNT + wid * 2304; unsigned char* sT = lds + G_ST + wid * 2304;
            const bf16x8 vb0 = ldsfrag(lds + G_VBT, 16 * wid + l15, 16 * lq), vb1 = ldsfrag(lds + G_VBT, 16 * wid + l15, 64 + 16 * lq);
            const bf16x8 s0 = ldsfrag(sT, l15, 16 * lq), s1 = ldsfrag(sT, l15, 64 + 16 * lq);
            f32x4v vn[4], oo[4];
#pragma unroll
            for (int mt = 0; mt < 4; ++mt) {
                const bf16x8 t0 = ldsfrag(lds + G_T, 16 * mt + l15, 16 * lq), t1 = ldsfrag(lds + G_T, 16 * mt + l15, 64 + 16 * lq);
                const bf16x8 w0 = ldsfrag(lds + G_W, 16 * mt + l15, 16 * lq), w1 = ldsfrag(lds + G_W, 16 * mt + l15, 64 + 16 * lq);
                const bf16x8 q0 = ldsfrag(lds + G_Q, 16 * mt + l15, 16 * lq), q1 = ldsfrag(lds + G_Q, 16 * mt + l15, 64 + 16 * lq);
                f32x4v u = {0.f, 0.f, 0.f, 0.f};
                u = __builtin_amdgcn_mfma_f32_16x16x32_bf16(t0, vb0, u, 0, 0, 0);
                u = __builtin_amdgcn_mfma_f32_16x16x32_bf16(t1, vb1, u, 0, 0, 0);
                u = __builtin_amdgcn_mfma_f32_16x16x32_bf16(w0, s0, u, 0, 0, 0);
                u = __builtin_amdgcn_mfma_f32_16x16x32_bf16(w1, s1, u, 0, 0, 0);
                vn[mt] = u;
                f32x4v o = {0.f, 0.f, 0.f, 0.f};
                o = __builtin_amdgcn_mfma_f32_16x16x32_bf16(q0, s0, o, 0, 0, 0);
                o = __builtin_amdgcn_mfma_f32_16x16x32_bf16(q1, s1, o, 0, 0, 0);
#pragma unroll
                for (int r = 0; r < 4; ++r) o[r] *= egA[16 * mt + 4 * lq + r];
                oo[mt] = o;
                u32x2 w; w.x = pk2(u[0], u[1]); w.y = pk2(u[2], u[3]);
                *(u32x2*)(vnT + l15 * GP + (16 * mt + 4 * lq) * 2) = w;
            }
            asm volatile("s_waitcnt lgkmcnt(0)" ::: "memory");
            const bf16x8 n0 = ldsfrag(vnT, l15, 16 * lq), n1 = ldsfrag(vnT, l15, 64 + 16 * lq);
#pragma unroll
            for (int mt = 0; mt < 4; ++mt) {
                const bf16x8 a0 = ldsfrag(lds + G_QK, 16 * mt + l15, 16 * lq), a1 = ldsfrag(lds + G_QK, 16 * mt + l15, 64 + 16 * lq);
                f32x4v o = oo[mt];
                o = __builtin_amdgcn_mfma_f32_16x16x32_bf16(a0, n0, o, 0, 0, 0);
                o = __builtin_amdgcn_mfma_f32_16x16x32_bf16(a1, n1, o, 0, 0, 0);
#pragma unroll
                for (int r = 0; r < 4; ++r) {
                    const int mi = gdn_row(b, dir, ci, 16 * mt + 4 * lq + r);
                    OUT[(size_t)mi * 512 + h * 64 + 16 * wid + l15] = f2bf(o[r]);
                }
                const bf16x8 d0 = ldsfrag(lds + G_KDT, 16 * mt + l15, 16 * lq), d1 = ldsfrag(lds + G_KDT, 16 * mt + l15, 64 + 16 * lq);
                f32x4v sn = sacc[mt] * gl;
                sn = __builtin_amdgcn_mfma_f32_16x16x32_bf16(d0, n0, sn, 0, 0, 0);
                sn = __builtin_amdgcn_mfma_f32_16x16x32_bf16(d1, n1, sn, 0, 0, 0);
                sacc[mt] = sn;
            }
#pragma unroll
            for (int mt = 0; mt < 4; ++mt) {
                u32x2 w; w.x = pk2(sacc[mt][0], sacc[mt][1]); w.y = pk2(sacc[mt][2], sacc[mt][3]);
                *(u32x2*)(sT + l15 * GP + (16 * mt + 4 * lq) * 2) = w;
            }
        }
        __syncthreads();
    }
}

DI void phase_gdn_scan(const KParams& p, unsigned char* lds) {
    for (int u = blockIdx.x; u < 128; u += gridDim.x) gdn_scan_unit(p, u >> 4, (u >> 1) & 7, u & 1, lds);
}

#ifndef PHMASK
#define PHMASK 0xffffffffu
#endif
typedef const __attribute__((address_space(4))) KParams* KArgPtr;
DI KParams load_params(KArgPtr kp) {
    KParams p;
#pragma unroll
    for (int i = 0; i < 28; ++i) p.in[i] = kp->in[i];
    p.out = kp->out; p.ws = kp->ws; return p;
}
__global__ void __launch_bounds__(NTHREADS, 2) fwd_megakernel(KParams p_unused) {
    extern __shared__ __attribute__((aligned(16))) unsigned char lds[];
    cg::grid_group grid = cg::this_grid();
    KArgPtr kp0 = (KArgPtr)__builtin_amdgcn_kernarg_segment_ptr();
#define SYNC() grid.sync()
#define PH(n, ...) if ((PHMASK >> (n)) & 1u) { KArgPtr kp = kp0; asm volatile("" : "+s"(kp)); const KParams p = load_params(kp); unsigned char* ws = p.ws; \
        bf16* U = (bf16*)(ws + WS_U); bf16* Zb = (bf16*)(ws + WS_Z); bf16* Yb = (bf16*)(ws + WS_Y); (void)U; (void)Zb; (void)Yb; __VA_ARGS__; }

    PH(0, phase_prologue(p, lds))
    SYNC();
    PH(1, phase_modnorm0(p))
    SYNC();
    PH(2, gemm_store(lds, U, (const bf16*)(ws + WS_WIN0), MT, NZ0, DM, Zb, NZ0))
    SYNC();
    PH(3, phase_prep0(p))
    SYNC();
    PH(4, gemm_store(lds, (const bf16*)(ws + WS_QN), (const bf16*)(ws + WS_WQUP), MT, 768, 256, (bf16*)(ws + WS_QMLA), 768))
    PH(5, gemm_store(lds, (const bf16*)(ws + WS_KVN), (const bf16*)(ws + WS_WKVUP), MT, 1024, 128, (bf16*)(ws + WS_KVMLA), 1024))
    SYNC();
    PH(6, phase_attn0(p, lds))
    SYNC();
    PH(7, phase_tinv(p, lds))
    SYNC();
    PH(8, phase_gdn_scan(p, lds))
    SYNC();
    PH(9, phase_gdn_combine(p))
    SYNC();
    PH(10, gemm_store(lds, U, (const bf16*)(ws + WS_WOUT0), MT, DM, DM, Yb, DM))
    SYNC();
    PH(11, phase_post(p, MT, Yb, 1, 0, 2, p.in[7], p.in[8], 0, 3, U, true))
    SYNC();
    PH(12, gemm_swiglu(lds, U, (const bf16*)(ws + WS_WGU0), MT, Zb))
    SYNC();
    PH(13, gemm_store(lds, Zb, (const bf16*)(ws + WS_WDN0), MT, DM, DFF, Yb, DM))
    SYNC();
    PH(14, phase_post(p, MT, Yb, 0, 0, 5, p.in[9], p.in[6] + 1024, 1, 0, U, true))
    SYNC();
    PH(15, gemm_store(lds, U, (const bf16*)(ws + WS_WIN1), MT, NZ1, DM, Zb, NZ1))
    SYNC();
    PH(16, phase_prep1(p))
    SYNC();
    PH(17, phase_attn1(p, lds))
    SYNC();
    PH(18, gemm_store(lds, U, (const bf16*)(ws + WS_WOUT1), ML, DM, DM, Yb, DM))
    SYNC();
    PH(19, phase_post(p, ML, Yb, 0, 1, 2, p.in[7] + 1024, p.in[8] + 1024, 1, 3, U, false))
    SYNC();
    PH(20, gemm_swiglu(lds, U, (const bf16*)(ws + WS_WGU1), ML, Zb))
    SYNC();
    PH(21, gemm_store(lds, Zb, (const bf16*)(ws + WS_WDN1), ML, DM, DFF, Yb, DM))
    SYNC();
    PH(22, phase_post(p, ML, Yb, 0, 1, 5, p.in[9] + 1024, nullptr, 1, 0, nullptr, false))
#undef SYNC
#undef PH
}

extern "C" void kernel_launch(void* const* d_in, const int* in_sizes, int n_in, void* d_out, int out_size,
                              void* d_ws, size_t ws_size, hipStream_t stream) {
    static int grid_blocks = 0;
    if (grid_blocks == 0) {
        int dev = 0, cus = 0, per_cu = 0;
        (void)hipGetDevice(&dev);
        (void)hipDeviceGetAttribute(&cus, hipDeviceAttributeMultiprocessorCount, dev);
        (void)hipFuncSetAttribute((const void*)fwd_megakernel, hipFuncAttributeMaxDynamicSharedMemorySize, LDS_BYTES);
        (void)hipOccupancyMaxActiveBlocksPerMultiprocessor(&per_cu, (const void*)fwd_megakernel, NTHREADS, LDS_BYTES);
        if (per_cu < 1) { fprintf(stderr, "kernel_launch: occupancy query says %d blocks/CU\n", per_cu); per_cu = 1; }
        grid_blocks = cus;
        if (n_in != 28 || ws_size < WS_END) fprintf(stderr, "kernel_launch: unexpected n_in %d / ws_size %zu (need %zu)\n", n_in, ws_size, (size_t)WS_END);
    }
    KParams p{};
    for (int i = 0; i < 28; ++i) p.in[i] = (const float*)d_in[i];
    p.out = (float*)d_out; p.ws = (unsigned char*)d_ws;
    void* args[] = {&p};
    hipError_t e = hipLaunchCooperativeKernel((void*)fwd_megakernel, dim3(grid_blocks), dim3(NTHREADS), args, LDS_BYTES, stream);
    if (e != hipSuccess) fprintf(stderr, "cooperative launch failed: %s (grid %d)\n", hipGetErrorString(e), grid_blocks);
}
```

```cpp
#include <hip/hip_runtime.h>
#include <hip/hip_cooperative_groups.h>
#include <cstdio>
#include <cstdint>
namespace cg = cooperative_groups;
__device__ __forceinline__ int tid_fresh() { int t = threadIdx.x; asm volatile("" : "+v"(t)); return t; }
namespace pg8 {
#define PG8_LAS __attribute__((address_space(3)))
typedef unsigned short bf16_t;
typedef short bf16x8 __attribute__((ext_vector_type(8)));
typedef float f32x4 __attribute__((ext_vector_type(4)));
typedef unsigned u32x4 __attribute__((ext_vector_type(4)));
constexpr int BM = 256, BK = 64, HALF = 128, HTB = HALF * BK * 2  , STAGE_BYTES = 8 * HTB, NXCD = 8, WGM = 8;

__host__ __device__ __forceinline__ int lds_byte(int r, int c) { const int st = (r >> 4) * 2 + (c >> 5), rr = r & 15, cc = c & 31, ob = rr * 64 + cc * 2; return st * 1024 + (ob ^ (((ob >> 9) & 1) << 5)); }
__host__ __device__ __forceinline__ void stage_rc(int b, int& R, int& C) { const int st = b / 1024, sb = b % 1024, swz = sb ^ (((sb >> 9) & 1) << 5); R = (st >> 1) * 16 + swz / 64; C = (st & 1) * 32 + (swz % 64) / 2; }
__host__ __device__ __forceinline__ int perm32(int rho) { const int n = rho >> 4, i = rho & 15; return 8 * (i >> 2) + 4 * n + (i & 3); }

struct Unit { int pm, pn; };
struct Gemm { const bf16_t* A; const bf16_t* Bt; int M, N, K; };

struct StaticOrder {
    int nM, nN, nwg, G, c;
    __host__ __device__ void init(int M, int N, int G_, int c_) { nM = M / BM; nN = N / BM; nwg = nM * nN; G = G_; c = c_; }
    __host__ __device__ bool next(int i, Unit& u) const {
        const long L = (long)i * G + c; if (L >= nwg) return false;
        int wgid = (int)L; { const int q = nwg / NXCD, r = nwg % NXCD, xcd = wgid % NXCD, off = wgid / NXCD; wgid = (xcd < r ? xcd * (q + 1) : r * (q + 1) + (xcd - r) * q) + off; }
        const int nig = WGM * nN, gid = wgid / nig, fm = gid * WGM, gsz = (nM - fm) < WGM ? (nM - fm) : WGM;
        u.pm = fm + ((wgid % nig) % gsz); u.pn = (wgid % nig) / gsz; return true;
    }
    __device__ __forceinline__ void a_ready(const Unit&) const {}
    __device__ __forceinline__ void done(const Unit&) const {}
};

__device__ __forceinline__ unsigned cvt_pk_bf16(float lo, float hi) { unsigned r; asm volatile("v_cvt_pk_bf16_f32 %0, %1, %2" : "=v"(r) : "v"(lo), "v"(hi)); return r; }
typedef float f32x2 __attribute__((ext_vector_type(2)));
__device__ __forceinline__ f32x2 gelu_pk(f32x2 v) {
    const f32x2 av = __builtin_elementwise_abs(v), d = av * 0.2316418882f + 1.0f;
    f32x2 t; t.x = __builtin_amdgcn_rcpf(d.x); t.y = __builtin_amdgcn_rcpf(d.y);
    f32x2 q = t * 0.5307027145f + (-0.7265760135f); q = q * t + 0.7107068705f; q = q * t + (-0.142248368f); q = q * t + 0.127414796f; q = q * t;
    const f32x2 s = (v * v) * (-0.72134752044f);
    f32x2 e; e.x = __builtin_amdgcn_exp2f(s.x); e.y = __builtin_amdgcn_exp2f(s.y);
    const f32x2 m = v * (q * e), r = v - m;
    f32x2 o; o.x = v.x < 0.f ? m.x : r.x; o.y = v.y < 0.f ? m.y : r.y; return o;
}

template <int ACT  > struct EpiBf16 {
    static constexpr bool PERM = true, AFTER_DRAIN = false; static_assert(ACT == 0 || ACT == 1, "EpiBf16: ACT is 0 (none) or 1 (gelu_pk)");
    bf16_t* O; int ldc; const float* bias; int split_cols; size_t split_stride; float scale0;
    __device__ __forceinline__ void operator()(const f32x4 (&acc)[2][2][4][2], const Unit& u, int wr, int wc, int fr, int fq) const {
        const int row0 = u.pm * BM + wr * 64 + fr; int colt = u.pn * BM; bf16_t* base = O;
        float sc = 1.f; if (split_cols) { const int t = colt / split_cols; base += (size_t)t * split_stride; colt -= t * split_cols; if (t == 0) sc = scale0; }
        const int col0 = colt + wc * 32 + 8 * fq, bcol0 = u.pn * BM + wc * 32 + 8 * fq;
        f32x4 bv[2][2];
#pragma unroll
        for (int bj = 0; bj < 2; ++bj)
#pragma unroll
            for (int n = 0; n < 2; ++n) bv[bj][n] = bias ? *(const f32x4*)(bias + bcol0 + bj * HALF + 4 * n) : (f32x4){0.f, 0.f, 0.f, 0.f};
#pragma unroll
        for (int ai = 0; ai < 2; ++ai)
#pragma unroll
            for (int m = 0; m < 4; ++m) { bf16_t* rowp = base + (size_t)(row0 + ai * HALF + m * 16) * ldc + col0;
#pragma unroll
                for (int bj = 0; bj < 2; ++bj) { f32x4 v0 = acc[ai][bj][m][0] + bv[bj][0], v1 = acc[ai][bj][m][1] + bv[bj][1];
                    if (ACT == 1) { f32x2 a = gelu_pk((f32x2){v0[0], v0[1]}), b = gelu_pk((f32x2){v0[2], v0[3]}), c = gelu_pk((f32x2){v1[0], v1[1]}), d = gelu_pk((f32x2){v1[2], v1[3]});
                        v0 = (f32x4){a.x, a.y, b.x, b.y}; v1 = (f32x4){c.x, c.y, d.x, d.y}; }
                    v0 = v0 * sc; v1 = v1 * sc; u32x4 w; w.x = cvt_pk_bf16(v0[0], v0[1]); w.y = cvt_pk_bf16(v0[2], v0[3]); w.z = cvt_pk_bf16(v1[0], v1[1]); w.w = cvt_pk_bf16(v1[2], v1[3]);
                    *(u32x4*)(rowp + bj * HALF) = w; } }
    }
};

struct PanelStats {
    unsigned* xbuf;
    unsigned* cnt;
    unsigned* tmo;
    int ntn; float eps;
    unsigned code;
    __device__ __forceinline__ bool run(const f32x4 (&v)[2][2][4][2], const Unit& u, int wr, int wc, int fr, int fq, PG8_LAS unsigned char* lds, int wid, int lane) const {
        typedef float f32x2v __attribute__((ext_vector_type(2)));
        PG8_LAS f32x2v* P = (PG8_LAS f32x2v*)lds;
        PG8_LAS f32x2v* S = (PG8_LAS f32x2v*)(lds + 8192);
        PG8_LAS unsigned* flag = (PG8_LAS unsigned*)(lds + 8192 + 2048);
#pragma unroll
        for (int ai = 0; ai < 2; ++ai)
#pragma unroll
            for (int m = 0; m < 4; ++m) {
                float s = 0.f;
#pragma unroll
                for (int bj = 0; bj < 2; ++bj)
#pragma unroll
                    for (int n = 0; n < 2; ++n) { const f32x4 x = v[ai][bj][m][n]; s += (x[0] + x[1]) + (x[2] + x[3]); }
                s += __shfl_xor(s, 16); s += __shfl_xor(s, 32);
                const float mw = s * (1.0f / 64.0f); float q = 0.f;
#pragma unroll
                for (int bj = 0; bj < 2; ++bj)
#pragma unroll
                    for (int n = 0; n < 2; ++n) { const f32x4 d = v[ai][bj][m][n] - mw; q += (d[0] * d[0] + d[1] * d[1]) + (d[2] * d[2] + d[3] * d[3]); }
                q += __shfl_xor(q, 16); q += __shfl_xor(q, 32);
                if (fq == 0) P[(ai * HALF + wr * 64 + m * 16 + fr) * 4 + wc] = (f32x2v){mw, q};
            }
        asm volatile("s_waitcnt lgkmcnt(0)" ::: "memory"); __builtin_amdgcn_s_barrier(); asm volatile("" ::: "memory");
#if defined(BROKEN_EXCHANGE_NO_WAIT)
#warning BROKEN CONTROL BUILD: the row-statistics exchange does not wait; results are wrong by design
        if (blockIdx.x >= 64) { const long long t0_ = clock64(); while (clock64() - t0_ < 60000) __builtin_amdgcn_s_sleep(8); }
#endif
        const int row = wid * 32 + (lane & 31);
        if (lane < 32) {
            const f32x2v a = P[row * 4 + 0], b = P[row * 4 + 1], c = P[row * 4 + 2], d = P[row * 4 + 3];
            const float mt = (a.x + b.x + c.x + d.x) * 0.25f;
            const float da = a.x - mt, db = b.x - mt, dc = c.x - mt, dd = d.x - mt;
            const float m2 = (a.y + b.y) + (c.y + d.y) + 64.0f * ((da * da + db * db) + (dc * dc + dd * dd));
            unsigned long long* slot = (unsigned long long*)xbuf + ((size_t)(u.pm * BM + row) * 4 + u.pn);
            __hip_atomic_store(slot, ((unsigned long long)__float_as_uint(m2) << 32) | __float_as_uint(mt), __ATOMIC_RELAXED, __HIP_MEMORY_SCOPE_AGENT);
        }
        asm volatile("s_waitcnt vmcnt(0)" ::: "memory");
        if (lane == 0) __hip_atomic_fetch_add(cnt + 64 * u.pm, 1u, __ATOMIC_RELAXED, __HIP_MEMORY_SCOPE_AGENT);
        if (wid == 0) {
            bool dead = false; const unsigned long long t0 = __builtin_amdgcn_s_memrealtime(); const unsigned want = 8u * (unsigned)ntn;
            for (;;) {
#if defined(BROKEN_EXCHANGE_NO_WAIT)
                break;
#endif
                if ((unsigned)__builtin_amdgcn_readfirstlane(__hip_atomic_load(cnt + 64 * u.pm, __ATOMIC_RELAXED, __HIP_MEMORY_SCOPE_AGENT)) >= want) break;
                if (__builtin_amdgcn_s_memrealtime() - t0 > 2000000ull) {
                    if (lane == 0) { unsigned expect = 0u; __hip_atomic_compare_exchange_strong(tmo + 1, &expect, code | (unsigned)(u.pm & 0xff), __ATOMIC_RELAXED, __ATOMIC_RELAXED, __HIP_MEMORY_SCOPE_AGENT);
                                     __hip_atomic_store(tmo, 1u, __ATOMIC_RELAXED, __HIP_MEMORY_SCOPE_AGENT); }
                    dead = true; break; }
                __builtin_amdgcn_s_sleep(2);
            }
            __builtin_amdgcn_fence(__ATOMIC_ACQUIRE, "agent");
            if (lane == 0) flag[0] = dead ? 1u : 0u;
        }
        asm volatile("s_waitcnt vmcnt(0) lgkmcnt(0)" ::: "memory"); __builtin_amdgcn_s_barrier(); asm volatile("" ::: "memory");
        const bool bad = flag[0] != 0u;
        if (lane < 32) {
            const unsigned long long* slot = (const unsigned long long*)xbuf + (size_t)(u.pm * BM + row) * 4; float mt[4], m2[4]; float ms = 0.f;
#pragma unroll
            for (int t = 0; t < 4; ++t) { if (t < ntn) { const unsigned long long w = __hip_atomic_load(slot + t, __ATOMIC_RELAXED, __HIP_MEMORY_SCOPE_AGENT); mt[t] = __uint_as_float((unsigned)w); m2[t] = __uint_as_float((unsigned)(w >> 32)); } else { mt[t] = 0.f; m2[t] = 0.f; } ms += mt[t]; }
            const float mean = ms / (float)ntn; float q = 0.f;
#pragma unroll
            for (int t = 0; t < 4; ++t) if (t < ntn) { const float dm = mt[t] - mean; q += m2[t] + 256.0f * dm * dm; }
            S[row] = (f32x2v){mean, 1.0f / sqrtf(q / (256.0f * (float)ntn) + eps)};
        }
        asm volatile("s_waitcnt lgkmcnt(0)" ::: "memory"); __builtin_amdgcn_s_barrier(); asm volatile("" ::: "memory");
        return bad;
    }
};
struct EpiLnRes {
    static constexpr bool PERM = false, AFTER_DRAIN = true;
    const float* base; float* out; int ldc; const float* bias; PanelStats st; unsigned poison;
    __device__ __forceinline__ void fused(f32x4 (&acc)[2][2][4][2], const Unit& u, int wr, int wc, int fr, int fq, PG8_LAS unsigned char* lds, int wid, int lane) const {
        typedef float f32x2v __attribute__((ext_vector_type(2)));
        const PG8_LAS f32x2v* S = (const PG8_LAS f32x2v*)(lds + 8192);
        const int col0 = u.pn * BM + wc * 32 + 4 * fq;
#pragma unroll
        for (int bj = 0; bj < 2; ++bj)
#pragma unroll
            for (int n = 0; n < 2; ++n) { const f32x4 bv = bias ? *(const f32x4*)(bias + col0 + bj * HALF + n * 16) : (f32x4){0.f, 0.f, 0.f, 0.f};
#pragma unroll
                for (int ai = 0; ai < 2; ++ai)
#pragma unroll
                    for (int m = 0; m < 4; ++m) acc[ai][bj][m][n] += bv; }
        f32x4 pre[4][2][2];
#pragma unroll
        for (int m = 0; m < 4; ++m) { const size_t off = (size_t)(u.pm * BM + wr * 64 + m * 16 + fr) * ldc + col0;
#pragma unroll
            for (int bj = 0; bj < 2; ++bj)
#pragma unroll
                for (int n = 0; n < 2; ++n) pre[m][bj][n] = *(const f32x4*)(base + off + bj * HALF + n * 16); }
        const bool bad = st.run(acc, u, wr, wc, fr, fq, lds, wid, lane) || poison != 0u;
        const float qnan = __builtin_nanf("");
#pragma unroll
        for (int ai = 0; ai < 2; ++ai)
#pragma unroll
            for (int m = 0; m < 4; ++m) { const int r = ai * HALF + wr * 64 + m * 16 + fr; const f32x2v sr = S[r]; const size_t off = (size_t)(u.pm * BM + r) * ldc + col0;
#pragma unroll
                for (int bj = 0; bj < 2; ++bj)
#pragma unroll
                    for (int n = 0; n < 2; ++n) { const f32x4 bs = ai == 0 ? pre[m][bj][n] : *(const f32x4*)(base + off + bj * HALF + n * 16); f32x4 o = bs + (acc[ai][bj][m][n] - sr.x) * sr.y;
                        if (bad) o = (f32x4){qnan, qnan, qnan, qnan}; *(f32x4*)(out + off + bj * HALF + n * 16) = o; }
                if (m & 1) asm volatile("" ::: "memory"); }
    }
};
struct EpiLnResLn {
    static constexpr bool PERM = false, AFTER_DRAIN = true;
    const float* base; float* out; bf16_t* xn; int ldc; const float* bias; PanelStats st1, st2; unsigned poison;
    __device__ __forceinline__ void fused(f32x4 (&acc)[2][2][4][2], const Unit& u, int wr, int wc, int fr, int fq, PG8_LAS unsigned char* lds, int wid, int lane) const {
        typedef float f32x2v __attribute__((ext_vector_type(2))); typedef unsigned u32x2v __attribute__((ext_vector_type(2)));
        const PG8_LAS f32x2v* S = (const PG8_LAS f32x2v*)(lds + 8192);
        const int col0 = u.pn * BM + wc * 32 + 4 * fq;
#pragma unroll
        for (int bj = 0; bj < 2; ++bj)
#pragma unroll
            for (int n = 0; n < 2; ++n) { const f32x4 bv = bias ? *(const f32x4*)(bias + col0 + bj * HALF + n * 16) : (f32x4){0.f, 0.f, 0.f, 0.f};
#pragma unroll
                for (int ai = 0; ai < 2; ++ai)
#pragma unroll
                    for (int m = 0; m < 4; ++m) acc[ai][bj][m][n] += bv; }
        bool bad = st1.run(acc, u, wr, wc, fr, fq, lds, wid, lane) || poison != 0u;
        const float qnan = __builtin_nanf("");
#pragma unroll
        for (int ai = 0; ai < 2; ++ai)
#pragma unroll
            for (int m = 0; m < 4; ++m) { const int r = ai * HALF + wr * 64 + m * 16 + fr; const f32x2v sr = S[r]; const size_t off = (size_t)(u.pm * BM + r) * ldc + col0;
#pragma unroll
                for (int bj = 0; bj < 2; ++bj)
#pragma unroll
                    for (int n = 0; n < 2; ++n) { const f32x4 bs = *(const f32x4*)(base + off + bj * HALF + n * 16); acc[ai][bj][m][n] = bs + (acc[ai][bj][m][n] - sr.x) * sr.y; }
                asm volatile("" : "+v"(acc[ai][0][m][0]), "+v"(acc[ai][0][m][1]), "+v"(acc[ai][1][m][0]), "+v"(acc[ai][1][m][1]));
                if (m & 1) asm volatile("" ::: "memory"); }
        const bool bad1 = bad;
        bad = st2.run(acc, u, wr, wc, fr, fq, lds, wid, lane) || bad;
#pragma unroll
        for (int ai = 0; ai < 2; ++ai)
#pragma unroll
            for (int m = 0; m < 4; ++m) { const int r = ai * HALF + wr * 64 + m * 16 + fr; const f32x2v sr = S[r]; const size_t off = (size_t)(u.pm * BM + r) * ldc + col0;
#pragma unroll
                for (int bj = 0; bj < 2; ++bj)
#pragma unroll
                    for (int n = 0; n < 2; ++n) { const f32x4 x1 = acc[ai][bj][m][n]; *(f32x4*)(out + off + bj * HALF + n * 16) = bad1 ? (f32x4){qnan, qnan, qnan, qnan} : x1;
                        const f32x4 o = (x1 - sr.x) * sr.y; u32x2v w; w.x = cvt_pk_bf16(o[0], o[1]); w.y = cvt_pk_bf16(o[2], o[3]);
                        if (bad) { w.x = 0x7fc07fc0u; w.y = 0x7fc07fc0u; } *(u32x2v*)(xn + off + bj * HALF + n * 16) = w; }
                asm volatile("" ::: "memory"); }
    }
};

template <class Epi, class Sched, bool ALIGN_EPI = false, bool SP2 = false>
__device__ __forceinline__ void gemm_phase(PG8_LAS unsigned char* lds, const Gemm g, const Sched& S, const Epi& E) {
    const int tid = ::tid_fresh(), wid = __builtin_amdgcn_readfirstlane(tid >> 6), lane = tid & 63, wr = wid >> 2, wc = wid & 3, fr = lane & 15, fq = lane >> 4;
    const int K = g.K, nt = K / BK;
    unsigned voffA[2], voffB[2];
#pragma unroll
    for (int i = 0; i < 2; ++i) { int R, C; stage_rc(tid * 16 + i * 8192, R, C); const int Rb = Epi::PERM ? ((R & ~31) + perm32(R & 31)) : R;
        voffA[i] = (unsigned)(R * K + C) * 2u; voffB[i] = (unsigned)(Rb * K + C) * 2u; }
    const size_t kstep = (size_t)(BK * 2);
    const size_t hstep = (size_t)HALF * K * 2;
    const size_t tstep = 2 * hstep;
    const unsigned ldsw = (unsigned)wid * 1024u;
    const int aoff = lds_byte(wr * 64 + fr, fq * 8), boff = lds_byte(wc * 32 + fr, fq * 8);
#define PG8_SA(b, h) (((b) * 2 + (h)) * HTB)
#define PG8_SB(b, h) ((4 + (b) * 2 + (h)) * HTB)
#define PG8_STAGE(bufoff, gbase, voff) do { _Pragma("unroll") for (int _i = 0; _i < 2; ++_i) \
        __builtin_amdgcn_global_load_lds((const unsigned*)((const char*)(gbase) + (voff)[_i]), (PG8_LAS unsigned*)(lds + (bufoff) + ldsw + _i * 8192), 16, 0, 0); } while (0)
#define PG8_LDA(dst, b, h) do { _Pragma("unroll") for (int m = 0; m < 4; ++m) _Pragma("unroll") for (int k = 0; k < 2; ++k) dst[m][k] = *(const PG8_LAS bf16x8*)(lds + PG8_SA(b, h) + aoff + m * 2048 + k * 1024); } while (0)
#define PG8_LDB(dst, b, h) do { _Pragma("unroll") for (int n = 0; n < 2; ++n) _Pragma("unroll") for (int k = 0; k < 2; ++k) dst[n][k] = *(const PG8_LAS bf16x8*)(lds + PG8_SB(b, h) + boff + n * 2048 + k * 1024); } while (0)
#define PG8_MMA(ai, bj, At, Bt) do { __builtin_amdgcn_s_setprio(1); _Pragma("unroll") for (int m = 0; m < 4; ++m) _Pragma("unroll") for (int n = 0; n < 2; ++n) _Pragma("unroll") for (int k = 0; k < 2; ++k) \
        acc[ai][bj][m][n] = __builtin_amdgcn_mfma_f32_16x16x32_bf16(Bt[n][k], At[m][k], acc[ai][bj][m][n], 0, 0, 0); __builtin_amdgcn_s_setprio(0); } while (0)
#define PG8_WAIT_V(n) asm volatile("s_waitcnt vmcnt(" #n ")" ::: "memory")
#define PG8_WAIT_L(n) asm volatile("s_waitcnt lgkmcnt(" #n ")" ::: "memory")
#define PG8_BAR __builtin_amdgcn_s_barrier()
#define PG8_SCHED __builtin_amdgcn_sched_barrier(0)
    Unit cur, nxt; int ui = 0;
    if (!S.next(0, cur)) return;
    f32x4 acc[2][2][4][2];
#pragma unroll
    for (int a = 0; a < 2; ++a)
#pragma unroll
        for (int b = 0; b < 2; ++b)
#pragma unroll
            for (int m = 0; m < 4; ++m)
#pragma unroll
                for (int n = 0; n < 2; ++n) acc[a][b][m][n] = (f32x4){0.f, 0.f, 0.f, 0.f};
    bf16x8 At[4][2], B0[2][2], B1[2][2];
    const char* cA = (const char*)g.A + (size_t)cur.pm * tstep; const char* cB = (const char*)g.Bt + (size_t)cur.pn * tstep;
    S.a_ready(cur);
    if constexpr (SP2) {
        PG8_STAGE(PG8_SB(0, 0), cB, voffB); PG8_STAGE(PG8_SB(0, 1), cB + hstep, voffB); PG8_STAGE(PG8_SA(0, 0), cA, voffA); PG8_STAGE(PG8_SA(0, 1), cA + hstep, voffA);
        if (wr == 1) PG8_BAR;
        PG8_WAIT_V(2); PG8_BAR;
        PG8_STAGE(PG8_SB(1, 0), cB + kstep, voffB); PG8_STAGE(PG8_SA(1, 0), cA + kstep, voffA); PG8_STAGE(PG8_SB(1, 1), cB + hstep + kstep, voffB);
        PG8_WAIT_V(6); PG8_BAR;
    } else {
        PG8_STAGE(PG8_SB(0, 0), cB, voffB); PG8_STAGE(PG8_SA(0, 0), cA, voffA); PG8_STAGE(PG8_SB(0, 1), cB + hstep, voffB); PG8_STAGE(PG8_SA(0, 1), cA + hstep, voffA);
        if (wr == 1) PG8_BAR;
        PG8_WAIT_V(4); PG8_BAR;
        PG8_STAGE(PG8_SB(1, 0), cB + kstep, voffB); PG8_STAGE(PG8_SA(1, 0), cA + kstep, voffA); PG8_STAGE(PG8_SB(1, 1), cB + hstep + kstep, voffB);
        PG8_WAIT_V(6); PG8_BAR;
    }
    for (;;) {
        const bool has_next = S.next(ui + 1, nxt);
        const char* nA = has_next ? (const char*)g.A + (size_t)nxt.pm * tstep : cA; const char* nB = has_next ? (const char*)g.Bt + (size_t)nxt.pn * tstep : cB;
        for (int t = 0; t < nt; t += 2) {
            const bool last = (t == nt - 2);
            const char* a1 = cA + (size_t)(t + 1) * kstep;
            const char* a2 = last ? nA : cA + (size_t)(t + 2) * kstep; const char* b2 = last ? nB : cB + (size_t)(t + 2) * kstep;
            const char* a3 = a2 + kstep; const char* b3 = b2 + kstep;
            if (last && has_next) S.a_ready(nxt);
            if constexpr (SP2) {
            PG8_LDB(B0, 0, 0); PG8_LDB(B1, 0, 1); PG8_SCHED; PG8_LDA(At, 0, 0); PG8_STAGE(PG8_SA(1, 1), a1 + hstep, voffA);
            PG8_WAIT_V(8); PG8_WAIT_L(0); PG8_BAR; PG8_MMA(0, 0, At, B0); PG8_MMA(0, 1, At, B1); PG8_BAR; PG8_SCHED;
            PG8_LDA(At, 0, 1); PG8_STAGE(PG8_SB(0, 0), b2, voffB); PG8_STAGE(PG8_SB(0, 1), b2 + hstep, voffB); PG8_STAGE(PG8_SA(0, 0), a2, voffA);
            PG8_WAIT_V(8); PG8_WAIT_L(0); PG8_BAR; PG8_MMA(1, 0, At, B0); PG8_MMA(1, 1, At, B1); PG8_BAR; PG8_SCHED;
            PG8_LDB(B0, 1, 0); PG8_LDB(B1, 1, 1); PG8_SCHED; PG8_LDA(At, 1, 0); PG8_STAGE(PG8_SA(0, 1), a2 + hstep, voffA);
            PG8_WAIT_V(8); PG8_WAIT_L(0); PG8_BAR; PG8_MMA(0, 0, At, B0); PG8_MMA(0, 1, At, B1); PG8_BAR; PG8_SCHED;
            PG8_LDA(At, 1, 1); PG8_STAGE(PG8_SB(1, 0), b3, voffB); PG8_STAGE(PG8_SB(1, 1), b3 + hstep, voffB); PG8_STAGE(PG8_SA(1, 0), a3, voffA);
            PG8_WAIT_V(8); PG8_WAIT_L(0); PG8_BAR; PG8_MMA(1, 0, At, B0); PG8_MMA(1, 1, At, B1); PG8_BAR; PG8_SCHED;
            } else {
            PG8_LDB(B0, 0, 0); PG8_SCHED; PG8_LDA(At, 0, 0); PG8_STAGE(PG8_SA(1, 1), a1 + hstep, voffA);
            PG8_WAIT_L(8); PG8_BAR; PG8_WAIT_L(0); PG8_MMA(0, 0, At, B0); PG8_BAR; PG8_SCHED;
            PG8_LDB(B1, 0, 1); PG8_STAGE(PG8_SB(0, 0), b2, voffB);
            PG8_BAR; PG8_WAIT_L(0); PG8_MMA(0, 1, At, B1); PG8_BAR;
            PG8_LDA(At, 0, 1); PG8_STAGE(PG8_SA(0, 0), a2, voffA);
            PG8_BAR; PG8_WAIT_L(0); PG8_MMA(1, 0, At, B0); PG8_BAR; PG8_SCHED;
            PG8_STAGE(PG8_SB(0, 1), b2 + hstep, voffB);
            PG8_WAIT_V(6); PG8_BAR; PG8_MMA(1, 1, At, B1); PG8_BAR;
            PG8_LDB(B0, 1, 0); PG8_SCHED; PG8_LDA(At, 1, 0); PG8_STAGE(PG8_SA(0, 1), a2 + hstep, voffA);
            PG8_WAIT_L(8); PG8_BAR; PG8_WAIT_L(0); PG8_MMA(0, 0, At, B0); PG8_BAR; PG8_SCHED;
            PG8_LDB(B1, 1, 1); PG8_STAGE(PG8_SB(1, 0), b3, voffB);
            PG8_BAR; PG8_WAIT_L(0); PG8_MMA(0, 1, At, B1); PG8_BAR;
            PG8_LDA(At, 1, 1); PG8_STAGE(PG8_SA(1, 0), a3, voffA);
            PG8_BAR; PG8_WAIT_L(0); PG8_MMA(1, 0, At, B0); PG8_BAR; PG8_SCHED;
            PG8_STAGE(PG8_SB(1, 1), b3 + hstep, voffB);
            PG8_WAIT_V(6); PG8_BAR; PG8_MMA(1, 1, At, B1); PG8_BAR;
            }
        }
        if constexpr (ALIGN_EPI) { if (wr == 0) PG8_BAR; }
        if constexpr (!Epi::AFTER_DRAIN) { E(acc, cur, wr, wc, fr, fq); S.done(cur); }
        if (!has_next) break;
#pragma unroll
        for (int a = 0; a < 2; ++a)
#pragma unroll
            for (int b = 0; b < 2; ++b)
#pragma unroll
                for (int m = 0; m < 4; ++m)
#pragma unroll
                    for (int n = 0; n < 2; ++n) acc[a][b][m][n] = (f32x4){0.f, 0.f, 0.f, 0.f};
        cur = nxt; cA = nA; cB = nB; ++ui;
        if constexpr (ALIGN_EPI) { if (wr == 1) PG8_BAR; }
    }
    PG8_WAIT_V(0);
    if constexpr (!ALIGN_EPI) { if (wr == 0) PG8_BAR; }
    PG8_BAR;
    if constexpr (Epi::AFTER_DRAIN) { E.fused(acc, cur, wr, wc, fr, fq, lds, wid, lane); S.done(cur); }
#undef PG8_SA
#undef PG8_SB
#undef PG8_STAGE
#undef PG8_LDA
#undef PG8_LDB
#undef PG8_MMA
#undef PG8_WAIT_V
#undef PG8_WAIT_L
#undef PG8_BAR
#undef PG8_SCHED
}
}

#define GAS __attribute__((address_space(1)))
#define LAS __attribute__((address_space(3)))
typedef GAS unsigned gu32;
typedef GAS unsigned long long gu64;
#define RLX_AGENT __ATOMIC_RELAXED, __HIP_MEMORY_SCOPE_AGENT
#define LDS_WAIT() asm volatile("s_waitcnt lgkmcnt(0)" ::: "memory")
#define VM_WAIT() asm volatile("s_waitcnt vmcnt(0)" ::: "memory")
__device__ __forceinline__ unsigned long long rt() { return __builtin_amdgcn_s_memrealtime(); }
#define XB_TMO      128
#define XB_XCNT(j)  (256  + 64 * (j))
#define XB_XSUB(j)  (1280 + 64 * (j))
#define XB_XGEN(j)  (2304 + 64 * (j))
#define XB_TOP      3328
#define XB_TOPGEN   3392
#define XCD_BAR_WORDS 3456
#define XB_SPIN_CAP (1u << 20)

__device__ __forceinline__ unsigned xb_ld(unsigned* p)              { return __hip_atomic_load(p, __ATOMIC_RELAXED, __HIP_MEMORY_SCOPE_AGENT); }
__device__ __forceinline__ unsigned xb_add(unsigned* p, unsigned v) { return __hip_atomic_fetch_add(p, v, __ATOMIC_RELAXED, __HIP_MEMORY_SCOPE_AGENT); }
__device__ __forceinline__ unsigned xb_xcc_id() { return (unsigned)__builtin_amdgcn_s_getreg((3 << 11) | 20) & 0xFu; }
#define XB_SPIN(cond, bar) do { unsigned _sp = 0; while (cond) { __builtin_amdgcn_s_sleep(1); \
    if ((++_sp & 255u) == 0u) { if (xb_ld(&(bar)[XB_TMO])) break; if (_sp > XB_SPIN_CAP) { atomicAdd(&(bar)[XB_TMO], 1u); break; } } } } while (0)

struct XcdBarrier {
    unsigned* bar; unsigned x;
    volatile LAS unsigned* st;
};

__device__ __forceinline__ XcdBarrier xcd_barrier_post(unsigned* bar, volatile LAS unsigned* st) {
    XcdBarrier b; b.bar = bar; b.x = xb_xcc_id(); b.st = st;
    if (threadIdx.x == 0) (void)xb_add(&bar[XB_XCNT(b.x)], 1u);
    return b;
}
__device__ __forceinline__ void xcd_barrier_complete(unsigned* bar, unsigned x, unsigned& nloc, unsigned& nx) {
    const unsigned G = gridDim.x * gridDim.y * gridDim.z;
    unsigned sum, cnt, mine, sp = 0u;
    for (;;) {
        sum = 0u; cnt = 0u; mine = 0u;
#pragma unroll
        for (unsigned j = 0; j < 16; ++j) { const unsigned c = xb_ld(&bar[XB_XCNT(j)]); sum += c; cnt += (c > 0u) ? 1u : 0u; mine = (j == x) ? c : mine; }
        if (sum == G) break;
        __builtin_amdgcn_s_sleep(1);
        if ((++sp & 255u) == 0u) { if (xb_ld(&bar[XB_TMO])) break; if (sp > XB_SPIN_CAP) { atomicAdd(&bar[XB_TMO], 1u); break; } }
    }
    nloc = mine > 0u ? mine : 1u; nx = cnt > 0u ? cnt : 1u;
}

__device__ __forceinline__ void xcd_barrier(const XcdBarrier& b) {
    asm volatile("s_waitcnt vmcnt(0)" ::: "memory");
    __syncthreads();
    if (threadIdx.x == 0) {
        unsigned* bar = b.bar;
        __builtin_amdgcn_s_waitcnt(0);
        unsigned nloc = b.st[0], nx = b.st[1];
        if (nloc == 0u) { xcd_barrier_complete(bar, b.x, nloc, nx); b.st[0] = nloc; b.st[1] = nx; }
        const unsigned old = xb_add(&bar[XB_XSUB(b.x)], 1u);
        const unsigned gen = old / nloc;
        if (old + 1u == (gen + 1u) * nloc) {
            __builtin_amdgcn_fence(__ATOMIC_RELEASE, "agent");
            asm volatile("s_waitcnt vmcnt(0)" ::: "memory");
            const unsigned og = xb_add(&bar[XB_TOP], 1u);
            const unsigned tg = og / nx;
            if (og + 1u == (tg + 1u) * nx) xb_add(&bar[XB_TOPGEN], 1u);
            else XB_SPIN(xb_ld(&bar[XB_TOPGEN]) == tg, bar);
            __builtin_amdgcn_fence(__ATOMIC_ACQUIRE, "agent");
            xb_add(&bar[XB_XGEN(b.x)], 1u);
            asm volatile("s_waitcnt vmcnt(0)" ::: "memory");
        } else {
            XB_SPIN(xb_ld(&bar[XB_XGEN(b.x)]) == gen, bar);
            __builtin_amdgcn_fence(__ATOMIC_ACQUIRE, "agent");
            asm volatile("s_waitcnt vmcnt(0)" ::: "memory");
        }
    }
    __syncthreads();
}


#define DI __device__ __forceinline__
typedef unsigned short bf16;
typedef short bf16x8 __attribute__((ext_vector_type(8)));
typedef short s16x4 __attribute__((ext_vector_type(4)));
typedef float f32x4 __attribute__((ext_vector_type(4)));
typedef float f32x16 __attribute__((ext_vector_type(16)));
typedef unsigned u32x4 __attribute__((ext_vector_type(4)));
typedef unsigned u32x2 __attribute__((ext_vector_type(2)));
typedef float f32x2_t __attribute__((ext_vector_type(2)));
typedef __bf16 bf16x2_t __attribute__((ext_vector_type(2)));

constexpr int DM = 1024, NB = 8, SEQ = 4096, CTXL = 256;
constexpr int ML = NB * SEQ;
constexpr int MC = NB * CTXL;
constexpr int MT = ML + MC;
constexpr int DFF = 2816;
constexpr int NZ0 = 2560;
constexpr int NZ1 = 2304;
constexpr int ZQKV = 0, ZGATE = 1536, ZA = 2048, ZBT = 2064, ZQD = 2080, ZKVD = 2336, ZKPE = 2464;
constexpr int Z1_NAQ = 0, Z1_NAK = 512, Z1_NAV = 1024, Z1_GQ = 1536, Z1_GK = 2048, Z1_GV = 2176;
constexpr float EPS = 1e-6f;
constexpr float LOG2E = 1.4426950408889634f;
constexpr int NTHREADS = 512, NWAVES = 8;
constexpr int LDS_BYTES = 147456;

constexpr size_t MiB = 1048576;
constexpr size_t WS_WIN0 = 0;
constexpr size_t WS_WOUT0 = 5 * MiB;
constexpr size_t WS_WGU0 = 7 * MiB;
constexpr size_t WS_WDN0 = 18 * MiB;
constexpr size_t WS_WQUP = 24 * MiB;
constexpr size_t WS_WKVUP = 24 * MiB + 512 * 1024;
constexpr size_t WS_WIN1 = 25 * MiB;
constexpr size_t WS_WOUT1 = 30 * MiB;
constexpr size_t WS_WGU1 = 32 * MiB;
constexpr size_t WS_WDN1 = 43 * MiB;
constexpr size_t WS_MOD = 49 * MiB;
constexpr size_t WS_HC = 50 * MiB;
constexpr size_t WS_CTL = 60 * MiB;
constexpr size_t WS_QCTR = 60 * MiB + 14336;
constexpr size_t WS_CTL2 = 60 * MiB + 16384;
constexpr size_t WS_SUBCNT = 60 * MiB + 13824;
constexpr size_t WS_ROPE16 = 60 * MiB + 65536;
constexpr size_t WS_ROPE8 = 60 * MiB + 65536 + 8192;
constexpr size_t WS_U = 64 * MiB;
constexpr size_t WS_Z = 132 * MiB;
constexpr size_t WS_S = 320 * MiB;
constexpr size_t WS_TINV = WS_S;
constexpr size_t WS_QN = WS_U;
constexpr size_t WS_KVN = WS_U + 17 * MiB;
constexpr size_t WS_QMLA = 388 * MiB;
constexpr size_t WS_KVMLA = 439 * MiB;
constexpr size_t WS_KPE = 507 * MiB;
constexpr size_t WS_GB = 302 * MiB;
constexpr size_t WS_OBHI = 307 * MiB;
constexpr int OB_SPLIT = 26624;
constexpr size_t OUT_OBLO = 102 * MiB;
constexpr size_t WS_Y = WS_S;
constexpr size_t WS_GQ = WS_S + 70 * MiB;
constexpr size_t WS_GKK = WS_S + 104 * MiB;
constexpr size_t WS_GKV = WS_S + 70 * MiB;
constexpr size_t WS_HB = 436 * MiB;
constexpr size_t WS_END = 510 * MiB;

struct KParams {
    const float* in[28];
    float* out;
    unsigned char* ws;
};

DI float bflo(unsigned w) { return __uint_as_float(w << 16); }
DI float bfhi(unsigned w) { return __uint_as_float(w & 0xffff0000u); }
DI float bf2f(bf16 b) { return __uint_as_float(((unsigned)b) << 16); }
DI unsigned pk2(float lo, float hi) { f32x2_t v = {lo, hi}; bf16x2_t b = __builtin_convertvector(v, bf16x2_t); return __builtin_bit_cast(unsigned, b); }
DI bf16 f2bf(float x) { return (bf16)(pk2(x, 0.f) & 0xffffu); }
DI void unpack8(const u32x4 w, float* f) {
    f[0] = bflo(w.x); f[1] = bfhi(w.x); f[2] = bflo(w.y); f[3] = bfhi(w.y); f[4] = bflo(w.z); f[5] = bfhi(w.z); f[6] = bflo(w.w); f[7] = bfhi(w.w);
}
DI u32x4 pack8(const float* f) { u32x4 w; w.x = pk2(f[0], f[1]); w.y = pk2(f[2], f[3]); w.z = pk2(f[4], f[5]); w.w = pk2(f[6], f[7]); return w; }
DI float wave_sum(float v) {
#pragma unroll
    for (int o = 1; o < 64; o <<= 1) v += __shfl_xor(v, o);
    return v;
}
DI float silu_f(float x) { return x * __builtin_amdgcn_rcpf(1.f + __expf(-x)); }
DI float sigmoid_f(float x) { return 1.f / (1.f + __expf(-x)); }
DI float softplus_f(float x) { return x > 20.f ? x : log1pf(expf(x)); }
DI int crow(int r, int hi) { return (r & 3) + 8 * (r >> 2) + 4 * hi; }
DI int batch_of(int m) { return m < ML ? (m >> 12) : 8; }
DI const float* modp(const KParams& p, int layer, int m) { return (const float*)(p.ws + WS_MOD) + (size_t)(layer * 9 + batch_of(m)) * 6144; }

struct TDesc { int src, src_off, K, N, ldw; unsigned dst_off_kb; int grp, gstride, goff; int nitems; };
constexpr int NTD = 14;
static constexpr TDesc g_td[NTD] = {
    {13, 0, 1024, 2496, 2496, (unsigned)(WS_WIN0 / 1024), 1 << 20, 0, 0, 16 * 39},
    {14, 0, 1024, 1024, 1024, (unsigned)(WS_WOUT0 / 1024), 1 << 20, 0, 0, 16 * 16},
    {10, 0, 1024, 2816, 2816, (unsigned)(WS_WGU0 / 1024), 128, 256, 0, 16 * 44},
    {11, 0, 1024, 2816, 2816, (unsigned)(WS_WGU0 / 1024), 128, 256, 128, 16 * 44},
    {12, 0, 2816, 1024, 1024, (unsigned)(WS_WDN0 / 1024), 1 << 20, 0, 0, 44 * 16},
    {20, 0, 256, 768, 768, (unsigned)(WS_WQUP / 1024), 1 << 20, 0, 0, 4 * 12},
    {22, 0, 128, 1024, 1024, (unsigned)(WS_WKVUP / 1024), 1 << 20, 0, 0, 2 * 16},
    {23, 0, 1024, 2304, 2304, (unsigned)(WS_WIN1 / 1024), 1 << 20, 0, 0, 16 * 36},
    {24, 0, 1024, 1024, 1024, (unsigned)(WS_WOUT1 / 1024), 1 << 20, 0, 0, 16 * 16},
    {10, 1024 * 2816, 1024, 2816, 2816, (unsigned)(WS_WGU1 / 1024), 128, 256, 0, 16 * 44},
    {11, 1024 * 2816, 1024, 2816, 2816, (unsigned)(WS_WGU1 / 1024), 128, 256, 128, 16 * 44},
    {12, 2816 * 1024, 2816, 1024, 1024, (unsigned)(WS_WDN1 / 1024), 1 << 20, 0, 0, 44 * 16},
    {0, 0, 0, 0, 0, 0, 1, 0, 0, 0},
    {0, 0, 0, 0, 0, 0, 1, 0, 0, 0},
};
constexpr int NTD_USED = 12;

DI void transpose_item(const float* W, int K, int N, bf16* WT, int grp, int gstride, int goff, float* scr_, int item, int lane) {
    unsigned* scr = (unsigned*)scr_;
    const int nblk = N / 64, kb = item / nblk, nb = item % nblk, k0 = 64 * kb, n0 = 64 * nb;
    const float* src = W + (size_t)k0 * N + n0 + lane;
#pragma unroll
    for (int hf = 0; hf < 2; ++hf) {
        float w[32];
#pragma unroll
        for (int i = 0; i < 32; ++i) w[i] = src[(size_t)(32 * hf + i) * N];
#pragma unroll
        for (int i = 0; i < 16; ++i) scr[(16 * hf + i) * 66 + lane] = pk2(w[2 * i], w[2 * i + 1]);
    }
    asm volatile("s_waitcnt lgkmcnt(0)" ::: "memory");
    asm volatile("" ::: "memory");
    const int c = lane & 7;
#pragma unroll
    for (int j = 0; j < 8; ++j) {
        const int n = (lane >> 3) + 8 * j; const unsigned* s = scr + (4 * c) * 66 + n;
        u32x4 o; o.x = s[0]; o.y = s[66]; o.z = s[132]; o.w = s[198];
        const int nn = n0 + n; const int drow = (nn / grp) * gstride + (nn % grp) + goff;
        *(u32x4*)(WT + (size_t)drow * K + k0 + 8 * c) = o;
    }
    asm volatile("s_waitcnt lgkmcnt(0)" ::: "memory");
}
constexpr unsigned TD_EARLY = (1u << 0) | (1u << 5) | (1u << 6);
constexpr unsigned TD_LATE = ((1u << NTD_USED) - 1u) & ~TD_EARLY;
template <unsigned MASK> DI void weight_transposes(const KParams& p, unsigned char* lds, int gw, int NGW) {
    const int tid = tid_fresh(), lane = tid & 63, wave = tid >> 6;
    float* scr = (float*)(lds + 57344 + wave * 8448);
    int total = 0;
#pragma unroll
    for (int d = 0; d < NTD_USED; ++d) if ((MASK >> d) & 1u) total += g_td[d].nitems;
    for (int it = gw; it < total; it += NGW) {
        int r = it;
#pragma unroll
        for (int d = 0; d < NTD_USED; ++d) if ((MASK >> d) & 1u) {
            if (r >= 0 && r < g_td[d].nitems)
                transpose_item(p.in[g_td[d].src] + g_td[d].src_off, g_td[d].K, g_td[d].N, (bf16*)(p.ws + (size_t)g_td[d].dst_off_kb * 1024), g_td[d].grp, g_td[d].gstride, g_td[d].goff, scr, r, lane);
            r -= g_td[d].nitems;
        }
    }
}

DI void phase_prologue(const KParams& p, unsigned char* lds) {
    const int tid = tid_fresh(), lane = tid & 63, wave = tid >> 6;
    const int G = gridDim.x;
    float* sc = (float*)lds;
    float* red = (float*)(lds + 36864);
    bool have_sc = false;
    for (int it = blockIdx.x; it < 192; it += G) {
        if (!have_sc) {
            for (int i = tid; i < 9 * 1024; i += NTHREADS) {
                const int bb = i >> 10, k = i & 1023;
                const float cv = bb < 8 ? p.in[1][bb * 1024 + k] : p.in[3][k];
                sc[i] = cv / (1.f + expf(-cv));
            }
            have_sc = true;
        }
        __syncthreads();
        const int layer = it / 96, n0 = (it % 96) * 64;
        const int col = tid & 63, ks = tid >> 6;
        const float* W = p.in[4] + (size_t)layer * 1024 * 6144 + n0 + col;
        float acc[9];
#pragma unroll
        for (int b = 0; b < 9; ++b) acc[b] = 0.f;
        for (int k0 = ks * 128; k0 < ks * 128 + 128; k0 += 32) {
            float w[32];
#pragma unroll
            for (int kk = 0; kk < 32; ++kk) w[kk] = W[(size_t)(k0 + kk) * 6144];
#pragma unroll
            for (int kk = 0; kk < 32; ++kk)
#pragma unroll
                for (int b = 0; b < 9; ++b) acc[b] += sc[b * 1024 + k0 + kk] * w[kk];
        }
#pragma unroll
        for (int b = 0; b < 9; ++b) red[(ks * 9 + b) * 64 + col] = acc[b];
        __syncthreads();
        for (int i = tid; i < 576; i += NTHREADS) {
            const int b = i >> 6, c2 = i & 63; float s = 0.f;
#pragma unroll
            for (int k2 = 0; k2 < 8; ++k2) s += red[(k2 * 9 + b) * 64 + c2];
            s += p.in[5][layer * 6144 + n0 + c2];
            ((float*)(p.ws + WS_MOD))[(size_t)(layer * 9 + b) * 6144 + n0 + c2] = s;
        }
        __syncthreads();
    }
    __syncthreads();
#ifdef ALL_W_EARLY
    weight_transposes<TD_EARLY | TD_LATE>(p, lds, blockIdx.x * NWAVES + wave, G * NWAVES);
#else
    weight_transposes<TD_EARLY>(p, lds, blockIdx.x * NWAVES + wave, G * NWAVES);
#endif
    if (blockIdx.x == G - 1) {
        float2* t16 = (float2*)(p.ws + WS_ROPE16); float2* t8 = (float2*)(p.ws + WS_ROPE8);
        for (int i = tid; i < 1024; i += NTHREADS) {
            const float invf = exp2f(-(float)(i & 15) * (13.287712379549449f / 16.f));
            float sn, cs; sincosf((float)(i >> 4) * invf, &sn, &cs); t16[i] = make_float2(cs, sn);
        }
        {
            const int i = tid;
            const float invf8[8] = {1.f, 0.31622776601683794f, 0.1f, 0.031622776601683794f, 0.01f, 0.0031622776601683794f, 0.001f, 0.00031622776601683794f};
            float iv = invf8[0];
#pragma unroll
            for (int e = 1; e < 8; ++e) iv = ((i & 7) == e) ? invf8[e] : iv;
            float sn, cs; sincosf((float)(i >> 3) * iv, &sn, &cs); t8[i] = make_float2(cs, sn);
        }
    }
    {
        u32x4* z = (u32x4*)(p.ws + WS_WIN0 + (size_t)2496 * 1024 * 2);
        const u32x4 zero = {0u, 0u, 0u, 0u};
        for (int i = blockIdx.x * NTHREADS + tid; i < 64 * 1024 * 2 / 16; i += G * NTHREADS) z[i] = zero;
    }
}

DI void ld8f(const float* p, float* f) { const f32x4 a = *(const f32x4*)p, b2 = *(const f32x4*)(p + 4); f[0] = a.x; f[1] = a.y; f[2] = a.z; f[3] = a.w; f[4] = b2.x; f[5] = b2.y; f[6] = b2.z; f[7] = b2.w; }
DI void st8f(float* p, const float* f) { *(f32x4*)p = (f32x4){f[0], f[1], f[2], f[3]}; *(f32x4*)(p + 4) = (f32x4){f[4], f[5], f[6], f[7]}; }

DI void wave_pair_range(int npairs, int gw, int NGW, int& p0, int& np) {
    const int base = npairs / NGW, rem = npairs % NGW;
    np = base + (gw < rem ? 1 : 0); p0 = gw * base + (gw < rem ? gw : rem);
}
DI void phase_modnorm0(const KParams& p) {
    const int tid_ = tid_fresh(); const int lane = tid_ & 63, wave = tid_ >> 6;
    const int gw = blockIdx.x * NWAVES + wave, NGW = gridDim.x * NWAVES;
    const float* g = p.in[6];
    bf16* U = (bf16*)(p.ws + WS_U);
    float gg[2][8], sh[2][8], scl[2][8];
#pragma unroll
    for (int j = 0; j < 2; ++j) ld8f(g + 8 * lane + 512 * j, gg[j]);
    int p0, np; wave_pair_range(MT / 2, gw, NGW, p0, np);
    int cur_b = -1;
    for (int i = 0; i < np; ++i) {
        const int m0 = 2 * (p0 + i);
        float v[2][2][8];
#pragma unroll
        for (int r = 0; r < 2; ++r) {
            const int m = m0 + r;
            const float* src = m < ML ? p.in[0] + (size_t)m * DM : p.in[2] + (size_t)(m - ML) * DM;
#pragma unroll
            for (int j = 0; j < 2; ++j) ld8f(src + 8 * lane + 512 * j, v[r][j]);
        }
        const int bb = batch_of(m0);
        if (bb != cur_b) {
            cur_b = bb; const float* md = modp(p, 0, m0);
#pragma unroll
            for (int j = 0; j < 2; ++j) { ld8f(md + 8 * lane + 512 * j, sh[j]); ld8f(md + 1024 + 8 * lane + 512 * j, scl[j]); }
        }
#pragma unroll
        for (int r = 0; r < 2; ++r) {
            const int m = m0 + r;
            float ss = 0.f;
#pragma unroll
            for (int j = 0; j < 2; ++j)
#pragma unroll
                for (int e = 0; e < 8; ++e) ss += v[r][j][e] * v[r][j][e];
            const float rstd = rsqrtf(wave_sum(ss) * (1.f / DM) + EPS);
#pragma unroll
            for (int j = 0; j < 2; ++j) {
                float o[8];
#pragma unroll
                for (int e = 0; e < 8; ++e) o[e] = (v[r][j][e] * rstd * gg[j][e]) * (1.f + scl[j][e]) + sh[j][e];
                *(u32x4*)(U + (size_t)m * DM + 8 * lane + 512 * j) = pack8(o);
            }
        }
    }
}

DI void phase_post(const KParams& p, int row0, int rows, const bf16* Y, int first_layer_input, int layer, int gate_chunk,
                   const float* gpost, const float* g2, int nlayer, int nshift_chunk, bf16* Udst, int wg0, int nwg) {
    const int tid_ = tid_fresh(); const int lane = tid_ & 63, wave = tid_ >> 6;
    const int gw = ((int)blockIdx.x - wg0) * NWAVES + wave, NGW = nwg * NWAVES;
    bf16* HB = (bf16*)(p.ws + WS_HB);
    float gp[2][8], gg[2][8], gt[2][8], sh[2][8], scl[2][8];
#pragma unroll
    for (int j = 0; j < 2; ++j) {
        ld8f(gpost + 8 * lane + 512 * j, gp[j]);
        if (Udst) ld8f(g2 + 8 * lane + 512 * j, gg[j]);
    }
    int p0, np; wave_pair_range((rows - row0) / 2, gw, NGW, p0, np);
    int cur_b = -1;
    u32x4 yn[2][2], hn4[2][4];
    auto fetch = [&](int m0) __attribute__((always_inline)) {
#pragma unroll
        for (int r = 0; r < 2; ++r) {
            const int m = m0 + r;
#pragma unroll
            for (int j = 0; j < 2; ++j) yn[r][j] = *(const u32x4*)(Y + (size_t)m * DM + 8 * lane + 512 * j);
            if (first_layer_input) {
                const float* hsrc = m < ML ? p.in[0] + (size_t)m * DM : p.in[2] + (size_t)(m - ML) * DM;
#pragma unroll
                for (int j = 0; j < 2; ++j) { hn4[r][2 * j] = *(const u32x4*)(hsrc + 8 * lane + 512 * j); hn4[r][2 * j + 1] = *(const u32x4*)(hsrc + 8 * lane + 512 * j + 4); }
            } else {
#pragma unroll
                for (int j = 0; j < 2; ++j) hn4[r][2 * j] = *(const u32x4*)(HB + (size_t)m * DM + 8 * lane + 512 * j);
            }
        }
    };
    if (np > 0) fetch(row0 + 2 * p0);
    for (int i = 0; i < np; ++i) {
        const int m0 = row0 + 2 * (p0 + i);
        u32x4 yw[2][2]; float hv[2][2][8];
#pragma unroll
        for (int r = 0; r < 2; ++r)
#pragma unroll
            for (int j = 0; j < 2; ++j) {
                yw[r][j] = yn[r][j];
                if (first_layer_input) {
                    const u32x4 a = hn4[r][2 * j], b2 = hn4[r][2 * j + 1];
                    hv[r][j][0] = __uint_as_float(a.x); hv[r][j][1] = __uint_as_float(a.y); hv[r][j][2] = __uint_as_float(a.z); hv[r][j][3] = __uint_as_float(a.w);
                    hv[r][j][4] = __uint_as_float(b2.x); hv[r][j][5] = __uint_as_float(b2.y); hv[r][j][6] = __uint_as_float(b2.z); hv[r][j][7] = __uint_as_float(b2.w);
                } else unpack8(hn4[r][2 * j], hv[r][j]);
            }
        if (i + 1 < np) fetch(m0 + 2);
        const int bb = batch_of(m0);
        if (bb != cur_b) {
            cur_b = bb; const float* md = modp(p, layer, m0); const float* md2 = modp(p, nlayer, m0);
#pragma unroll
            for (int j = 0; j < 2; ++j) {
                ld8f(md + gate_chunk * 1024 + 8 * lane + 512 * j, gt[j]);
                if (Udst) { ld8f(md2 + nshift_chunk * 1024 + 8 * lane + 512 * j, sh[j]); ld8f(md2 + (nshift_chunk + 1) * 1024 + 8 * lane + 512 * j, scl[j]); }
            }
        }
#pragma unroll
        for (int r = 0; r < 2; ++r) {
            const int m = m0 + r;
            float yy[2][8]; float ss = 0.f;
#pragma unroll
            for (int j = 0; j < 2; ++j) {
                unpack8(yw[r][j], yy[j]);
#pragma unroll
                for (int e = 0; e < 8; ++e) ss += yy[j][e] * yy[j][e];
            }
            const float rstd = rsqrtf(wave_sum(ss) * (1.f / DM) + EPS);
            float hn[2][8]; float ss2 = 0.f;
#pragma unroll
            for (int j = 0; j < 2; ++j) {
                const int c = 8 * lane + 512 * j;
#pragma unroll
                for (int e = 0; e < 8; ++e) { hn[j][e] = hv[r][j][e] + gt[j][e] * (yy[j][e] * rstd * gp[j][e]); ss2 += hn[j][e] * hn[j][e]; }
                if (Udst) *(u32x4*)(HB + (size_t)m * DM + c) = pack8(hn[j]);
                else st8f(p.out + (size_t)m * DM + c, hn[j]);
            }
            if (Udst) {
                const float rstd2 = rsqrtf(wave_sum(ss2) * (1.f / DM) + EPS);
#pragma unroll
                for (int j = 0; j < 2; ++j) {
                    float o[8];
#pragma unroll
                    for (int e = 0; e < 8; ++e) o[e] = (hn[j][e] * rstd2 * gg[j][e]) * (1.f + scl[j][e]) + sh[j][e];
                    *(u32x4*)(Udst + (size_t)m * DM + 8 * lane + 512 * j) = pack8(o);
                }
            }
        }
    }
}

struct EpiSwiglu {
    static constexpr bool PERM = true, AFTER_DRAIN = false;
    bf16* O; int ldc;
    __device__ __forceinline__ void operator()(const pg8::f32x4 (&acc)[2][2][4][2], const pg8::Unit& u, int wr, int wc, int fr, int fq) const {
        const int row0 = u.pm * 256 + wr * 64 + fr; const int col0 = u.pn * 128 + wc * 32 + 8 * fq;
#pragma unroll
        for (int ai = 0; ai < 2; ++ai)
#pragma unroll
            for (int m = 0; m < 4; ++m) {
                bf16* rowp = O + (size_t)(row0 + ai * 128 + m * 16) * ldc + col0;
                const pg8::f32x4 g0 = acc[ai][0][m][0], g1 = acc[ai][0][m][1], u0 = acc[ai][1][m][0], u1 = acc[ai][1][m][1];
                u32x4 w;
                w.x = pk2(silu_f(g0[0]) * u0[0], silu_f(g0[1]) * u0[1]); w.y = pk2(silu_f(g0[2]) * u0[2], silu_f(g0[3]) * u0[3]);
                w.z = pk2(silu_f(g1[0]) * u1[0], silu_f(g1[1]) * u1[1]); w.w = pk2(silu_f(g1[2]) * u1[2], silu_f(g1[3]) * u1[3]);
                *(u32x4*)rowp = w;
            }
    }
};

DI void gemm_store_sub(unsigned char* lds, const bf16* A, const bf16* Bt, int M, int N, int K, bf16* O, int ldc, int wg0, int nwg) {
    pg8::Gemm g{A, Bt, M, N, K}; pg8::StaticOrder S; S.init(M, N, nwg, (int)blockIdx.x - wg0);
    pg8::EpiBf16<0> E{O, ldc, nullptr, 0, 0, 1.f};
    pg8::gemm_phase<pg8::EpiBf16<0>, pg8::StaticOrder, true, true>((PG8_LAS unsigned char*)lds, g, S, E);
}
DI void gemm_store(unsigned char* lds, const bf16* A, const bf16* Bt, int M, int N, int K, bf16* O, int ldc) {
    gemm_store_sub(lds, A, Bt, M, N, K, O, ldc, 0, (int)gridDim.x);
}
DI void sub_barrier(unsigned* cnt, unsigned n) {
    asm volatile("s_waitcnt vmcnt(0)" ::: "memory");
    __syncthreads();
    if (threadIdx.x == 0) {
        __threadfence();
        __hip_atomic_fetch_add(cnt, 1u, __ATOMIC_RELAXED, __HIP_MEMORY_SCOPE_AGENT);
        unsigned spins = 0;
        while (__hip_atomic_load(cnt, __ATOMIC_RELAXED, __HIP_MEMORY_SCOPE_AGENT) < n) { __builtin_amdgcn_s_sleep(2); if (++spins > (1u << 22)) break; }
        __threadfence();
        asm volatile("s_waitcnt vmcnt(0)" ::: "memory");
    }
    __syncthreads();
}
DI void gemm_swiglu(unsigned char* lds, const bf16* A, const bf16* Bt, int M, bf16* O) {
    pg8::Gemm g{A, Bt, M, 2 * DFF, DM}; pg8::StaticOrder S; S.init(M, 2 * DFF, (int)gridDim.x, (int)blockIdx.x);
    EpiSwiglu E{O, DFF};
    pg8::gemm_phase<EpiSwiglu, pg8::StaticOrder, true, true>((PG8_LAS unsigned char*)lds, g, S, E);
}

DI void phase_prep0(const KParams& p) {
    const int tid_ = tid_fresh(); const int lane = tid_ & 63, wave = tid_ >> 6;
    const int gw = blockIdx.x * NWAVES + wave, NGW = gridDim.x * NWAVES;
    const bf16* Z = (const bf16*)(p.ws + WS_Z);
    bf16* QKVC = (bf16*)p.out;
    float* GB = (float*)(p.ws + WS_GB);
    bf16* QN = (bf16*)(p.ws + WS_QN); bf16* KVN = (bf16*)(p.ws + WS_KVN); bf16* KPE = (bf16*)(p.ws + WS_KPE);
    const float* convw = p.in[15];
    const int rows_per_wave = (MT + NGW - 1) / NGW;
#pragma unroll 1
    for (int i = 0; i < 3; ++i) {
        float cw[5][8];
#pragma unroll
        for (int j = 0; j < 5; ++j)
#pragma unroll
            for (int e = 0; e < 8; ++e) cw[j][e] = convw[j * 1536 + 8 * (lane + 64 * i) + e];
        u32x4 wv[5], wn[3];
        for (int ri = 0; ri < rows_per_wave; ++ri) {
            const int m = gw * rows_per_wave + ri;
            if (m >= MT) break;
            int base, L, t;
            if (m < ML) { base = m & ~4095; L = 4096; t = m & 4095; } else { base = ML + ((m - ML) & ~255); L = 256; t = (m - ML) & 255; }
            const bf16* zc = Z + ZQKV + 8 * (lane + 64 * i);
            auto ldrow = [&](int pos) -> u32x4 { pos = pos < 0 ? 0 : (pos > L - 1 ? L - 1 : pos); return *(const u32x4*)(zc + (size_t)(base + pos) * NZ0); };
            if (ri == 0 || t == 0) {
#pragma unroll
                for (int j = 0; j < 5; ++j) wv[j] = ldrow(t + j - 2);
                wn[0] = ldrow(t + 3); wn[1] = ldrow(t + 4); wn[2] = ldrow(t + 5);
            } else {
#pragma unroll
                for (int j = 0; j < 4; ++j) wv[j] = wv[j + 1];
                wv[4] = wn[0]; wn[0] = wn[1]; wn[1] = wn[2];
                wn[2] = ldrow(t + 5);
            }
            float acc[8];
#pragma unroll
            for (int e = 0; e < 8; ++e) acc[e] = 0.f;
            if (t >= 2 && t < L - 2) {
#pragma unroll
                for (int j = 0; j < 5; ++j) {
                    float f[8]; unpack8(wv[j], f);
#pragma unroll
                    for (int e = 0; e < 8; ++e) acc[e] += cw[j][e] * f[e];
                }
            } else {
#pragma unroll
                for (int j = 0; j < 5; ++j) {
                    const int pos = t + j - 2;
                    const float valid = (pos >= 0 && pos < L) ? 1.f : 0.f;
                    float f[8]; unpack8(wv[j], f);
#pragma unroll
                    for (int e = 0; e < 8; ++e) acc[e] += (cw[j][e] * valid) * f[e];
                }
            }
            float ss = 0.f;
#pragma unroll
            for (int e = 0; e < 8; ++e) { acc[e] = acc[e] * __builtin_amdgcn_rcpf(1.f + __expf(-acc[e])); ss += acc[e] * acc[e]; }
            if (i < 2) {
                ss += __shfl_xor(ss, 1); ss += __shfl_xor(ss, 2); ss += __shfl_xor(ss, 4);
                const float inv = rsqrtf(ss + EPS) * (i == 0 ? 0.125f : 1.f);
#pragma unroll
                for (int e = 0; e < 8; ++e) acc[e] *= inv;
            }
            *(u32x4*)(QKVC + (size_t)m * 1536 + 8 * (lane + 64 * i)) = pack8(acc);
        }
    }
    {
        float nrm[8];
#pragma unroll
        for (int e = 0; e < 8; ++e) nrm[e] = lane < 32 ? p.in[19][8 * lane + e] : (lane < 48 ? p.in[21][8 * (lane - 32) + e] : 0.f);
        const float negA = lane < 16 ? -expf(p.in[16][lane]) : 0.f, dtb = lane < 16 ? p.in[17][lane] : 0.f;
        const int col1 = lane < 32 ? ZQD + 8 * lane : (lane < 48 ? ZKVD + 8 * (lane - 32) : ZKPE + 8 * (lane & 1));
        const int col2 = ZKPE + 16 + 8 * (lane & 1);
        const int colg = lane < 16 ? lane : 0;
        u32x4 d1n, d2n; bf16 zan, zbn;
        auto fetch = [&](int m) { const bf16* zr = Z + (size_t)m * NZ0; d1n = *(const u32x4*)(zr + col1); d2n = *(const u32x4*)(zr + col2); zan = zr[ZA + colg]; zbn = zr[ZBT + colg]; };
        const int mfirst = gw * rows_per_wave;
        if (mfirst < MT) fetch(mfirst);
        for (int ri = 0; ri < rows_per_wave; ++ri) {
            const int m = mfirst + ri;
            if (m >= MT) break;
            const int t = m < ML ? (m & 4095) : ((m - ML) & 255);
            const u32x4 d1 = d1n, d2 = d2n; const bf16 za = zan, zb = zbn;
            if (ri + 1 < rows_per_wave && m + 1 < MT) fetch(m + 1);
            if (lane < 16) {
                GB[(size_t)m * 32 + lane] = negA * softplus_f(bf2f(za) + dtb);
                GB[(size_t)m * 32 + 16 + lane] = __builtin_amdgcn_rcpf(1.f + __expf(-bf2f(zb)));
            }
            float f[8]; unpack8(d1, f);
            float ss = 0.f;
#pragma unroll
            for (int e = 0; e < 8; ++e) ss += f[e] * f[e];
            const float sq = wave_sum(lane < 32 ? ss : 0.f), skv = wave_sum((lane >= 32 && lane < 48) ? ss : 0.f);
            if (lane < 48) {
                const float r = lane < 32 ? rsqrtf(sq * (1.f / 256.f) + EPS) : rsqrtf(skv * (1.f / 128.f) + EPS);
#pragma unroll
                for (int e = 0; e < 8; ++e) f[e] = f[e] * r * nrm[e];
                if (lane < 32) *(u32x4*)(QN + (size_t)m * 256 + 8 * lane) = pack8(f);
                else *(u32x4*)(KVN + (size_t)m * 128 + 8 * (lane - 32)) = pack8(f);
            } else if (lane < 50) {
                const int hh = lane - 48;
                float x2[8]; unpack8(d2, x2);
                if (m < ML) {
                    const float2* rt = (const float2*)(p.ws + WS_ROPE8) + (hh ? (t & 63) : (t >> 6)) * 8;
#pragma unroll
                    for (int e = 0; e < 8; ++e) {
                        const float2 cssn = rt[e]; const float cs = cssn.x, sn = cssn.y;
                        const float a = f[e], b2 = x2[e];
                        f[e] = a * cs - b2 * sn; x2[e] = b2 * cs + a * sn;
                    }
                }
                *(u32x4*)(KPE + (size_t)m * 32 + 8 * hh) = pack8(f);
                *(u32x4*)(KPE + (size_t)m * 32 + 16 + 8 * hh) = pack8(x2);
            }
        }
    }
}

DI void phase_prep1(const KParams& p) {
    const int tid_ = tid_fresh(); const int lane = tid_ & 63, wave = tid_ >> 6;
    const int gw = blockIdx.x * NWAVES + wave, NGW = gridDim.x * NWAVES;
    const bf16* Z = (const bf16*)(p.ws + WS_Z);
    bf16* GKV = (bf16*)(p.ws + WS_GKV);
    const float* kn = p.in[27];
    const int l32 = lane & 31, l16 = lane & 15, q8 = lane & 7, rsub = lane >> 5;
    const bool isv = l32 >= 16;
    const int fbase = (8 * (q8 & 3)) & 15;
    const bool use_col = (q8 & 3) >= 2;
    float gk[8];
#pragma unroll
    for (int e = 0; e < 8; ++e) gk[e] = kn[8 * q8 + e];
    for (int m0 = 2 * gw; m0 < MT; m0 += 2 * NGW) {
        const int m = m0 + rsub;
        const bool lat = m < ML;
        const int t = m & 4095;
        const u32x4 raw = *(const u32x4*)(Z + (size_t)m * NZ1 + (isv ? Z1_GV : Z1_GK) + 8 * l16);
        float f[8]; unpack8(raw, f);
        float ss = 0.f;
#pragma unroll
        for (int e = 0; e < 8; ++e) ss += f[e] * f[e];
        ss += __shfl_xor(ss, 1); ss += __shfl_xor(ss, 2); ss += __shfl_xor(ss, 4);
        const float r = rsqrtf(ss * (1.f / 64.f) + EPS);
#pragma unroll
        for (int e = 0; e < 8; ++e) f[e] = f[e] * r * gk[e];
        float o[8];
        const float2* rt = (const float2*)(p.ws + WS_ROPE16) + (use_col ? (t & 63) : (t >> 6)) * 16 + fbase;
#pragma unroll
        for (int e = 0; e < 8; ++e) {
            const float other = __shfl_xor(f[e], 4);
            const float2 v = rt[e];
            o[e] = (q8 < 4) ? f[e] * v.x - other * v.y : f[e] * v.x + other * v.y;
        }
        if (lat) {
#pragma unroll
            for (int e = 0; e < 8; ++e) f[e] = o[e];
        }
        *(u32x4*)(GKV + (size_t)m * 256 + 8 * l32) = isv ? raw : pack8(f);
    }
}

DI void gdn_combine_run(const KParams& p, int p0, int np) {
    const int tid_ = tid_fresh(); const int lane = tid_ & 63;
    const bf16* Z = (const bf16*)(p.ws + WS_Z);
    bf16* MIX = (bf16*)(p.ws + WS_U);
    float on[8];
#pragma unroll
    for (int e = 0; e < 8; ++e) on[e] = p.in[18][8 * (lane & 7) + e];
    u32x4 wa[2], wb[2], wg[2], na[2], nb[2], ng[2];
    auto fetch = [&](int m0, u32x4 (&xa)[2], u32x4 (&xb)[2], u32x4 (&xg)[2]) __attribute__((always_inline)) {
#pragma unroll
        for (int r = 0; r < 2; ++r) {
            const int m = m0 + r;
            const bf16* obp = m < OB_SPLIT ? (const bf16*)((const unsigned char*)p.out + OUT_OBLO) + (size_t)m * 512 : (const bf16*)(p.ws + WS_OBHI) + (size_t)(m - OB_SPLIT) * 512;
            xa[r] = *(const u32x4*)(MIX + (size_t)m * DM + 8 * lane);
            xb[r] = *(const u32x4*)(obp + 8 * lane);
            xg[r] = *(const u32x4*)(Z + (size_t)m * NZ0 + ZGATE + 8 * lane);
        }
    };
    if (np > 0) fetch(2 * p0, na, nb, ng);
    for (int i = 0; i < np; ++i) {
        const int m0 = 2 * (p0 + i);
#pragma unroll
        for (int r = 0; r < 2; ++r) { wa[r] = na[r]; wb[r] = nb[r]; wg[r] = ng[r]; }
        if (i + 1 < np) fetch(m0 + 2, na, nb, ng);
#pragma unroll
        for (int r = 0; r < 2; ++r) {
            const int m = m0 + r;
            float a[8], b2[8], g[8];
            unpack8(wa[r], a); unpack8(wb[r], b2); unpack8(wg[r], g);
            float ss = 0.f;
#pragma unroll
            for (int e = 0; e < 8; ++e) { a[e] += b2[e]; ss += a[e] * a[e]; }
            ss += __shfl_xor(ss, 1); ss += __shfl_xor(ss, 2); ss += __shfl_xor(ss, 4);
            const float rr = rsqrtf(ss * (1.f / 64.f) + EPS);
#pragma unroll
            for (int e = 0; e < 8; ++e) a[e] = a[e] * rr * on[e] * (g[e] * __builtin_amdgcn_rcpf(1.f + __expf(-g[e])));
            *(u32x4*)(MIX + (size_t)m * DM + 8 * lane) = pack8(a);
        }
    }
}
DI void phase_gdn_combine(const KParams& p) {
    const int tid_ = tid_fresh(); const int wave = tid_ >> 6;
    int p0, np; wave_pair_range(MT / 2, blockIdx.x * NWAVES + wave, gridDim.x * NWAVES, p0, np);
    gdn_combine_run(p, p0, np);
}

DI int gdn_row(int b, int dir, int ci, int i) {
    if (ci < 4) { int s = 64 * ci + i; if (dir) s = 255 - s; return ML + b * 256 + s; }
    int t = 64 * (ci - 4) + i; if (dir) t = 4095 - t; return b * 4096 + t;
}
DI float wave_incl_scan(float x, int lane) {
#pragma unroll
    for (int off = 1; off < 64; off <<= 1) { const float v = __shfl_up(x, off); if (lane >= off) x += v; }
    return x;
}


constexpr int tinv_segidx(int i, int sg) { return ((i <= 33) ? i : 33 + 2 * (i - 33)) + sg; }
constexpr int tinv_nseg(int i) { return (i > 32) ? 2 : 1; }
template <int I>
DI void tinv_step(float (&acc)[64], const float* Mt) {
    if constexpr (I < 63) {
        typedef float f32x2p __attribute__((ext_vector_type(2)));
        const float ti = acc[I];
        const f32x2p nt2 = {-ti, -ti};
#pragma unroll
        for (int jq = (I + 1) / 4; jq < 16; ++jq) {
            const f32x4 mv = *(const f32x4*)(Mt + I * 64 + 4 * jq);
            const int r0 = 4 * jq;
            if (r0 > I) {
                f32x2p a01 = {acc[r0], acc[r0 + 1]}, a23 = {acc[r0 + 2], acc[r0 + 3]};
                a01 = __builtin_elementwise_fma((f32x2p){mv.x, mv.y}, nt2, a01);
                a23 = __builtin_elementwise_fma((f32x2p){mv.z, mv.w}, nt2, a23);
                acc[r0] = a01.x; acc[r0 + 1] = a01.y; acc[r0 + 2] = a23.x; acc[r0 + 3] = a23.y;
            } else {
                if (r0 + 1 > I) acc[r0 + 1] -= mv.y * ti;
                if (r0 + 2 > I) acc[r0 + 2] -= mv.z * ti;
                if (r0 + 3 > I) acc[r0 + 3] -= mv.w * ti;
            }
        }
        tinv_step<I + 1>(acc, Mt);
    }
}

template <int I>
DI void tinv32_step(float (&acc)[32], const float* blk) {
    if constexpr (I < 31) {
        typedef float f32x2p __attribute__((ext_vector_type(2)));
        const float ti = acc[I];
        const f32x2p nt2 = {-ti, -ti};
#pragma unroll
        for (int jq = (I + 1) / 4; jq < 8; ++jq) {
            const f32x4 mv = *(const f32x4*)(blk + I * 32 + 4 * jq);
            const int r0 = 4 * jq;
            if (r0 > I) {
                f32x2p a01 = {acc[r0], acc[r0 + 1]}, a23 = {acc[r0 + 2], acc[r0 + 3]};
                a01 = __builtin_elementwise_fma((f32x2p){mv.x, mv.y}, nt2, a01);
                a23 = __builtin_elementwise_fma((f32x2p){mv.z, mv.w}, nt2, a23);
                acc[r0] = a01.x; acc[r0 + 1] = a01.y; acc[r0 + 2] = a23.x; acc[r0 + 3] = a23.y;
            } else {
                if (r0 + 1 > I) acc[r0 + 1] -= mv.y * ti;
                if (r0 + 2 > I) acc[r0 + 2] -= mv.z * ti;
                if (r0 + 3 > I) acc[r0 + 3] -= mv.w * ti;
            }
        }
        tinv32_step<I + 1>(acc, blk);
    }
}

DI void phase_tinv(const KParams& p, unsigned char* lds, bool dry = false) {
    const int tid_ = tid_fresh(); const int lane = tid_ & 63, wave = tid_ >> 6, r32 = lane & 31, hi = lane >> 5;
    const int gw = blockIdx.x * NWAVES + wave, NGW = gridDim.x * NWAVES;
    float* Mw = (float*)(lds + wave * 17408);
    float* gcs = Mw + 4096; float* bts = gcs + 64;
    const bf16* QKVC = (const bf16*)p.out;
    const float* GB = (const float*)(p.ws + WS_GB);
    bf16* TINV = (bf16*)(p.ws + WS_TINV);
    unsigned* lctr = (unsigned*)(lds + NWAVES * 17408);
    if (threadIdx.x == 0) *lctr = 0u;
    __syncthreads();
    const int per_wg = (8704 + (int)gridDim.x - 1) / (int)gridDim.x;
    auto grab = [&]() -> int {
        int li = 0;
        if (lane == 0) li = (int)__hip_atomic_fetch_add(lctr, 1u, __ATOMIC_RELAXED, __HIP_MEMORY_SCOPE_WORKGROUP);
        li = __builtin_amdgcn_readfirstlane(li);
        const int inst = (int)blockIdx.x * per_wg + li;
        return (li < per_wg && inst < 8704) ? inst : -1;
    };
    bf16x8 kfN[2][4]; float giN = 0.f, biN = 0.f;
    auto issue = [&](int inst) __attribute__((always_inline)) {
        const int ci = inst % 68, bhd = inst / 68, dir = bhd & 1, h = (bhd >> 1) & 7, b = bhd >> 4;
        const int mi = gdn_row(b, dir, ci, lane);
        giN = GB[(size_t)mi * 32 + dir * 8 + h]; biN = GB[(size_t)mi * 32 + 16 + dir * 8 + h];
#pragma unroll
        for (int a = 0; a < 2; ++a) {
            const int mt = gdn_row(b, dir, ci, 32 * a + r32);
#pragma unroll
            for (int s = 0; s < 4; ++s) kfN[a][s] = *(const bf16x8*)(QKVC + (size_t)mt * 1536 + 512 + h * 64 + 16 * s + 8 * hi);
        }
    };
    int inst = grab();
    if (inst >= 0) issue(inst);
    while (inst >= 0) {
        const int ci = inst % 68, bhd = inst / 68, dir = bhd & 1, h = (bhd >> 1) & 7, b = bhd >> 4;
        const int mi = gdn_row(b, dir, ci, lane);
        const float gi = giN, bi = biN;
        const float gc = wave_incl_scan(gi, lane);
        gcs[lane] = gc; bts[lane] = bi;
        if (!dry) ((float*)(p.ws + WS_GB))[(size_t)mi * 32 + dir * 8 + h] = gc;
        bf16x8 kf[2][4];
#pragma unroll
        for (int a = 0; a < 2; ++a)
#pragma unroll
            for (int s = 0; s < 4; ++s) kf[a][s] = kfN[a][s];
        f32x16 g00, g10, g11;
#pragma unroll
        for (int r = 0; r < 16; ++r) { g00[r] = 0.f; g10[r] = 0.f; g11[r] = 0.f; }
#pragma unroll
        for (int s = 0; s < 4; ++s) {
            g00 = __builtin_amdgcn_mfma_f32_32x32x16_bf16(kf[0][s], kf[0][s], g00, 0, 0, 0);
            g10 = __builtin_amdgcn_mfma_f32_32x32x16_bf16(kf[0][s], kf[1][s], g10, 0, 0, 0);
            g11 = __builtin_amdgcn_mfma_f32_32x32x16_bf16(kf[1][s], kf[1][s], g11, 0, 0, 0);
        }
        const int inst_next = grab();
        if (inst_next >= 0) issue(inst_next);
        asm volatile("s_waitcnt lgkmcnt(0)" ::: "memory");
        float* blk11 = Mw; float* blk22 = Mw + 1024;
        unsigned char* m21img = (unsigned char*)(Mw + 2048);
        unsigned char* t11img = m21img + 2560;
        {
            const int i0 = r32, i1 = 32 + r32;
            const float b0 = bts[i0], b1 = bts[i1], gc0 = gcs[i0], gc1 = gcs[i1];
#pragma unroll
            for (int r = 0; r < 16; ++r) {
                const int j0 = crow(r, hi), j1 = 32 + j0;
                blk11[j0 * 32 + r32] = (i0 > j0) ? b0 * g00[r] * __expf(gc0 - gcs[j0]) : 0.f;
                blk22[j0 * 32 + r32] = (i1 > j1) ? b1 * g11[r] * __expf(gc1 - gcs[j1]) : 0.f;
                *(bf16*)(m21img + r32 * 80 + j0 * 2) = f2bf(b1 * g10[r] * __expf(gc1 - gcs[j0]));
            }
        }
        asm volatile("s_waitcnt lgkmcnt(0)" ::: "memory");
        float T[32];
#pragma unroll
        for (int r = 0; r < 32; ++r) T[r] = (r32 == r) ? 1.f : 0.f;
        tinv32_step<0>(T, hi ? blk22 : blk11);
        if (hi == 0) {
#pragma unroll
            for (int q = 0; q < 4; ++q) *(u32x4*)(t11img + r32 * 80 + q * 16) = pack8(&T[8 * q]);
        }
        asm volatile("s_waitcnt lgkmcnt(0)" ::: "memory");
        f32x16 X;
#pragma unroll
        for (int r = 0; r < 16; ++r) X[r] = 0.f;
#pragma unroll
        for (int s = 0; s < 2; ++s) {
            const bf16x8 af = *(const bf16x8*)(m21img + r32 * 80 + (16 * s + 8 * hi) * 2);
            const bf16x8 bfr = *(const bf16x8*)(t11img + r32 * 80 + (16 * s + 8 * hi) * 2);
            X = __builtin_amdgcn_mfma_f32_32x32x16_bf16(af, bfr, X, 0, 0, 0);
        }
        bf16* Tb = (bf16*)Mw;
#pragma unroll
        for (int r = 0; r < 32; ++r) Tb[(32 * hi + r) * 64 + 32 * hi + r32] = f2bf(T[r]);
        {
            const u32x4 z4 = {0u, 0u, 0u, 0u};
#pragma unroll
            for (int q = 0; q < 2; ++q) { const int idx = q * 64 + lane; *(u32x4*)(Tb + (idx >> 2) * 64 + 32 + (idx & 3) * 8) = z4; }
        }
        asm volatile("s_waitcnt lgkmcnt(0)" ::: "memory");
        f32x16 Y;
#pragma unroll
        for (int r = 0; r < 16; ++r) Y[r] = 0.f;
#pragma unroll
        for (int s = 0; s < 2; ++s) {
            const bf16* trow = Tb + (32 + r32) * 64 + 32 + 16 * s + 4 * hi;
            const u32x2 a_lo = *(const u32x2*)(trow), a_hi = *(const u32x2*)(trow + 8);
            const u32x4 aw = {a_lo.x, a_lo.y, a_hi.x, a_hi.y};
            const u32x4 bw = {pk2(X[8 * s + 0], X[8 * s + 1]), pk2(X[8 * s + 2], X[8 * s + 3]), pk2(X[8 * s + 4], X[8 * s + 5]), pk2(X[8 * s + 6], X[8 * s + 7])};
            Y = __builtin_amdgcn_mfma_f32_32x32x16_bf16(__builtin_bit_cast(bf16x8, aw), __builtin_bit_cast(bf16x8, bw), Y, 0, 0, 0);
        }
#pragma unroll
        for (int r = 0; r < 16; ++r) Tb[(32 + crow(r, hi)) * 64 + r32] = f2bf(-Y[r]);
        asm volatile("s_waitcnt lgkmcnt(0)" ::: "memory");
#pragma unroll
        for (int q = 0; q < 8; ++q) {
            const u32x4 v = *(const u32x4*)(Tb + (q * 64 + lane) * 8);
            if (!dry) *(u32x4*)(TINV + (size_t)inst * 4096 + (q * 64 + lane) * 8) = v; else asm volatile("" :: "v"(v));
        }
        asm volatile("s_waitcnt lgkmcnt(0)" ::: "memory");
        inst = inst_next;
    }
}

constexpr int GP = 144;
constexpr int GIMG = 64 * GP;
constexpr int G_CB = 5 * GIMG;
constexpr int G_QK = 0, G_KDT = GIMG, G_T = 2 * GIMG, G_KBGT = 3 * GIMG, G_VBT = 4 * GIMG;
constexpr int G_Q = 2 * G_CB;
constexpr int G_K = G_Q + GIMG;
constexpr int G_ARR = G_K + GIMG;
static_assert(G_ARR + 2 * 1024 <= LDS_BYTES - 64, "GDN scan LDS map");

#define LDS_BAR() do { asm volatile("s_waitcnt lgkmcnt(0)" ::: "memory"); __builtin_amdgcn_s_barrier(); asm volatile("" ::: "memory"); } while (0)
DI bf16x8 ldsfrag(const unsigned char* base, int row, int colbyte) { return *(const bf16x8*)(base + row * GP + colbyte); }
typedef short gv4i16_t __attribute__((ext_vector_type(4)));
DI bf16x8 trfrag(const unsigned char* img, int k0, int k1, int n0, int l15) {
    const int q = l15 >> 2, pp = l15 & 3;
    const unsigned char* a = img + (k0 + q) * GP + (n0 + 4 * pp) * 2;
    const unsigned char* b2 = img + (k1 + q) * GP + (n0 + 4 * pp) * 2;
    const s16x4 lo = __builtin_bit_cast(s16x4, __builtin_amdgcn_ds_read_tr16_b64_v4i16((__attribute__((address_space(3))) gv4i16_t*)a));
    const s16x4 hi4 = __builtin_bit_cast(s16x4, __builtin_amdgcn_ds_read_tr16_b64_v4i16((__attribute__((address_space(3))) gv4i16_t*)b2));
    const bf16x8 r = {lo[0], lo[1], lo[2], lo[3], hi4[0], hi4[1], hi4[2], hi4[3]};
    return r;
}
DI bf16x8 ldsfrag_perm(const unsigned char* base, int row, int c0) {
    const u32x2 a = *(const u32x2*)(base + row * GP + c0 * 2), b2 = *(const u32x2*)(base + row * GP + (c0 + 16) * 2);
    const u32x4 w = {a.x, a.y, b2.x, b2.y};
    return __builtin_bit_cast(bf16x8, w);
}
typedef float f32x4v __attribute__((ext_vector_type(4)));
DI bf16x8 pack_b(const f32x4v& lo, const f32x4v& hi4) {
    const u32x4 w = {pk2(lo[0], lo[1]), pk2(lo[2], lo[3]), pk2(hi4[0], hi4[1]), pk2(hi4[2], hi4[3])};
    return __builtin_bit_cast(bf16x8, w);
}

#ifdef SCAN_PROBE_A
#define SCAN_REP_A(x) do { asm volatile("" ::: "memory"); x; } while (0)
#else
#define SCAN_REP_A(x) do { } while (0)
#endif
#ifdef SCAN_PROBE_B
#define SCAN_REP_B(x) do { asm volatile("" ::: "memory"); x; } while (0)
#else
#define SCAN_REP_B(x) do { } while (0)
#endif
DI void gdn_scan_unit(const KParams& p, int b, int h, int dir, unsigned char* lds) {
    const int tid = tid_fresh(), lane = tid & 63, wid = tid >> 6, l15 = lane & 15, lq = lane >> 4;
    const bf16* QKVC = (const bf16*)p.out;
    const float* GB = (const float*)(p.ws + WS_GB);
    const bf16* TINV = (const bf16*)(p.ws + WS_TINV);
    const size_t inst0 = (size_t)((b * 8 + h) * 2 + dir) * 68;
    __syncthreads();
    if (wid >= 4) {
        const int ptid = tid - 256, pw = wid - 4;
        struct PF { u32x4 rq[2], rk[2], rv[2], rt[2]; float rg, rb; };
        PF RA, RB;
        auto prefetch = [&](int ci, PF& R) __attribute__((always_inline)) {
#pragma unroll
            for (int e = 0; e < 2; ++e) {
                const int pi = ptid + 256 * e, sj = pi >> 3, sp = pi & 7;
                const int mj = gdn_row(b, dir, ci, sj);
                const bf16* src = QKVC + (size_t)mj * 1536 + h * 64 + 8 * sp;
                R.rq[e] = *(const u32x4*)(src); R.rk[e] = *(const u32x4*)(src + 512); R.rv[e] = *(const u32x4*)(src + 1024);
                R.rt[e] = *(const u32x4*)(TINV + (inst0 + ci) * 4096 + sj * 64 + 8 * sp);
            }
            const int mi = gdn_row(b, dir, ci, lane);
            R.rg = GB[(size_t)mi * 32 + dir * 8 + h]; R.rb = GB[(size_t)mi * 32 + 16 + dir * 8 + h];
        };
        auto stage = [&](int ci, const PF& R) __attribute__((always_inline)) {
            unsigned char* cb = lds + (ci & 1) * G_CB;
            float* gcA = (float*)(lds + G_ARR + (ci & 1) * 1024); float* btA = gcA + 64; float* egA = btA + 64;
            const float gsc = R.rg;
            const float gcl = __shfl(gsc, 63);
#pragma unroll
            for (int e = 0; e < 2; ++e) {
                const int pi = ptid + 256 * e, sj = pi >> 3, sp = pi & 7;
                const float gcj = __shfl(gsc, sj), btj = __shfl(R.rb, sj);
                *(u32x4*)(lds + G_Q + sj * GP + sp * 16) = R.rq[e];
                *(u32x4*)(lds + G_K + sj * GP + sp * 16) = R.rk[e];
                *(u32x4*)(cb + G_T + sj * GP + sp * 16) = R.rt[e];
                float kf8[8], vf8[8], kb8[8], kd8[8]; unpack8(R.rk[e], kf8); unpack8(R.rv[e], vf8);
                const float ekb = btj * __expf(gcj), ekd = __expf(gcl - gcj);
#pragma unroll
                for (int x = 0; x < 8; ++x) { kb8[x] = -(kf8[x] * ekb); kd8[x] = kf8[x] * ekd; vf8[x] *= btj; }
                *(u32x4*)(cb + G_KBGT + sj * GP + sp * 16) = pack8(kb8);
                *(u32x4*)(cb + G_KDT + sj * GP + sp * 16) = pack8(kd8);
                *(u32x4*)(cb + G_VBT + sj * GP + sp * 16) = pack8(vf8);
            }
            if (pw == 0) { gcA[lane] = gsc; btA[lane] = R.rb; egA[lane] = __expf(gsc); }
        };
        auto mma_step = [&](int ci) {
            unsigned char* cb = lds + (ci & 1) * G_CB;
            const float* gcA = (const float*)(lds + G_ARR + (ci & 1) * 1024);
            const int mt = pw;
            const bf16x8 qb0 = ldsfrag(lds + G_Q, 16 * mt + l15, 16 * lq), qb1 = ldsfrag(lds + G_Q, 16 * mt + l15, 64 + 16 * lq);
            const int icol = 16 * mt + l15;
            const float gci = gcA[icol];
#pragma unroll
            for (int nt = 0; nt < 4; ++nt) {
                f32x4v acc = {0.f, 0.f, 0.f, 0.f};
                if (nt <= mt) {
                    const bf16x8 a0 = ldsfrag(lds + G_K, 16 * nt + l15, 16 * lq), a1 = ldsfrag(lds + G_K, 16 * nt + l15, 64 + 16 * lq);
                    acc = __builtin_amdgcn_mfma_f32_16x16x32_bf16(a0, qb0, acc, 0, 0, 0);
                    acc = __builtin_amdgcn_mfma_f32_16x16x32_bf16(a1, qb1, acc, 0, 0, 0);
                }
                float v[4];
#pragma unroll
                for (int r = 0; r < 4; ++r) { const int j = 16 * nt + 4 * lq + r; v[r] = (icol >= j) ? acc[r] * __expf(gci - gcA[j]) : 0.f; }
                u32x2 w; w.x = pk2(v[0], v[1]); w.y = pk2(v[2], v[3]);
                *(u32x2*)(cb + G_QK + icol * GP + (16 * nt + 4 * lq) * 2) = w;
            }
        };
        prefetch(0, RA); prefetch(1, RB);
        stage(0, RA);
        prefetch(2, RA);
        LDS_BAR();
        mma_step(0);
        LDS_BAR();
        for (int k = 0; k < 68; k += 2) {
            stage(k + 1, RB); SCAN_REP_A(stage(k + 1, RB)); if (k + 3 < 68) prefetch(k + 3, RB);
            LDS_BAR();
            mma_step(k + 1); SCAN_REP_B(mma_step(k + 1));
            LDS_BAR();
            if (k + 2 < 68) { stage(k + 2, RA); SCAN_REP_A(stage(k + 2, RA)); if (k + 4 < 68) prefetch(k + 4, RA); }
            LDS_BAR();
            if (k + 2 < 68) { mma_step(k + 2); SCAN_REP_B(mma_step(k + 2)); }
            LDS_BAR();
        }
    } else {
        f32x4v sacc[4];
#pragma unroll
        for (int mt = 0; mt < 4; ++mt) sacc[mt] = (f32x4v){0.f, 0.f, 0.f, 0.f};
        const int rstep = dir ? -1 : 1;
        bf16x8 qfr[4][2];
        auto load_q = [&]() {
#pragma unroll
            for (int mt = 0; mt < 4; ++mt)
#pragma unroll
                for (int ks = 0; ks < 2; ++ks) qfr[mt][ks] = ldsfrag_perm(lds + G_Q, 16 * mt + l15, 32 * ks + 4 * lq);
        };
        LDS_BAR();
        LDS_BAR();
        load_q();
        for (int k = 0; k < 68; ++k) {
            const unsigned char* cb = lds + (k & 1) * G_CB;
            const float* gcA = (const float*)(lds + G_ARR + (k & 1) * 1024); const float* egA = gcA + 128;
            const float gl = __expf(gcA[63]);
            const bf16x8 sb0 = pack_b(sacc[0], sacc[1]), sb1 = pack_b(sacc[2], sacc[3]);
            f32x4v rr[4], vn[4];
#pragma unroll
            for (int mt = 0; mt < 4; ++mt) {
                const int q = l15 >> 2, pp = l15 & 3;
                const s16x4 vw = __builtin_bit_cast(s16x4, __builtin_amdgcn_ds_read_tr16_b64_v4i16((__attribute__((address_space(3))) gv4i16_t*)(cb + G_VBT + (16 * mt + 4 * lq + q) * GP + (16 * wid + 4 * pp) * 2)));
                f32x4v acc = {bf2f((bf16)vw[0]), bf2f((bf16)vw[1]), bf2f((bf16)vw[2]), bf2f((bf16)vw[3])};
                acc = __builtin_amdgcn_mfma_f32_16x16x32_bf16(ldsfrag_perm(cb + G_KBGT, 16 * mt + l15, 4 * lq), sb0, acc, 0, 0, 0);
                acc = __builtin_amdgcn_mfma_f32_16x16x32_bf16(ldsfrag_perm(cb + G_KBGT, 16 * mt + l15, 32 + 4 * lq), sb1, acc, 0, 0, 0);
                rr[mt] = acc;
            }
            const bf16x8 rb0 = pack_b(rr[0], rr[1]), rb1 = pack_b(rr[2], rr[3]);
#pragma unroll
            for (int mt = 0; mt < 4; ++mt) {
                f32x4v acc = {0.f, 0.f, 0.f, 0.f};
                acc = __builtin_amdgcn_mfma_f32_16x16x32_bf16(ldsfrag_perm(cb + G_T, 16 * mt + l15, 4 * lq), rb0, acc, 0, 0, 0);
                acc = __builtin_amdgcn_mfma_f32_16x16x32_bf16(ldsfrag_perm(cb + G_T, 16 * mt + l15, 32 + 4 * lq), rb1, acc, 0, 0, 0);
                vn[mt] = acc;
            }
            const bf16x8 vb0 = pack_b(vn[0], vn[1]), vb1 = pack_b(vn[2], vn[3]);
#pragma unroll
            for (int mt = 0; mt < 4; ++mt) {
                f32x4v sn = sacc[mt] * gl;
                sn = __builtin_amdgcn_mfma_f32_16x16x32_bf16(trfrag(cb + G_KDT, 4 * lq, 16 + 4 * lq, 16 * mt, l15), vb0, sn, 0, 0, 0);
                sn = __builtin_amdgcn_mfma_f32_16x16x32_bf16(trfrag(cb + G_KDT, 32 + 4 * lq, 48 + 4 * lq, 16 * mt, l15), vb1, sn, 0, 0, 0);
                sacc[mt] = sn;
            }
            f32x4v oo[4];
#pragma unroll
            for (int mt = 0; mt < 4; ++mt) {
                f32x4v o = {0.f, 0.f, 0.f, 0.f};
                o = __builtin_amdgcn_mfma_f32_16x16x32_bf16(qfr[mt][0], sb0, o, 0, 0, 0);
                o = __builtin_amdgcn_mfma_f32_16x16x32_bf16(qfr[mt][1], sb1, o, 0, 0, 0);
#pragma unroll
                for (int r = 0; r < 4; ++r) o[r] *= egA[16 * mt + 4 * lq + r];
                o = __builtin_amdgcn_mfma_f32_16x16x32_bf16(ldsfrag_perm(cb + G_QK, 16 * mt + l15, 4 * lq), vb0, o, 0, 0, 0);
                o = __builtin_amdgcn_mfma_f32_16x16x32_bf16(ldsfrag_perm(cb + G_QK, 16 * mt + l15, 32 + 4 * lq), vb1, o, 0, 0, 0);
                oo[mt] = o;
            }
            LDS_BAR();
            if (k + 1 < 68) load_q();
            {
                const int m0 = gdn_row(b, dir, k, 0);
                bf16* ob; long pitch;
                if (dir == 0) { ob = (bf16*)(p.ws + WS_U) + (long)m0 * 1024; pitch = 1024; }
                else if (m0 < OB_SPLIT) { ob = (bf16*)((unsigned char*)p.out + OUT_OBLO) + (long)m0 * 512; pitch = 512; }
                else { ob = (bf16*)(p.ws + WS_OBHI) + (long)(m0 - OB_SPLIT) * 512; pitch = 512; }
                bf16* op = ob + (long)rstep * (4 * lq) * pitch + h * 64 + 16 * wid + l15;
                const long rsp = (long)rstep * pitch;
#pragma unroll
                for (int mt = 0; mt < 4; ++mt)
#pragma unroll
                    for (int r = 0; r < 4; ++r) op[rsp * (16 * mt + r)] = f2bf(oo[mt][r]);
#ifdef SCAN_PROBE_D
                asm volatile("" ::: "memory");
#pragma unroll
                for (int mt = 0; mt < 4; ++mt)
#pragma unroll
                    for (int r = 0; r < 4; ++r) op[rsp * (16 * mt + r)] = f2bf(oo[mt][r]);
#endif
            }
            LDS_BAR();
        }
    }
}


template <int MODE> struct AttnCfg { static constexpr int DQK = (MODE <= 1) ? 96 : 64; };
typedef short v4i16_t __attribute__((ext_vector_type(4)));
DI s16x4 lds_tr16(const unsigned char* p) { return __builtin_bit_cast(s16x4, __builtin_amdgcn_ds_read_tr16_b64_v4i16((__attribute__((address_space(3))) v4i16_t*)p)); }
DI float fmax3(float a, float b, float c) { return __builtin_fmaxf(__builtin_fmaxf(a, b), c); }
#ifndef ATT_THR_VAL
#define ATT_THR_VAL 8.f
#endif
constexpr float ATT_THR = ATT_THR_VAL;

template <int MODE>
DI void attn_unit(const KParams& p, int b, int h, int qb, unsigned char* lds) {
    constexpr int DQK = AttnCfg<MODE>::DQK, NS = DQK / 16;
    constexpr int KP = DQK * 2 + 16;
    constexpr int VP = 64 * 2 + 16;
    constexpr int KBUF = 64 * KP, VBUF = 64 * VP, BUF = KBUF + VBUF;
    constexpr int KCH = DQK / 8;
    const int tid = tid_fresh(), lane = tid & 63, wid = tid >> 6, r32 = lane & 31, hi = lane >> 5;
    float* rpbL = (float*)(lds + 3 * BUF);

    int mq;
    int qr = 0, qc = 0;
    if (MODE == 0 || MODE == 2) mq = b * 4096 + qb * 256 + wid * 32 + r32;
    else if (MODE == 1) mq = ML + b * 256 + wid * 32 + r32;
    else { qr = 4 * qb + (wid >> 1); qc = 32 * (wid & 1) + r32; mq = b * 4096 + qr * 64 + qc; }
    const bf16* Qp; float sl2;
    if (MODE <= 1) { Qp = (const bf16*)(p.ws + WS_QMLA) + (size_t)mq * 768 + h * 96; sl2 = 0.10206207261596577f * LOG2E; }
    else if (MODE == 2) { Qp = (const bf16*)(p.ws + WS_Z) + (size_t)mq * NZ1 + Z1_GQ + h * 64; sl2 = 0.125f * LOG2E; }
    else { Qp = (const bf16*)(p.ws + WS_Z) + (size_t)mq * NZ1 + Z1_NAQ + h * 64; sl2 = 0.125f * LOG2E; }
    u32x4 qraw[NS];
#pragma unroll
    for (int s = 0; s < NS; ++s) qraw[s] = *(const u32x4*)(Qp + 16 * s + 8 * hi);
    bf16x8 qf[NS];
    int NT, kr_lo = 0;
    if (MODE == 0 || MODE == 2) NT = 68; else if (MODE == 1) NT = 4;
    else { kr_lo = 4 * qb - 4; if (kr_lo < 0) kr_lo = 0; int last = 4 * qb - 1; if (last < 0) last = 0; if (last > 56) last = 56; NT = 4 + (last + 7 - kr_lo + 1); }
    int rs = 0, cs0 = 0;
    if (MODE == 3) {
        rs = qr - 4; if (rs < 0) rs = 0; if (rs > 56) rs = 56;
        cs0 = qc - 8; if (cs0 < 0) cs0 = 0; if (cs0 > 48) cs0 = 48;
        for (int i = tid; i < 15 * 31; i += NTHREADS) rpbL[i] = p.in[25][h * 465 + i] * LOG2E;
    }
    unsigned cmask = 0u; const float* rpbB = rpbL;
    if (MODE == 3) {
#pragma unroll
        for (int r = 0; r < 16; ++r) {
            const int kc0 = crow(r, hi), kc1 = 32 + kc0;
            if (kc0 >= cs0 && kc0 <= cs0 + 15) cmask |= 1u << r;
            if (kc1 >= cs0 && kc1 <= cs0 + 15) cmask |= 1u << (16 + r);
        }
        rpbB = rpbL + (4 * hi - qc + 15);
    }
    const int kkey0 = tid / KCH, kpart0 = tid % KCH;
    const int kkey1 = (tid + 512) / KCH, kpart1 = (tid + 512) % KCH;
    const bool k1act = (KCH == 12) && (tid + 512 < 64 * KCH);
    const int vkey = tid >> 3, vpart = tid & 7;
    auto keyrow = [&](int t, int i) -> int {
        if (t < 4) return ML + b * 256 + 64 * t + i;
        if (MODE == 3) return b * 4096 + (kr_lo + t - 4) * 64 + i;
        return b * 4096 + 64 * (t - 4) + i;
    };
    auto kchunk = [&](int row, int part) -> u32x4 {
        if (MODE <= 1) {
            if (part < 8) return *(const u32x4*)((const bf16*)(p.ws + WS_KVMLA) + (size_t)row * 1024 + h * 128 + 8 * part);
            return *(const u32x4*)((const bf16*)(p.ws + WS_KPE) + (size_t)row * 32 + 8 * (part - 8));
        } else if (MODE == 2) return *(const u32x4*)((const bf16*)(p.ws + WS_GKV) + (size_t)row * 256 + (h >> 2) * 64 + 8 * part);
        else return *(const u32x4*)((const bf16*)(p.ws + WS_Z) + (size_t)row * NZ1 + Z1_NAK + h * 64 + 8 * part);
    };
    auto vchunk = [&](int row, int part) -> u32x4 {
        if (MODE <= 1) return *(const u32x4*)((const bf16*)(p.ws + WS_KVMLA) + (size_t)row * 1024 + h * 128 + 64 + 8 * part);
        else if (MODE == 2) return *(const u32x4*)((const bf16*)(p.ws + WS_GKV) + (size_t)row * 256 + 128 + (h >> 2) * 64 + 8 * part);
        else return *(const u32x4*)((const bf16*)(p.ws + WS_Z) + (size_t)row * NZ1 + Z1_NAV + h * 64 + 8 * part);
    };
    u32x4 rk0, rk1 = {0u, 0u, 0u, 0u}, rv;
    auto load_tile = [&](int t) {
        rk0 = kchunk(keyrow(t, kkey0), kpart0);
        if (k1act) rk1 = kchunk(keyrow(t, kkey1), kpart1);
        rv = vchunk(keyrow(t, vkey), vpart);
    };
    auto write_tile = [&](int buf) {
        unsigned char* kb = lds + buf * BUF; unsigned char* vb = kb + KBUF;
        *(u32x4*)(kb + kkey0 * KP + kpart0 * 16) = rk0;
        if (k1act) *(u32x4*)(kb + kkey1 * KP + kpart1 * 16) = rk1;
        *(u32x4*)(vb + vkey * VP + vpart * 16) = rv;
    };
    const int vtr_base = (4 * hi + ((lane & 15) >> 2)) * VP + (16 * ((lane >> 4) & 1) + 4 * (lane & 3)) * 2;
    f32x16 o0, o1, ol, negm;
#pragma unroll
    for (int r = 0; r < 16; ++r) { o0[r] = 0.f; o1[r] = 0.f; ol[r] = 0.f; negm[r] = 0.f; }
    asm volatile("" : "+v"(negm));
    const bf16x8 ones = {(short)0x3F80, (short)0x3F80, (short)0x3F80, (short)0x3F80, (short)0x3F80, (short)0x3F80, (short)0x3F80, (short)0x3F80};
    float m_run = 0.f;
    auto tile_active = [&](int t) -> bool { if (MODE != 3 || t < 4) return true; const int kr = kr_lo + t - 4; return (kr >= rs) && (kr <= rs + 7); };
    auto qk_tile = [&](int slot, f32x16& s0, f32x16& s1) __attribute__((always_inline)) {
        const unsigned char* kb = lds + slot * BUF;
#pragma unroll
        for (int s = 0; s < NS; ++s) {
            const bf16x8 k0 = *(const bf16x8*)(kb + r32 * KP + (16 * s + 8 * hi) * 2);
            const bf16x8 k1 = *(const bf16x8*)(kb + (32 + r32) * KP + (16 * s + 8 * hi) * 2);
            s0 = __builtin_amdgcn_mfma_f32_32x32x16_bf16(k0, qf[s], s == 0 ? negm : s0, 0, 0, 0);
            s1 = __builtin_amdgcn_mfma_f32_32x32x16_bf16(k1, qf[s], s == 0 ? negm : s1, 0, 0, 0);
        }
    };
    int slot = 0;
    auto step = [&](const bool first, int t, f32x16& c0, f32x16& c1, f32x16& n0, f32x16& n1) __attribute__((always_inline)) {
        const int slot1 = (slot == 2) ? 0 : slot + 1, slot2 = (slot1 == 2) ? 0 : slot1 + 1;
        if (t + 2 < NT) load_tile(t + 2);
        const bool act_n = (t + 1 < NT) && tile_active(t + 1);
        if (act_n) qk_tile(slot1, n0, n1);
        if (tile_active(t)) {
            const unsigned char* vb = lds + slot * BUF + KBUF;
            if (MODE == 3 && t >= 4) {
                const int kr = kr_lo + t - 4;
                const float* bp = rpbB + (kr - qr + 7) * 31;
#pragma unroll
                for (int r = 0; r < 16; ++r) {
                    const float b0 = bp[(r & 3) + 8 * (r >> 2)], b1 = bp[32 + (r & 3) + 8 * (r >> 2)];
                    c0[r] = ((cmask >> r) & 1u) ? c0[r] + b0 : -INFINITY;
                    c1[r] = ((cmask >> (16 + r)) & 1u) ? c1[r] + b1 : -INFINITY;
                }
            }
            float mloc;
            {
                float a = fmax3(c0[0], c0[1], c1[0]), c2 = fmax3(c0[2], c0[3], c1[1]);
                a = fmax3(a, c1[2], c1[3]);
#pragma unroll
                for (int r = 4; r < 16; r += 4) { a = fmax3(a, c0[r], c0[r + 1]); c2 = fmax3(c2, c0[r + 2], c0[r + 3]); a = fmax3(a, c1[r], c1[r + 1]); c2 = fmax3(c2, c1[r + 2], c1[r + 3]); }
                mloc = __builtin_fmaxf(a, c2);
                auto rr = __builtin_amdgcn_permlane32_swap(__float_as_uint(mloc), __float_as_uint(mloc), false, false);
                mloc = __builtin_fmaxf(__uint_as_float(rr[0]), __uint_as_float(rr[1]));
            }
            if (first || __builtin_expect(__any(mloc > ATT_THR), 0)) {
                float dl = first ? mloc : __builtin_fmaxf(mloc, 0.f);
                asm volatile("" : "+v"(dl));
                m_run += dl;
#pragma unroll
                for (int r = 0; r < 16; ++r) { c0[r] -= dl; c1[r] -= dl; negm[r] = -m_run; }
                asm volatile("" : "+v"(negm));
                if (act_n) {
#pragma unroll
                    for (int r = 0; r < 16; ++r) { n0[r] -= dl; n1[r] -= dl; }
                }
                if (!first) {
                    const float alpha = __builtin_amdgcn_exp2f(-dl);
#pragma unroll
                    for (int r = 0; r < 16; ++r) { o0[r] *= alpha; o1[r] *= alpha; ol[r] *= alpha; }
                }
            }
#pragma unroll
            for (int r = 0; r < 16; ++r) { c0[r] = __builtin_amdgcn_exp2f(c0[r]); c1[r] = __builtin_amdgcn_exp2f(c1[r]); }
#pragma unroll
            for (int kt = 0; kt < 2; ++kt)
#pragma unroll
                for (int s = 0; s < 2; ++s) {
                    const f32x16& pp = kt ? c1 : c0;
                    u32x4 pw;
                    pw.x = pk2(pp[8 * s + 0], pp[8 * s + 1]); pw.y = pk2(pp[8 * s + 2], pp[8 * s + 3]);
                    pw.z = pk2(pp[8 * s + 4], pp[8 * s + 5]); pw.w = pk2(pp[8 * s + 6], pp[8 * s + 7]);
                    const bf16x8 pf = __builtin_bit_cast(bf16x8, pw);
                    const unsigned char* vp = vb + vtr_base + (32 * kt + 16 * s) * VP;
                    const s16x4 a0 = lds_tr16(vp), a1 = lds_tr16(vp + 8 * VP);
                    const s16x4 e0 = lds_tr16(vp + 64), e1 = lds_tr16(vp + 8 * VP + 64);
                    const bf16x8 va = {a0[0], a0[1], a0[2], a0[3], a1[0], a1[1], a1[2], a1[3]};
                    const bf16x8 vc = {e0[0], e0[1], e0[2], e0[3], e1[0], e1[1], e1[2], e1[3]};
                    o0 = __builtin_amdgcn_mfma_f32_32x32x16_bf16(va, pf, o0, 0, 0, 0);
                    o1 = __builtin_amdgcn_mfma_f32_32x32x16_bf16(vc, pf, o1, 0, 0, 0);
                    ol = __builtin_amdgcn_mfma_f32_32x32x16_bf16(ones, pf, ol, 0, 0, 0);
                }
        }
#ifdef ATT_SGB
#pragma unroll
        for (int i = 0; i < 2 * NS + 12; ++i) {
            __builtin_amdgcn_sched_group_barrier(0x8, 1, 0);
            __builtin_amdgcn_sched_group_barrier(0x100, 1, 0);
            __builtin_amdgcn_sched_group_barrier(0x2, ATT_SGB, 0);
        }
#endif
        if (t + 2 < NT) write_tile(slot2);
        slot = slot1;
        __syncthreads();
    };

    load_tile(0);
    const u32x4 t0a = rk0, t0b = rk1, t0c = rv;
    load_tile(1);
    const u32x4 t1a = rk0, t1b = rk1, t1c = rv;
    {
        float qx[NS][8];
#pragma unroll
        for (int s = 0; s < NS; ++s) unpack8(qraw[s], qx[s]);
        if (MODE == 0) {
            const int t = mq & 4095; const float2* rt = (const float2*)(p.ws + WS_ROPE8) + (hi ? (t & 63) : (t >> 6)) * 8;
#pragma unroll
            for (int e = 0; e < 8; ++e) { const float2 v = rt[e]; const float cs = v.x, sn = v.y; const float a = qx[4][e], c2 = qx[5][e]; qx[4][e] = a * cs - c2 * sn; qx[5][e] = c2 * cs + a * sn; }
        }
        if (MODE == 2) {
            float ss = 0.f;
#pragma unroll
            for (int s = 0; s < NS; ++s)
#pragma unroll
                for (int e = 0; e < 8; ++e) ss += qx[s][e] * qx[s][e];
            ss += __shfl_xor(ss, 32);
            const float r = rsqrtf(ss * (1.f / 64.f) + EPS);
            const float* qn = p.in[26];
#pragma unroll
            for (int s = 0; s < NS; ++s)
#pragma unroll
                for (int e = 0; e < 8; ++e) qx[s][e] *= r * qn[16 * s + 8 * hi + e];
            const int t = mq & 4095;
#pragma unroll
            for (int s = 0; s < 2; ++s) {
                const float2* rt = (const float2*)(p.ws + WS_ROPE16) + (s ? (t & 63) : (t >> 6)) * 16 + 8 * hi;
#pragma unroll
                for (int e = 0; e < 8; ++e) { const float2 v = rt[e]; const float a1 = qx[s][e], a2 = qx[s + 2][e]; qx[s][e] = a1 * v.x - a2 * v.y; qx[s + 2][e] = a2 * v.x + a1 * v.y; }
            }
        }
#pragma unroll
        for (int s = 0; s < NS; ++s) {
#pragma unroll
            for (int e = 0; e < 8; ++e) qx[s][e] *= sl2;
            qf[s] = __builtin_bit_cast(bf16x8, pack8(qx[s]));
        }
    }
    __syncthreads();
    rk0 = t0a; rk1 = t0b; rv = t0c; write_tile(0);
    rk0 = t1a; rk1 = t1b; rv = t1c; write_tile(1);
    __syncthreads();
    f32x16 sA0, sA1, sB0, sB1;
    qk_tile(0, sA0, sA1);
    step(true, 0, sA0, sA1, sB0, sB1);
    int t = 1;
    for (; t + 1 < NT; t += 2) {
        step(false, t, sB0, sB1, sA0, sA1);
        step(false, t + 1, sA0, sA1, sB0, sB1);
    }
    if (t < NT) step(false, t, sB0, sB1, sA0, sA1);
    const float l_run = ol[0];
    const float il = 1.f / l_run;
    bf16* Ob;
    {
        const int mq0 = mq - r32;
        if (MODE == 3) Ob = (bf16*)(p.ws + WS_U) + (size_t)mq0 * DM + h * 64;
        else Ob = (bf16*)(p.ws + WS_U) + (size_t)mq0 * DM + 512 + h * 64;
    }
    unsigned char* stg = lds + 3 * BUF + 2048 + wid * (32 * 144);
#pragma unroll
    for (int g = 0; g < 4; ++g) {
        u32x2 w0, w1;
        w0.x = pk2(o0[4 * g] * il, o0[4 * g + 1] * il); w0.y = pk2(o0[4 * g + 2] * il, o0[4 * g + 3] * il);
        w1.x = pk2(o1[4 * g] * il, o1[4 * g + 1] * il); w1.y = pk2(o1[4 * g + 2] * il, o1[4 * g + 3] * il);
        *(u32x2*)(stg + r32 * 144 + (8 * g + 4 * hi) * 2) = w0;
        *(u32x2*)(stg + r32 * 144 + (32 + 8 * g + 4 * hi) * 2) = w1;
    }
    asm volatile("s_waitcnt lgkmcnt(0)" ::: "memory");
#pragma unroll
    for (int i = 0; i < 4; ++i) {
        const int row = 8 * i + (lane >> 3), ch = lane & 7;
        const u32x4 v = *(const u32x4*)(stg + row * 144 + ch * 16);
        *(u32x4*)(Ob + (size_t)row * DM + ch * 8) = v;
    }
}

template <int MODE> DI void attn_unit3(const KParams& p, int b, int h, int qb, unsigned char* lds);
#ifdef ATT_PIPE3
#define ATTN_FN attn_unit3
#else
#define ATTN_FN attn_unit
#endif
DI void phase_scan_attn0(const KParams& p, unsigned char* lds) {
    unsigned* ctl2 = (unsigned*)(p.ws + WS_CTL2);
    for (int su = blockIdx.x; su < 128; su += gridDim.x) {
        gdn_scan_unit(p, su >> 4, (su >> 1) & 7, su & 1, lds);
#ifndef COMBINE_PHASE
        asm volatile("s_waitcnt vmcnt(0)" ::: "memory"); __syncthreads();
        if (threadIdx.x == 0) { __builtin_amdgcn_fence(__ATOMIC_RELEASE, "agent"); asm volatile("s_waitcnt vmcnt(0)" ::: "memory"); (void)xb_add(ctl2, 1u); }
#endif
    }
    unsigned* qbase = (unsigned*)(p.ws + WS_QCTR);
    volatile int* nxt = (volatile int*)(lds + LDS_BYTES - 128);
    const int x0 = (int)(xb_xcc_id() & 7u);
    int tries = 0;
    for (;;) {
        __syncthreads();
        if (threadIdx.x == 0) {
            int t = tries, li = 0;
            for (; t < 8; ++t) {
                li = (int)__hip_atomic_fetch_add(qbase + 64 * ((x0 + t) & 7), 1u, __ATOMIC_RELAXED, __HIP_MEMORY_SCOPE_AGENT);
                if (li < 136) break;
            }
            nxt[0] = t; nxt[1] = li;
        }
        __syncthreads();
        tries = nxt[0];
        if (tries >= 8) break;
        const int li = nxt[1], x = (x0 + tries) & 7;
        if (li < 128) { const int bh = (li >> 4) * 8 + x, j = li & 15; ATTN_FN<0>(p, bh >> 3, bh & 7, j, lds); }
        else { const int bh = (li - 128) * 8 + x; ATTN_FN<1>(p, bh >> 3, bh & 7, 0, lds); }
    }
#ifndef COMBINE_PHASE
    __syncthreads();
    if (threadIdx.x == 0) {
        unsigned* bar = (unsigned*)(p.ws + WS_CTL);
        XB_SPIN(xb_ld(ctl2) < 128u, bar);
        __builtin_amdgcn_fence(__ATOMIC_ACQUIRE, "agent"); asm volatile("s_waitcnt vmcnt(0)" ::: "memory");
    }
    for (;;) {
        __syncthreads();
        if (threadIdx.x == 0) nxt[0] = (int)__hip_atomic_fetch_add(ctl2 + 64, 1u, __ATOMIC_RELAXED, __HIP_MEMORY_SCOPE_AGENT);
        __syncthreads();
        const int it = nxt[0];
        if (it >= MT / 128) break;
        gdn_combine_run(p, it * 64 + (int)(tid_fresh() >> 6) * 8, 8);
    }
#endif
}
template <int MODE>
DI void attn_unit3(const KParams& p, int b, int h, int qb, unsigned char* lds) {
    static_assert(MODE <= 2, "attn_unit3: MLA / GQA only");
    constexpr int DQK = AttnCfg<MODE>::DQK, NS = DQK / 16;
    constexpr int KP = DQK * 2 + 16, VP = 64 * 2 + 16, KBUF = 64 * KP, VBUF = 64 * VP, BUF = KBUF + VBUF, KCH = DQK / 8;
    const int tid = tid_fresh(), lane = tid & 63, wid = tid >> 6, r32 = lane & 31, hi = lane >> 5;
    int mq;
    if (MODE == 0 || MODE == 2) mq = b * 4096 + qb * 256 + wid * 32 + r32; else mq = ML + b * 256 + wid * 32 + r32;
    const bf16* Qp; float sl2;
    if (MODE <= 1) { Qp = (const bf16*)(p.ws + WS_QMLA) + (size_t)mq * 768 + h * 96; sl2 = 0.10206207261596577f * LOG2E; }
    else { Qp = (const bf16*)(p.ws + WS_Z) + (size_t)mq * NZ1 + Z1_GQ + h * 64; sl2 = 0.125f * LOG2E; }
    u32x4 qraw[NS];
#pragma unroll
    for (int s = 0; s < NS; ++s) qraw[s] = *(const u32x4*)(Qp + 16 * s + 8 * hi);
    bf16x8 qf[NS];
    const int NT = (MODE == 1) ? 4 : 68;
    const int kkey0 = tid / KCH, kpart0 = tid % KCH;
    const int kkey1 = (tid + 512) / KCH, kpart1 = (tid + 512) % KCH;
    const bool k1act = (KCH == 12) && (tid + 512 < 64 * KCH);
    const int vkey = tid >> 3, vpart = tid & 7;
    auto keyrow = [&](int t, int i) -> int { return t < 4 ? ML + b * 256 + 64 * t + i : b * 4096 + 64 * (t - 4) + i; };
    auto kchunk = [&](int row, int part) -> u32x4 {
        if (MODE <= 1) {
            if (part < 8) return *(const u32x4*)((const bf16*)(p.ws + WS_KVMLA) + (size_t)row * 1024 + h * 128 + 8 * part);
            return *(const u32x4*)((const bf16*)(p.ws + WS_KPE) + (size_t)row * 32 + 8 * (part - 8));
        } else return *(const u32x4*)((const bf16*)(p.ws + WS_GKV) + (size_t)row * 256 + (h >> 2) * 64 + 8 * part);
    };
    auto vchunk = [&](int row, int part) -> u32x4 {
        if (MODE <= 1) return *(const u32x4*)((const bf16*)(p.ws + WS_KVMLA) + (size_t)row * 1024 + h * 128 + 64 + 8 * part);
        else return *(const u32x4*)((const bf16*)(p.ws + WS_GKV) + (size_t)row * 256 + 128 + (h >> 2) * 64 + 8 * part);
    };
    u32x4 rk0, rk1 = {0u, 0u, 0u, 0u}, rv;
    auto load_tile = [&](int t) { rk0 = kchunk(keyrow(t, kkey0), kpart0); if (k1act) rk1 = kchunk(keyrow(t, kkey1), kpart1); rv = vchunk(keyrow(t, vkey), vpart); };
    auto write_tile = [&](int sl) {
        unsigned char* kb = lds + sl * BUF; unsigned char* vb = kb + KBUF;
        *(u32x4*)(kb + kkey0 * KP + kpart0 * 16) = rk0;
        if (k1act) *(u32x4*)(kb + kkey1 * KP + kpart1 * 16) = rk1;
        *(u32x4*)(vb + vkey * VP + vpart * 16) = rv;
    };
    const int vtr_base = (4 * hi + ((lane & 15) >> 2)) * VP + (16 * ((lane >> 4) & 1) + 4 * (lane & 3)) * 2;
    f32x16 o0, o1, ol, negm;
    {
        float zf = 0.f; asm volatile("" : "+v"(zf));
#pragma unroll
        for (int r = 0; r < 16; ++r) { o0[r] = zf; o1[r] = zf; ol[r] = zf; negm[r] = zf; }
    }
    asm volatile("" : "+v"(negm));
    const bf16x8 ones = {(short)0x3F80, (short)0x3F80, (short)0x3F80, (short)0x3F80, (short)0x3F80, (short)0x3F80, (short)0x3F80, (short)0x3F80};
    float m_run = 0.f;
    auto qk_tile = [&](int sl, f32x16& s0, f32x16& s1) __attribute__((always_inline)) {
        const unsigned char* kb = lds + sl * BUF;
#pragma unroll
        for (int s = 0; s < NS; ++s) {
            const bf16x8 k0 = *(const bf16x8*)(kb + r32 * KP + (16 * s + 8 * hi) * 2);
            const bf16x8 k1 = *(const bf16x8*)(kb + (32 + r32) * KP + (16 * s + 8 * hi) * 2);
            s0 = __builtin_amdgcn_mfma_f32_32x32x16_bf16(k0, qf[s], s == 0 ? negm : s0, 0, 0, 0);
            s1 = __builtin_amdgcn_mfma_f32_32x32x16_bf16(k1, qf[s], s == 0 ? negm : s1, 0, 0, 0);
        }
    };
    auto pv_tile = [&](int sl, const bf16x8 (&pk)[4]) __attribute__((always_inline)) {
        const unsigned char* vb = lds + sl * BUF + KBUF + vtr_base;
#pragma unroll
        for (int c = 0; c < 4; ++c) {
            const unsigned char* vp = vb + (16 * c) * VP;
            const s16x4 a0 = lds_tr16(vp), a1 = lds_tr16(vp + 8 * VP), e0 = lds_tr16(vp + 64), e1 = lds_tr16(vp + 8 * VP + 64);
            const bf16x8 va = {a0[0], a0[1], a0[2], a0[3], a1[0], a1[1], a1[2], a1[3]};
            const bf16x8 vc = {e0[0], e0[1], e0[2], e0[3], e1[0], e1[1], e1[2], e1[3]};
            o0 = __builtin_amdgcn_mfma_f32_32x32x16_bf16(va, pk[c], o0, 0, 0, 0);
            o1 = __builtin_amdgcn_mfma_f32_32x32x16_bf16(vc, pk[c], o1, 0, 0, 0);
            ol = __builtin_amdgcn_mfma_f32_32x32x16_bf16(ones, pk[c], ol, 0, 0, 0);
        }
    };
    auto step = [&](const bool first, int t, f32x16& c0, f32x16& c1, f32x16& n0, f32x16& n1, const bf16x8 (&pprev)[4], bf16x8 (&pcur)[4]) __attribute__((always_inline)) {
        if (t + 2 < NT) load_tile(t + 2);
        const bool has_n = t + 1 < NT;
        if (has_n) qk_tile((t + 1) & 3, n0, n1);
        if (!first) pv_tile((t - 1) & 3, pprev);
        float mloc;
        {
            float a = fmax3(c0[0], c0[1], c1[0]), c2 = fmax3(c0[2], c0[3], c1[1]);
            a = fmax3(a, c1[2], c1[3]);
#pragma unroll
            for (int r = 4; r < 16; r += 4) { a = fmax3(a, c0[r], c0[r + 1]); c2 = fmax3(c2, c0[r + 2], c0[r + 3]); a = fmax3(a, c1[r], c1[r + 1]); c2 = fmax3(c2, c1[r + 2], c1[r + 3]); }
            mloc = __builtin_fmaxf(a, c2);
            auto rr = __builtin_amdgcn_permlane32_swap(__float_as_uint(mloc), __float_as_uint(mloc), false, false);
            mloc = __builtin_fmaxf(__uint_as_float(rr[0]), __uint_as_float(rr[1]));
        }
        if (first || __builtin_expect(__any(mloc > ATT_THR), 0)) {
            float dl = first ? mloc : __builtin_fmaxf(mloc, 0.f);
            asm volatile("" : "+v"(dl));
            m_run += dl;
#pragma unroll
            for (int r = 0; r < 16; ++r) { c0[r] -= dl; c1[r] -= dl; negm[r] = -m_run; }
            asm volatile("" : "+v"(negm));
            if (has_n) {
#pragma unroll
                for (int r = 0; r < 16; ++r) { n0[r] -= dl; n1[r] -= dl; }
            }
            if (!first) {
                const float alpha = __builtin_amdgcn_exp2f(-dl);
#pragma unroll
                for (int r = 0; r < 16; ++r) { o0[r] *= alpha; o1[r] *= alpha; ol[r] *= alpha; }
            }
        }
#pragma unroll
        for (int r = 0; r < 16; ++r) { c0[r] = __builtin_amdgcn_exp2f(c0[r]); c1[r] = __builtin_amdgcn_exp2f(c1[r]); }
#pragma unroll
        for (int kt = 0; kt < 2; ++kt)
#pragma unroll
            for (int s = 0; s < 2; ++s) {
                const f32x16& pp = kt ? c1 : c0;
                u32x4 pw;
                pw.x = pk2(pp[8 * s + 0], pp[8 * s + 1]); pw.y = pk2(pp[8 * s + 2], pp[8 * s + 3]);
                pw.z = pk2(pp[8 * s + 4], pp[8 * s + 5]); pw.w = pk2(pp[8 * s + 6], pp[8 * s + 7]);
                pcur[2 * kt + s] = __builtin_bit_cast(bf16x8, pw);
            }
        if (t + 2 < NT) write_tile((t + 2) & 3);
        __syncthreads();
    };
    u32x4 t0a = {0u, 0u, 0u, 0u}, t0b = t0a, t0c = t0a, t1a = t0a, t1b = t0a, t1c = t0a;
    if (MODE != 2) { load_tile(0); t0a = rk0; t0b = rk1; t0c = rv; load_tile(1); t1a = rk0; t1b = rk1; t1c = rv; }
    {
        float qx[NS][8];
#pragma unroll
        for (int s = 0; s < NS; ++s) unpack8(qraw[s], qx[s]);
        if (MODE == 0) {
            const int t = mq & 4095; const float2* rt = (const float2*)(p.ws + WS_ROPE8) + (hi ? (t & 63) : (t >> 6)) * 8;
#pragma unroll
            for (int e = 0; e < 8; ++e) { const float2 v = rt[e]; const float cs = v.x, sn = v.y; const float a1 = qx[4][e], c2 = qx[5][e]; qx[4][e] = a1 * cs - c2 * sn; qx[5][e] = c2 * cs + a1 * sn; }
        }
        if (MODE == 2) {
            float ss = 0.f;
#pragma unroll
            for (int s = 0; s < NS; ++s)
#pragma unroll
                for (int e = 0; e < 8; ++e) ss += qx[s][e] * qx[s][e];
            ss += __shfl_xor(ss, 32);
            const float r = rsqrtf(ss * (1.f / 64.f) + EPS);
            const float* qn = p.in[26];
#pragma unroll
            for (int s = 0; s < NS; ++s)
#pragma unroll
                for (int e = 0; e < 8; ++e) qx[s][e] *= r * qn[16 * s + 8 * hi + e];
            const int t = mq & 4095;
#pragma unroll
            for (int s = 0; s < 2; ++s) {
                const float2* rt = (const float2*)(p.ws + WS_ROPE16) + (s ? (t & 63) : (t >> 6)) * 16 + 8 * hi;
#pragma unroll
                for (int e = 0; e < 8; ++e) { const float2 v = rt[e]; const float a1 = qx[s][e], a2 = qx[s + 2][e]; qx[s][e] = a1 * v.x - a2 * v.y; qx[s + 2][e] = a2 * v.x + a1 * v.y; }
            }
        }
#pragma unroll
        for (int s = 0; s < NS; ++s) {
#pragma unroll
            for (int e = 0; e < 8; ++e) qx[s][e] *= sl2;
            qf[s] = __builtin_bit_cast(bf16x8, pack8(qx[s]));
        }
    }
    if (MODE == 2) { load_tile(0); t0a = rk0; t0b = rk1; t0c = rv; load_tile(1); t1a = rk0; t1b = rk1; t1c = rv; }
    __syncthreads();
    rk0 = t0a; rk1 = t0b; rv = t0c; write_tile(0);
    rk0 = t1a; rk1 = t1b; rv = t1c; write_tile(1);
    __syncthreads();
    f32x16 sA0, sA1, sB0, sB1;
    bf16x8 pA[4], pB[4];
    qk_tile(0, sA0, sA1);
    step(true, 0, sA0, sA1, sB0, sB1, pB, pA);
    int t = 1;
    for (; t + 1 < NT; t += 2) {
        step(false, t, sB0, sB1, sA0, sA1, pA, pB);
        step(false, t + 1, sA0, sA1, sB0, sB1, pB, pA);
    }
    if (t < NT) { step(false, t, sB0, sB1, sA0, sA1, pA, pB); pv_tile((NT - 1) & 3, pB); }
    else pv_tile((NT - 1) & 3, pA);
    const float il = 1.f / ol[0];
    bf16* Ob = (bf16*)(p.ws + WS_U) + (size_t)(mq - r32) * DM + 512 + h * 64;
    unsigned char* stg = lds + 4 * BUF + wid * (32 * 144);
#pragma unroll
    for (int g = 0; g < 4; ++g) {
        u32x2 w0, w1;
        w0.x = pk2(o0[4 * g] * il, o0[4 * g + 1] * il); w0.y = pk2(o0[4 * g + 2] * il, o0[4 * g + 3] * il);
        w1.x = pk2(o1[4 * g] * il, o1[4 * g + 1] * il); w1.y = pk2(o1[4 * g + 2] * il, o1[4 * g + 3] * il);
        *(u32x2*)(stg + r32 * 144 + (8 * g + 4 * hi) * 2) = w0;
        *(u32x2*)(stg + r32 * 144 + (32 + 8 * g + 4 * hi) * 2) = w1;
    }
    asm volatile("s_waitcnt lgkmcnt(0)" ::: "memory");
#pragma unroll
    for (int i = 0; i < 4; ++i) {
        const int row = 8 * i + (lane >> 3), ch = lane & 7;
        const u32x4 v = *(const u32x4*)(stg + row * 144 + ch * 16);
        *(u32x4*)(Ob + (size_t)row * DM + ch * 8) = v;
    }
    __syncthreads();
}

DI void na_unit(const KParams& p, int b, int h, int qb, unsigned char* lds) {
    constexpr int KP = 144, VP = 144, KBUF = 64 * KP, BUF = 2 * KBUF;
    const int tid = tid_fresh(), lane = tid & 63, wid = tid >> 6, r32 = lane & 31, hi = lane >> 5;
    float* rpbL = (float*)(lds + 2 * BUF + 256);
    const int ra = 4 * qb + 2 * (wid >> 2), c0 = 16 * (wid & 3);
    const int qrow = ra + (r32 >> 4), qcol = c0 + (r32 & 15);
    const int mq = b * 4096 + qrow * 64 + qcol;
    const bf16* Z = (const bf16*)(p.ws + WS_Z);
    bf16x8 qf[4];
    {
        const bf16* Qp = Z + (size_t)mq * NZ1 + Z1_NAQ + h * 64;
#pragma unroll
        for (int s = 0; s < 4; ++s) {
            float qx[8]; unpack8(*(const u32x4*)(Qp + 16 * s + 8 * hi), qx);
#pragma unroll
            for (int e = 0; e < 8; ++e) qx[e] *= 0.125f * LOG2E;
            qf[s] = __builtin_bit_cast(bf16x8, pack8(qx));
        }
    }
    int rs_l = qrow - 4; rs_l = rs_l < 0 ? 0 : (rs_l > 56 ? 56 : rs_l);
    int cs_l = qcol - 8; cs_l = cs_l < 0 ? 0 : (cs_l > 48 ? 48 : cs_l);
    int start = c0 - 8; start = start < 0 ? 0 : start; start = start > 32 ? 32 : start;
    int wlo = ra - 4; wlo = wlo < 0 ? 0 : (wlo > 56 ? 56 : wlo);
    int whi = ra + 1 - 4; whi = whi < 0 ? 0 : (whi > 56 ? 56 : whi); whi += 7;
    int kr_lo = 4 * qb - 4; if (kr_lo < 0) kr_lo = 0;
    int last = 4 * qb - 1; if (last < 0) last = 0; if (last > 56) last = 56;
    const int NT = 4 + (last + 7 - kr_lo + 1);
    unsigned cmask = 0u;
#pragma unroll
    for (int r = 0; r < 16; ++r) { const int kc = start + crow(r, hi); if (kc >= cs_l && kc <= cs_l + 15) cmask |= 1u << r; }
    const float* rpbB = rpbL + (start + 4 * hi - qcol + 15);
    for (int i = tid; i < 15 * 31; i += NTHREADS) rpbL[i] = p.in[25][h * 465 + i] * LOG2E;
    const int skey = tid >> 3, spart = tid & 7;
    auto keyrow = [&](int t) -> int { return t < 4 ? ML + b * 256 + 64 * t + skey : b * 4096 + (kr_lo + t - 4) * 64 + skey; };
    u32x4 rk, rv;
    auto load_tile = [&](int t) { const bf16* src = Z + (size_t)keyrow(t) * NZ1 + h * 64 + 8 * spart; rk = *(const u32x4*)(src + Z1_NAK); rv = *(const u32x4*)(src + Z1_NAV); };
    auto write_tile = [&](int buf) { *(u32x4*)(lds + buf * BUF + skey * KP + spart * 16) = rk; *(u32x4*)(lds + buf * BUF + KBUF + skey * VP + spart * 16) = rv; };
    const int vtr_base = (4 * hi + ((lane & 15) >> 2)) * VP + (16 * ((lane >> 4) & 1) + 4 * (lane & 3)) * 2;
    f32x16 o0, o1, ol, negm;
#pragma unroll
    for (int r = 0; r < 16; ++r) { o0[r] = 0.f; o1[r] = 0.f; ol[r] = 0.f; negm[r] = 0.f; }
    asm volatile("" : "+v"(negm));
    const bf16x8 ones = {(short)0x3F80, (short)0x3F80, (short)0x3F80, (short)0x3F80, (short)0x3F80, (short)0x3F80, (short)0x3F80, (short)0x3F80};
    float m_run = 0.f;
    auto span = [&](const unsigned char* kb, const unsigned char* vb, int koff, bool first, bool local, int kr) __attribute__((always_inline)) {
        f32x16 sc;
#pragma unroll
        for (int s = 0; s < 4; ++s) {
            const bf16x8 kf = *(const bf16x8*)(kb + (koff + r32) * KP + (16 * s + 8 * hi) * 2);
            sc = __builtin_amdgcn_mfma_f32_32x32x16_bf16(kf, qf[s], s == 0 ? negm : sc, 0, 0, 0);
        }
        if (local) {
            const bool rowok = (kr >= rs_l) && (kr <= rs_l + 7);
            const float* bp = rpbB + (kr - qrow + 7) * 31;
#pragma unroll
            for (int r = 0; r < 16; ++r) { const float bv = bp[(r & 3) + 8 * (r >> 2)]; sc[r] = (rowok && ((cmask >> r) & 1u)) ? sc[r] + bv : -INFINITY; }
        }
        float mloc;
        {
            float a = fmax3(sc[0], sc[1], sc[2]), c2 = fmax3(sc[3], sc[4], sc[5]);
            a = fmax3(a, sc[6], sc[7]); c2 = fmax3(c2, sc[8], sc[9]); a = fmax3(a, sc[10], sc[11]); c2 = fmax3(c2, sc[12], sc[13]); a = fmax3(a, sc[14], sc[15]);
            mloc = __builtin_fmaxf(a, c2);
            auto rr = __builtin_amdgcn_permlane32_swap(__float_as_uint(mloc), __float_as_uint(mloc), false, false);
            mloc = __builtin_fmaxf(__uint_as_float(rr[0]), __uint_as_float(rr[1]));
        }
        if (first || __builtin_expect(__any(mloc > ATT_THR), 0)) {
            float dl = first ? mloc : __builtin_fmaxf(mloc, 0.f);
            asm volatile("" : "+v"(dl));
            m_run += dl;
#pragma unroll
            for (int r = 0; r < 16; ++r) { sc[r] -= dl; negm[r] = -m_run; }
            asm volatile("" : "+v"(negm));
            if (!first) {
                const float alpha = __builtin_amdgcn_exp2f(-dl);
#pragma unroll
                for (int r = 0; r < 16; ++r) { o0[r] *= alpha; o1[r] *= alpha; ol[r] *= alpha; }
            }
        }
#pragma unroll
        for (int r = 0; r < 16; ++r) sc[r] = __builtin_amdgcn_exp2f(sc[r]);
#pragma unroll
        for (int s = 0; s < 2; ++s) {
            u32x4 pw;
            pw.x = pk2(sc[8 * s + 0], sc[8 * s + 1]); pw.y = pk2(sc[8 * s + 2], sc[8 * s + 3]);
            pw.z = pk2(sc[8 * s + 4], sc[8 * s + 5]); pw.w = pk2(sc[8 * s + 6], sc[8 * s + 7]);
            const bf16x8 pf = __builtin_bit_cast(bf16x8, pw);
            const unsigned char* vp = vb + vtr_base + (koff + 16 * s) * VP;
            const s16x4 a0 = lds_tr16(vp), a1 = lds_tr16(vp + 8 * VP), e0 = lds_tr16(vp + 64), e1 = lds_tr16(vp + 8 * VP + 64);
            const bf16x8 va = {a0[0], a0[1], a0[2], a0[3], a1[0], a1[1], a1[2], a1[3]};
            const bf16x8 vc = {e0[0], e0[1], e0[2], e0[3], e1[0], e1[1], e1[2], e1[3]};
            o0 = __builtin_amdgcn_mfma_f32_32x32x16_bf16(va, pf, o0, 0, 0, 0);
            o1 = __builtin_amdgcn_mfma_f32_32x32x16_bf16(vc, pf, o1, 0, 0, 0);
            ol = __builtin_amdgcn_mfma_f32_32x32x16_bf16(ones, pf, ol, 0, 0, 0);
        }
    };
    __syncthreads();
    load_tile(0); write_tile(0);
    __syncthreads();
    for (int t = 0; t < NT; ++t) {
        const int buf = t & 1;
        if (t + 1 < NT) load_tile(t + 1);
        const unsigned char* kb = lds + buf * BUF; const unsigned char* vb = kb + KBUF;
        if (t < 4) { span(kb, vb, 0, t == 0, false, 0); span(kb, vb, 32, false, false, 0); }
        else { const int kr = kr_lo + t - 4; if (kr >= wlo && kr <= whi) span(kb, vb, start, false, true, kr); }
        if (t + 1 < NT) write_tile(buf ^ 1);
        __syncthreads();
    }
    const float il = 1.f / ol[0];
    unsigned char* stg = lds + 2 * BUF + 4096 + wid * (32 * 144);
#pragma unroll
    for (int g = 0; g < 4; ++g) {
        u32x2 w0, w1;
        w0.x = pk2(o0[4 * g] * il, o0[4 * g + 1] * il); w0.y = pk2(o0[4 * g + 2] * il, o0[4 * g + 3] * il);
        w1.x = pk2(o1[4 * g] * il, o1[4 * g + 1] * il); w1.y = pk2(o1[4 * g + 2] * il, o1[4 * g + 3] * il);
        *(u32x2*)(stg + r32 * 144 + (8 * g + 4 * hi) * 2) = w0;
        *(u32x2*)(stg + r32 * 144 + (32 + 8 * g + 4 * hi) * 2) = w1;
    }
    asm volatile("s_waitcnt lgkmcnt(0)" ::: "memory");
#pragma unroll
    for (int i = 0; i < 4; ++i) {
        const int row = 8 * i + (lane >> 3), ch = lane & 7;
        const u32x4 v = *(const u32x4*)(stg + row * 144 + ch * 16);
        const int mrow = b * 4096 + (ra + (row >> 4)) * 64 + c0 + (row & 15);
        *(u32x4*)((bf16*)(p.ws + WS_U) + (size_t)mrow * DM + h * 64 + ch * 8) = v;
    }
}

DI void phase_attn1(const KParams& p, unsigned char* lds) {
    const int G = gridDim.x; const int vcu = (G % 8 == 0) ? (blockIdx.x % 8) * (G / 8) + blockIdx.x / 8 : blockIdx.x;
#ifndef NO_GQA
    for (int u = vcu; u < 1024; u += G) { const int bh = u >> 4, j = u & 15; ATTN_FN<2>(p, bh >> 3, bh & 7, j, lds); }
#endif
#if defined(NO_NA)
#elif defined(NA_OLD)
    for (int u = vcu; u < 1024; u += G) { const int bh = u >> 4, j = u & 15; attn_unit<3>(p, bh >> 3, bh & 7, j, lds); }
#else
    for (int u = vcu; u < 1024; u += G) { const int bh = u >> 4, j = u & 15; na_unit(p, bh >> 3, bh & 7, j, lds); }
#endif
#ifdef NA_PROBE
    for (int u = vcu; u < 1024; u += G) { const int bh = u >> 4, j = u & 15; na_unit(p, bh >> 3, bh & 7, j, lds); }
#endif
}

#ifndef PHMASK
#define PHMASK 0xffffffffu
#endif
typedef const __attribute__((address_space(4))) KParams* KArgPtr;
DI KParams load_params(KArgPtr kp) {
    KParams p;
#pragma unroll
    for (int i = 0; i < 28; ++i) p.in[i] = kp->in[i];
    p.out = kp->out; p.ws = kp->ws; return p;
}
__global__ void __launch_bounds__(NTHREADS, 2) fwd_megakernel(KParams p_unused) {
    extern __shared__ __attribute__((aligned(16))) unsigned char lds[];
    cg::grid_group grid = cg::this_grid();
    KArgPtr kp0 = (KArgPtr)__builtin_amdgcn_kernarg_segment_ptr();
    volatile LAS unsigned* bst = (volatile LAS unsigned*)((LAS unsigned char*)lds + (LDS_BYTES - 64));
    if (threadIdx.x == 0) { bst[0] = 0u; bst[1] = 0u; }
    __syncthreads();
    const XcdBarrier bar = xcd_barrier_post((unsigned*)(kp0->ws + WS_CTL), bst);
#ifdef USE_CG_SYNC
#define SYNC() grid.sync()
#else
#define SYNC() xcd_barrier(bar)
#endif
    constexpr int NSUB = 32;
#define PH1(n, ...) { KArgPtr kp = kp0; asm volatile("" : "+s"(kp)); const KParams p = load_params(kp); unsigned char* ws = p.ws; \
        bf16* U = (bf16*)(ws + WS_U); bf16* Zb = (bf16*)(ws + WS_Z); bf16* Yb = (bf16*)(ws + WS_Y); (void)U; (void)Zb; (void)Yb; __VA_ARGS__; }
#ifndef PHREP
#define PHREP 0u
#endif
#define PH(n, ...) if ((PHMASK >> (n)) & 1u) { PH1(n, __VA_ARGS__) if ((PHREP >> (n)) & 1u) { SYNC(); PH1(n, __VA_ARGS__) } }

    PH(0, phase_prologue(p, lds))
    if (__builtin_expect(gridDim.x > 65535u, 0)) grid.sync();
    SYNC();
    PH(1, phase_modnorm0(p))
    SYNC();
#ifdef ALL_W_EARLY
    PH(2, gemm_store(lds, U, (const bf16*)(ws + WS_WIN0), MT, NZ0, DM, Zb, NZ0))
#else
    PH(2, { gemm_store(lds, U, (const bf16*)(ws + WS_WIN0), MT, NZ0, DM, Zb, NZ0);
            const int G = (int)gridDim.x, first = ((MT / 256) * (NZ0 / 256)) % G;
            if ((int)blockIdx.x >= first) {
                asm volatile("s_waitcnt vmcnt(0) lgkmcnt(0)" ::: "memory"); __syncthreads();
                weight_transposes<TD_LATE>(p, lds, ((int)blockIdx.x - first) * NWAVES + (int)(tid_fresh() >> 6), (G - first) * NWAVES);
            } })
#endif
    SYNC();
    PH(3, phase_prep0(p))
    SYNC();
    PH(4, gemm_store(lds, (const bf16*)(ws + WS_QN), (const bf16*)(ws + WS_WQUP), MT, 768, 256, (bf16*)(ws + WS_QMLA), 768))
    PH(5, gemm_store(lds, (const bf16*)(ws + WS_KVN), (const bf16*)(ws + WS_WKVUP), MT, 1024, 128, (bf16*)(ws + WS_KVMLA), 1024))
    { asm volatile("s_waitcnt vmcnt(0) lgkmcnt(0)" ::: "memory"); __syncthreads(); }
    PH(7, phase_tinv(p, lds))
    SYNC();
#ifdef TINV_PROBE
    PH(7, phase_tinv(p, lds, true))
    SYNC();
#endif
    PH(6, phase_scan_attn0(p, lds))
    SYNC();
#ifdef COMBINE_PHASE
    PH(9, phase_gdn_combine(p))
    SYNC();
#endif
    PH(10, gemm_store(lds, U, (const bf16*)(ws + WS_WOUT0), ML, DM, DM, Yb, DM))
    SYNC();
    PH(11, { if (blockIdx.x < NSUB) { gemm_store_sub(lds, U + (size_t)ML * DM, (const bf16*)(ws + WS_WOUT0), MC, DM, DM, Yb + (size_t)ML * DM, DM, 0, NSUB);
                                      sub_barrier((unsigned*)(ws + WS_SUBCNT), NSUB);
                                      phase_post(p, ML, MT, Yb, 1, 0, 2, p.in[7], p.in[8], 0, 3, U, 0, NSUB); }
             else phase_post(p, 0, ML, Yb, 1, 0, 2, p.in[7], p.in[8], 0, 3, U, NSUB, (int)gridDim.x - NSUB); })
    SYNC();
    PH(12, gemm_swiglu(lds, U, (const bf16*)(ws + WS_WGU0), MT, Zb))
    SYNC();
    PH(13, gemm_store(lds, Zb, (const bf16*)(ws + WS_WDN0), ML, DM, DFF, Yb, DM))
    SYNC();
    PH(14, { if (blockIdx.x < NSUB) { gemm_store_sub(lds, Zb + (size_t)ML * DFF, (const bf16*)(ws + WS_WDN0), MC, DM, DFF, Yb + (size_t)ML * DM, DM, 0, NSUB);
                                      sub_barrier((unsigned*)(ws + WS_SUBCNT) + 64, NSUB);
                                      phase_post(p, ML, MT, Yb, 0, 0, 5, p.in[9], p.in[6] + 1024, 1, 0, U, 0, NSUB); }
             else phase_post(p, 0, ML, Yb, 0, 0, 5, p.in[9], p.in[6] + 1024, 1, 0, U, NSUB, (int)gridDim.x - NSUB); })
    SYNC();
    PH(15, gemm_store(lds, U, (const bf16*)(ws + WS_WIN1), MT, NZ1, DM, Zb, NZ1))
    SYNC();
    PH(16, phase_prep1(p))
    SYNC();
    PH(17, phase_attn1(p, lds))
    SYNC();
    PH(18, gemm_store(lds, U, (const bf16*)(ws + WS_WOUT1), ML, DM, DM, Yb, DM))
    SYNC();
    PH(19, phase_post(p, 0, ML, Yb, 0, 1, 2, p.in[7] + 1024, p.in[8] + 1024, 1, 3, U, 0, (int)gridDim.x))
    SYNC();
    PH(20, gemm_swiglu(lds, U, (const bf16*)(ws + WS_WGU1), ML, Zb))
    SYNC();
    PH(21, gemm_store(lds, Zb, (const bf16*)(ws + WS_WDN1), ML, DM, DFF, Yb, DM))
    SYNC();
    PH(22, phase_post(p, 0, ML, Yb, 0, 1, 5, p.in[9] + 1024, nullptr, 1, 0, nullptr, 0, (int)gridDim.x))
#undef SYNC
#undef PH
#undef PH1
}

extern "C" void kernel_launch(void* const* d_in, const int* in_sizes, int n_in, void* d_out, int out_size,
                              void* d_ws, size_t ws_size, hipStream_t stream) {
    static int grid_blocks = 0;
    if (grid_blocks == 0) {
        int dev = 0, cus = 0, per_cu = 0;
        (void)hipGetDevice(&dev);
        (void)hipDeviceGetAttribute(&cus, hipDeviceAttributeMultiprocessorCount, dev);
        (void)hipFuncSetAttribute((const void*)fwd_megakernel, hipFuncAttributeMaxDynamicSharedMemorySize, LDS_BYTES);
        (void)hipOccupancyMaxActiveBlocksPerMultiprocessor(&per_cu, (const void*)fwd_megakernel, NTHREADS, LDS_BYTES);
        if (per_cu < 1) { fprintf(stderr, "kernel_launch: occupancy query says %d blocks/CU\n", per_cu); per_cu = 1; }
        grid_blocks = cus;
        if (n_in != 28 || ws_size < WS_END) fprintf(stderr, "kernel_launch: unexpected n_in %d / ws_size %zu (need %zu)\n", n_in, ws_size, (size_t)WS_END);
    }
    (void)hipMemsetAsync((unsigned char*)d_ws + WS_CTL, 0, 16384 + 1024, stream);
    KParams p{};
    for (int i = 0; i < 28; ++i) p.in[i] = (const float*)d_in[i];
    p.out = (float*)d_out; p.ws = (unsigned char*)d_ws;
    void* args[] = {&p};
    hipError_t e = hipLaunchCooperativeKernel((void*)fwd_megakernel, dim3(grid_blocks), dim3(NTHREADS), args, LDS_BYTES, stream);
    if (e != hipSuccess) fprintf(stderr, "cooperative launch failed: %s (grid %d)\n", hipGetErrorString(e), grid_blocks);
}
```

```cpp
#include <hip/hip_runtime.h>
#include <hip/hip_cooperative_groups.h>
#include <cstdio>
#include <cstdint>
namespace cg = cooperative_groups;
__device__ __forceinline__ int tid_fresh() { int t = threadIdx.x; asm volatile("" : "+v"(t)); return t; }
namespace pg8 {
#define PG8_LAS __attribute__((address_space(3)))
typedef unsigned short bf16_t;
typedef short bf16x8 __attribute__((ext_vector_type(8)));
typedef float f32x4 __attribute__((ext_vector_type(4)));
typedef unsigned u32x4 __attribute__((ext_vector_type(4)));
constexpr int BM = 256, BK = 64, HALF = 128, HTB = HALF * BK * 2  , STAGE_BYTES = 8 * HTB, NXCD = 8, WGM = 8;

__host__ __device__ __forceinline__ int lds_byte(int r, int c) { const int st = (r >> 4) * 2 + (c >> 5), rr = r & 15, cc = c & 31, ob = rr * 64 + cc * 2; return st * 1024 + (ob ^ (((ob >> 9) & 1) << 5)); }
__host__ __device__ __forceinline__ void stage_rc(int b, int& R, int& C) { const int st = b / 1024, sb = b % 1024, swz = sb ^ (((sb >> 9) & 1) << 5); R = (st >> 1) * 16 + swz / 64; C = (st & 1) * 32 + (swz % 64) / 2; }
__host__ __device__ __forceinline__ int perm32(int rho) { const int n = rho >> 4, i = rho & 15; return 8 * (i >> 2) + 4 * n + (i & 3); }

struct Unit { int pm, pn; };
struct Gemm { const bf16_t* A; const bf16_t* Bt; int M, N, K; };

struct StaticOrder {
    int nM, nN, nwg, G, c;
    __host__ __device__ void init(int M, int N, int G_, int c_) { nM = M / BM; nN = N / BM; nwg = nM * nN; G = G_; c = c_; }
    __host__ __device__ bool next(int i, Unit& u) const {
        const long L = (long)i * G + c; if (L >= nwg) return false;
        int wgid = (int)L; { const int q = nwg / NXCD, r = nwg % NXCD, xcd = wgid % NXCD, off = wgid / NXCD; wgid = (xcd < r ? xcd * (q + 1) : r * (q + 1) + (xcd - r) * q) + off; }
        const int nig = WGM * nN, gid = wgid / nig, fm = gid * WGM, gsz = (nM - fm) < WGM ? (nM - fm) : WGM;
        u.pm = fm + ((wgid % nig) % gsz); u.pn = (wgid % nig) / gsz; return true;
    }
    __device__ __forceinline__ void a_ready(const Unit&) const {}
    __device__ __forceinline__ void done(const Unit&) const {}
};

__device__ __forceinline__ unsigned cvt_pk_bf16(float lo, float hi) { unsigned r; asm volatile("v_cvt_pk_bf16_f32 %0, %1, %2" : "=v"(r) : "v"(lo), "v"(hi)); return r; }
typedef float f32x2 __attribute__((ext_vector_type(2)));
__device__ __forceinline__ f32x2 gelu_pk(f32x2 v) {
    const f32x2 av = __builtin_elementwise_abs(v), d = av * 0.2316418882f + 1.0f;
    f32x2 t; t.x = __builtin_amdgcn_rcpf(d.x); t.y = __builtin_amdgcn_rcpf(d.y);
    f32x2 q = t * 0.5307027145f + (-0.7265760135f); q = q * t + 0.7107068705f; q = q * t + (-0.142248368f); q = q * t + 0.127414796f; q = q * t;
    const f32x2 s = (v * v) * (-0.72134752044f);
    f32x2 e; e.x = __builtin_amdgcn_exp2f(s.x); e.y = __builtin_amdgcn_exp2f(s.y);
    const f32x2 m = v * (q * e), r = v - m;
    f32x2 o; o.x = v.x < 0.f ? m.x : r.x; o.y = v.y < 0.f ? m.y : r.y; return o;
}

template <int ACT  > struct EpiBf16 {
    static constexpr bool PERM = true, AFTER_DRAIN = false; static_assert(ACT == 0 || ACT == 1, "EpiBf16: ACT is 0 (none) or 1 (gelu_pk)");
    bf16_t* O; int ldc; const float* bias; int split_cols; size_t split_stride; float scale0;
    __device__ __forceinline__ void operator()(const f32x4 (&acc)[2][2][4][2], const Unit& u, int wr, int wc, int fr, int fq) const {
        const int row0 = u.pm * BM + wr * 64 + fr; int colt = u.pn * BM; bf16_t* base = O;
        float sc = 1.f; if (split_cols) { const int t = colt / split_cols; base += (size_t)t * split_stride; colt -= t * split_cols; if (t == 0) sc = scale0; }
        const int col0 = colt + wc * 32 + 8 * fq, bcol0 = u.pn * BM + wc * 32 + 8 * fq;
        f32x4 bv[2][2];
#pragma unroll
        for (int bj = 0; bj < 2; ++bj)
#pragma unroll
            for (int n = 0; n < 2; ++n) bv[bj][n] = bias ? *(const f32x4*)(bias + bcol0 + bj * HALF + 4 * n) : (f32x4){0.f, 0.f, 0.f, 0.f};
#pragma unroll
        for (int ai = 0; ai < 2; ++ai)
#pragma unroll
            for (int m = 0; m < 4; ++m) { bf16_t* rowp = base + (size_t)(row0 + ai * HALF + m * 16) * ldc + col0;
#pragma unroll
                for (int bj = 0; bj < 2; ++bj) { f32x4 v0 = acc[ai][bj][m][0] + bv[bj][0], v1 = acc[ai][bj][m][1] + bv[bj][1];
                    if (ACT == 1) { f32x2 a = gelu_pk((f32x2){v0[0], v0[1]}), b = gelu_pk((f32x2){v0[2], v0[3]}), c = gelu_pk((f32x2){v1[0], v1[1]}), d = gelu_pk((f32x2){v1[2], v1[3]});
                        v0 = (f32x4){a.x, a.y, b.x, b.y}; v1 = (f32x4){c.x, c.y, d.x, d.y}; }
                    v0 = v0 * sc; v1 = v1 * sc; u32x4 w; w.x = cvt_pk_bf16(v0[0], v0[1]); w.y = cvt_pk_bf16(v0[2], v0[3]); w.z = cvt_pk_bf16(v1[0], v1[1]); w.w = cvt_pk_bf16(v1[2], v1[3]);
                    *(u32x4*)(rowp + bj * HALF) = w; } }
    }
};

struct PanelStats {
    unsigned* xbuf;
    unsigned* cnt;
    unsigned* tmo;
    int ntn; float eps;
    unsigned code;
    __device__ __forceinline__ bool run(const f32x4 (&v)[2][2][4][2], const Unit& u, int wr, int wc, int fr, int fq, PG8_LAS unsigned char* lds, int wid, int lane) const {
        typedef float f32x2v __attribute__((ext_vector_type(2)));
        PG8_LAS f32x2v* P = (PG8_LAS f32x2v*)lds;
        PG8_LAS f32x2v* S = (PG8_LAS f32x2v*)(lds + 8192);
        PG8_LAS unsigned* flag = (PG8_LAS unsigned*)(lds + 8192 + 2048);
#pragma unroll
        for (int ai = 0; ai < 2; ++ai)
#pragma unroll
            for (int m = 0; m < 4; ++m) {
                float s = 0.f;
#pragma unroll
                for (int bj = 0; bj < 2; ++bj)
#pragma unroll
                    for (int n = 0; n < 2; ++n) { const f32x4 x = v[ai][bj][m][n]; s += (x[0] + x[1]) + (x[2] + x[3]); }
                s += __shfl_xor(s, 16); s += __shfl_xor(s, 32);
                const float mw = s * (1.0f / 64.0f); float q = 0.f;
#pragma unroll
                for (int bj = 0; bj < 2; ++bj)
#pragma unroll
                    for (int n = 0; n < 2; ++n) { const f32x4 d = v[ai][bj][m][n] - mw; q += (d[0] * d[0] + d[1] * d[1]) + (d[2] * d[2] + d[3] * d[3]); }
                q += __shfl_xor(q, 16); q += __shfl_xor(q, 32);
                if (fq == 0) P[(ai * HALF + wr * 64 + m * 16 + fr) * 4 + wc] = (f32x2v){mw, q};
            }
        asm volatile("s_waitcnt lgkmcnt(0)" ::: "memory"); __builtin_amdgcn_s_barrier(); asm volatile("" ::: "memory");
#if defined(BROKEN_EXCHANGE_NO_WAIT)
#warning BROKEN CONTROL BUILD: the row-statistics exchange does not wait; results are wrong by design
        if (blockIdx.x >= 64) { const long long t0_ = clock64(); while (clock64() - t0_ < 60000) __builtin_amdgcn_s_sleep(8); }
#endif
        const int row = wid * 32 + (lane & 31);
        if (lane < 32) {
            const f32x2v a = P[row * 4 + 0], b = P[row * 4 + 1], c = P[row * 4 + 2], d = P[row * 4 + 3];
            const float mt = (a.x + b.x + c.x + d.x) * 0.25f;
            const float da = a.x - mt, db = b.x - mt, dc = c.x - mt, dd = d.x - mt;
            const float m2 = (a.y + b.y) + (c.y + d.y) + 64.0f * ((da * da + db * db) + (dc * dc + dd * dd));
            unsigned long long* slot = (unsigned long long*)xbuf + ((size_t)(u.pm * BM + row) * 4 + u.pn);
            __hip_atomic_store(slot, ((unsigned long long)__float_as_uint(m2) << 32) | __float_as_uint(mt), __ATOMIC_RELAXED, __HIP_MEMORY_SCOPE_AGENT);
        }
        asm volatile("s_waitcnt vmcnt(0)" ::: "memory");
        if (lane == 0) __hip_atomic_fetch_add(cnt + 64 * u.pm, 1u, __ATOMIC_RELAXED, __HIP_MEMORY_SCOPE_AGENT);
        if (wid == 0) {
            bool dead = false; const unsigned long long t0 = __builtin_amdgcn_s_memrealtime(); const unsigned want = 8u * (unsigned)ntn;
            for (;;) {
#if defined(BROKEN_EXCHANGE_NO_WAIT)
                break;
#endif
                if ((unsigned)__builtin_amdgcn_readfirstlane(__hip_atomic_load(cnt + 64 * u.pm, __ATOMIC_RELAXED, __HIP_MEMORY_SCOPE_AGENT)) >= want) break;
                if (__builtin_amdgcn_s_memrealtime() - t0 > 2000000ull) {
                    if (lane == 0) { unsigned expect = 0u; __hip_atomic_compare_exchange_strong(tmo + 1, &expect, code | (unsigned)(u.pm & 0xff), __ATOMIC_RELAXED, __ATOMIC_RELAXED, __HIP_MEMORY_SCOPE_AGENT);
                                     __hip_atomic_store(tmo, 1u, __ATOMIC_RELAXED, __HIP_MEMORY_SCOPE_AGENT); }
                    dead = true; break; }
                __builtin_amdgcn_s_sleep(2);
            }
            __builtin_amdgcn_fence(__ATOMIC_ACQUIRE, "agent");
            if (lane == 0) flag[0] = dead ? 1u : 0u;
        }
        asm volatile("s_waitcnt vmcnt(0) lgkmcnt(0)" ::: "memory"); __builtin_amdgcn_s_barrier(); asm volatile("" ::: "memory");
        const bool bad = flag[0] != 0u;
        if (lane < 32) {
            const unsigned long long* slot = (const unsigned long long*)xbuf + (size_t)(u.pm * BM + row) * 4; float mt[4], m2[4]; float ms = 0.f;
#pragma unroll
            for (int t = 0; t < 4; ++t) { if (t < ntn) { const unsigned long long w = __hip_atomic_load(slot + t, __ATOMIC_RELAXED, __HIP_MEMORY_SCOPE_AGENT); mt[t] = __uint_as_float((unsigned)w); m2[t] = __uint_as_float((unsigned)(w >> 32)); } else { mt[t] = 0.f; m2[t] = 0.f; } ms += mt[t]; }
            const float mean = ms / (float)ntn; float q = 0.f;
#pragma unroll
            for (int t = 0; t < 4; ++t) if (t < ntn) { const float dm = mt[t] - mean; q += m2[t] + 256.0f * dm * dm; }
            S[row] = (f32x2v){mean, 1.0f / sqrtf(q / (256.0f * (float)ntn) + eps)};
        }
        asm volatile("s_waitcnt lgkmcnt(0)" ::: "memory"); __builtin_amdgcn_s_barrier(); asm volatile("" ::: "memory");
        return bad;
    }
};
struct EpiLnRes {
    static constexpr bool PERM = false, AFTER_DRAIN = true;
    const float* base; float* out; int ldc; const float* bias; PanelStats st; unsigned poison;
    __device__ __forceinline__ void fused(f32x4 (&acc)[2][2][4][2], const Unit& u, int wr, int wc, int fr, int fq, PG8_LAS unsigned char* lds, int wid, int lane) const {
        typedef float f32x2v __attribute__((ext_vector_type(2)));
        const PG8_LAS f32x2v* S = (const PG8_LAS f32x2v*)(lds + 8192);
        const int col0 = u.pn * BM + wc * 32 + 4 * fq;
#pragma unroll
        for (int bj = 0; bj < 2; ++bj)
#pragma unroll
            for (int n = 0; n < 2; ++n) { const f32x4 bv = bias ? *(const f32x4*)(bias + col0 + bj * HALF + n * 16) : (f32x4){0.f, 0.f, 0.f, 0.f};
#pragma unroll
                for (int ai = 0; ai < 2; ++ai)
#pragma unroll
                    for (int m = 0; m < 4; ++m) acc[ai][bj][m][n] += bv; }
        f32x4 pre[4][2][2];
#pragma unroll
        for (int m = 0; m < 4; ++m) { const size_t off = (size_t)(u.pm * BM + wr * 64 + m * 16 + fr) * ldc + col0;
#pragma unroll
            for (int bj = 0; bj < 2; ++bj)
#pragma unroll
                for (int n = 0; n < 2; ++n) pre[m][bj][n] = *(const f32x4*)(base + off + bj * HALF + n * 16); }
        const bool bad = st.run(acc, u, wr, wc, fr, fq, lds, wid, lane) || poison != 0u;
        const float qnan = __builtin_nanf("");
#pragma unroll
        for (int ai = 0; ai < 2; ++ai)
#pragma unroll
            for (int m = 0; m < 4; ++m) { const int r = ai * HALF + wr * 64 + m * 16 + fr; const f32x2v sr = S[r]; const size_t off = (size_t)(u.pm * BM + r) * ldc + col0;
#pragma unroll
                for (int bj = 0; bj < 2; ++bj)
#pragma unroll
                    for (int n = 0; n < 2; ++n) { const f32x4 bs = ai == 0 ? pre[m][bj][n] : *(const f32x4*)(base + off + bj * HALF + n * 16); f32x4 o = bs + (acc[ai][bj][m][n] - sr.x) * sr.y;
                        if (bad) o = (f32x4){qnan, qnan, qnan, qnan}; *(f32x4*)(out + off + bj * HALF + n * 16) = o; }
                if (m & 1) asm volatile("" ::: "memory"); }
    }
};
struct EpiLnResLn {
    static constexpr bool PERM = false, AFTER_DRAIN = true;
    const float* base; float* out; bf16_t* xn; int ldc; const float* bias; PanelStats st1, st2; unsigned poison;
    __device__ __forceinline__ void fused(f32x4 (&acc)[2][2][4][2], const Unit& u, int wr, int wc, int fr, int fq, PG8_LAS unsigned char* lds, int wid, int lane) const {
        typedef float f32x2v __attribute__((ext_vector_type(2))); typedef unsigned u32x2v __attribute__((ext_vector_type(2)));
        const PG8_LAS f32x2v* S = (const PG8_LAS f32x2v*)(lds + 8192);
        const int col0 = u.pn * BM + wc * 32 + 4 * fq;
#pragma unroll
        for (int bj = 0; bj < 2; ++bj)
#pragma unroll
            for (int n = 0; n < 2; ++n) { const f32x4 bv = bias ? *(const f32x4*)(bias + col0 + bj * HALF + n * 16) : (f32x4){0.f, 0.f, 0.f, 0.f};
#pragma unroll
                for (int ai = 0; ai < 2; ++ai)
#pragma unroll
                    for (int m = 0; m < 4; ++m) acc[ai][bj][m][n] += bv; }
        bool bad = st1.run(acc, u, wr, wc, fr, fq, lds, wid, lane) || poison != 0u;
        const float qnan = __builtin_nanf("");
#pragma unroll
        for (int ai = 0; ai < 2; ++ai)
#pragma unroll
            for (int m = 0; m < 4; ++m) { const int r = ai * HALF + wr * 64 + m * 16 + fr; const f32x2v sr = S[r]; const size_t off = (size_t)(u.pm * BM + r) * ldc + col0;
#pragma unroll
                for (int bj = 0; bj < 2; ++bj)
#pragma unroll
                    for (int n = 0; n < 2; ++n) { const f32x4 bs = *(const f32x4*)(base + off + bj * HALF + n * 16); acc[ai][bj][m][n] = bs + (acc[ai][bj][m][n] - sr.x) * sr.y; }
                asm volatile("" : "+v"(acc[ai][0][m][0]), "+v"(acc[ai][0][m][1]), "+v"(acc[ai][1][m][0]), "+v"(acc[ai][1][m][1]));
                if (m & 1) asm volatile("" ::: "memory"); }
        const bool bad1 = bad;
        bad = st2.run(acc, u, wr, wc, fr, fq, lds, wid, lane) || bad;
#pragma unroll
        for (int ai = 0; ai < 2; ++ai)
#pragma unroll
            for (int m = 0; m < 4; ++m) { const int r = ai * HALF + wr * 64 + m * 16 + fr; const f32x2v sr = S[r]; const size_t off = (size_t)(u.pm * BM + r) * ldc + col0;
#pragma unroll
                for (int bj = 0; bj < 2; ++bj)
#pragma unroll
                    for (int n = 0; n < 2; ++n) { const f32x4 x1 = acc[ai][bj][m][n]; *(f32x4*)(out + off + bj * HALF + n * 16) = bad1 ? (f32x4){qnan, qnan, qnan, qnan} : x1;
                        const f32x4 o = (x1 - sr.x) * sr.y; u32x2v w; w.x = cvt_pk_bf16(o[0], o[1]); w.y = cvt_pk_bf16(o[2], o[3]);
                        if (bad) { w.x = 0x7fc07fc0u; w.y = 0x7fc07fc0u; } *(u32x2v*)(xn + off + bj * HALF + n * 16) = w; }
                asm volatile("" ::: "memory"); }
    }
};

template <class Epi, class Sched, bool ALIGN_EPI = false, bool SP2 = false>
__device__ __forceinline__ void gemm_phase(PG8_LAS unsigned char* lds, const Gemm g, const Sched& S, const Epi& E) {
    const int tid = ::tid_fresh(), wid = __builtin_amdgcn_readfirstlane(tid >> 6), lane = tid & 63, wr = wid >> 2, wc = wid & 3, fr = lane & 15, fq = lane >> 4;
    const int K = g.K, nt = K / BK;
    unsigned voffA[2], voffB[2];
#pragma unroll
    for (int i = 0; i < 2; ++i) { int R, C; stage_rc(tid * 16 + i * 8192, R, C); const int Rb = Epi::PERM ? ((R & ~31) + perm32(R & 31)) : R;
        voffA[i] = (unsigned)(R * K + C) * 2u; voffB[i] = (unsigned)(Rb * K + C) * 2u; }
    const size_t kstep = (size_t)(BK * 2);
    const size_t hstep = (size_t)HALF * K * 2;
    const size_t tstep = 2 * hstep;
    const unsigned ldsw = (unsigned)wid * 1024u;
    const int aoff = lds_byte(wr * 64 + fr, fq * 8), boff = lds_byte(wc * 32 + fr, fq * 8);
#define PG8_SA(b, h) (((b) * 2 + (h)) * HTB)
#define PG8_SB(b, h) ((4 + (b) * 2 + (h)) * HTB)
#define PG8_STAGE(bufoff, gbase, voff) do { _Pragma("unroll") for (int _i = 0; _i < 2; ++_i) \
        __builtin_amdgcn_global_load_lds((const unsigned*)((const char*)(gbase) + (voff)[_i]), (PG8_LAS unsigned*)(lds + (bufoff) + ldsw + _i * 8192), 16, 0, 0); } while (0)
#define PG8_LDA(dst, b, h) do { _Pragma("unroll") for (int m = 0; m < 4; ++m) _Pragma("unroll") for (int k = 0; k < 2; ++k) dst[m][k] = *(const PG8_LAS bf16x8*)(lds + PG8_SA(b, h) + aoff + m * 2048 + k * 1024); } while (0)
#define PG8_LDB(dst, b, h) do { _Pragma("unroll") for (int n = 0; n < 2; ++n) _Pragma("unroll") for (int k = 0; k < 2; ++k) dst[n][k] = *(const PG8_LAS bf16x8*)(lds + PG8_SB(b, h) + boff + n * 2048 + k * 1024); } while (0)
#define PG8_MMA(ai, bj, At, Bt) do { __builtin_amdgcn_s_setprio(1); _Pragma("unroll") for (int m = 0; m < 4; ++m) _Pragma("unroll") for (int n = 0; n < 2; ++n) _Pragma("unroll") for (int k = 0; k < 2; ++k) \
        acc[ai][bj][m][n] = __builtin_amdgcn_mfma_f32_16x16x32_bf16(Bt[n][k], At[m][k], acc[ai][bj][m][n], 0, 0, 0); __builtin_amdgcn_s_setprio(0); } while (0)
#define PG8_WAIT_V(n) asm volatile("s_waitcnt vmcnt(" #n ")" ::: "memory")
#define PG8_WAIT_L(n) asm volatile("s_waitcnt lgkmcnt(" #n ")" ::: "memory")
#define PG8_BAR __builtin_amdgcn_s_barrier()
#define PG8_SCHED __builtin_amdgcn_sched_barrier(0)
    Unit cur, nxt; int ui = 0;
    if (!S.next(0, cur)) return;
    f32x4 acc[2][2][4][2];
#pragma unroll
    for (int a = 0; a < 2; ++a)
#pragma unroll
        for (int b = 0; b < 2; ++b)
#pragma unroll
            for (int m = 0; m < 4; ++m)
#pragma unroll
                for (int n = 0; n < 2; ++n) acc[a][b][m][n] = (f32x4){0.f, 0.f, 0.f, 0.f};
    bf16x8 At[4][2], B0[2][2], B1[2][2];
    const char* cA = (const char*)g.A + (size_t)cur.pm * tstep; const char* cB = (const char*)g.Bt + (size_t)cur.pn * tstep;
    S.a_ready(cur);
    if constexpr (SP2) {
        PG8_STAGE(PG8_SB(0, 0), cB, voffB); PG8_STAGE(PG8_SB(0, 1), cB + hstep, voffB); PG8_STAGE(PG8_SA(0, 0), cA, voffA); PG8_STAGE(PG8_SA(0, 1), cA + hstep, voffA);
        if (wr == 1) PG8_BAR;
        PG8_WAIT_V(2); PG8_BAR;
        PG8_STAGE(PG8_SB(1, 0), cB + kstep, voffB); PG8_STAGE(PG8_SA(1, 0), cA + kstep, voffA); PG8_STAGE(PG8_SB(1, 1), cB + hstep + kstep, voffB);
        PG8_WAIT_V(6); PG8_BAR;
    } else {
        PG8_STAGE(PG8_SB(0, 0), cB, voffB); PG8_STAGE(PG8_SA(0, 0), cA, voffA); PG8_STAGE(PG8_SB(0, 1), cB + hstep, voffB); PG8_STAGE(PG8_SA(0, 1), cA + hstep, voffA);
        if (wr == 1) PG8_BAR;
        PG8_WAIT_V(4); PG8_BAR;
        PG8_STAGE(PG8_SB(1, 0), cB + kstep, voffB); PG8_STAGE(PG8_SA(1, 0), cA + kstep, voffA); PG8_STAGE(PG8_SB(1, 1), cB + hstep + kstep, voffB);
        PG8_WAIT_V(6); PG8_BAR;
    }
    for (;;) {
        const bool has_next = S.next(ui + 1, nxt);
        const char* nA = has_next ? (const char*)g.A + (size_t)nxt.pm * tstep : cA; const char* nB = has_next ? (const char*)g.Bt + (size_t)nxt.pn * tstep : cB;
        for (int t = 0; t < nt; t += 2) {
            const bool last = (t == nt - 2);
            const char* a1 = cA + (size_t)(t + 1) * kstep;
            const char* a2 = last ? nA : cA + (size_t)(t + 2) * kstep; const char* b2 = last ? nB : cB + (size_t)(t + 2) * kstep;
            const char* a3 = a2 + kstep; const char* b3 = b2 + kstep;
            if (last && has_next) S.a_ready(nxt);
            if constexpr (SP2) {
            PG8_LDB(B0, 0, 0); PG8_LDB(B1, 0, 1); PG8_SCHED; PG8_LDA(At, 0, 0); PG8_STAGE(PG8_SA(1, 1), a1 + hstep, voffA);
            PG8_WAIT_V(8); PG8_WAIT_L(0); PG8_BAR; PG8_MMA(0, 0, At, B0); PG8_MMA(0, 1, At, B1); PG8_BAR; PG8_SCHED;
            PG8_LDA(At, 0, 1); PG8_STAGE(PG8_SB(0, 0), b2, voffB); PG8_STAGE(PG8_SB(0, 1), b2 + hstep, voffB); PG8_STAGE(PG8_SA(0, 0), a2, voffA);
            PG8_WAIT_V(8); PG8_WAIT_L(0); PG8_BAR; PG8_MMA(1, 0, At, B0); PG8_MMA(1, 1, At, B1); PG8_BAR; PG8_SCHED;
            PG8_LDB(B0, 1, 0); PG8_LDB(B1, 1, 1); PG8_SCHED; PG8_LDA(At, 1, 0); PG8_STAGE(PG8_SA(0, 1), a2 + hstep, voffA);
            PG8_WAIT_V(8); PG8_WAIT_L(0); PG8_BAR; PG8_MMA(0, 0, At, B0); PG8_MMA(0, 1, At, B1); PG8_BAR; PG8_SCHED;
            PG8_LDA(At, 1, 1); PG8_STAGE(PG8_SB(1, 0), b3, voffB); PG8_STAGE(PG8_SB(1, 1), b3 + hstep, voffB); PG8_STAGE(PG8_SA(1, 0), a3, voffA);
            PG8_WAIT_V(8); PG8_WAIT_L(0); PG8_BAR; PG8_MMA(1, 0, At, B0); PG8_MMA(1, 1, At, B1); PG8_BAR; PG8_SCHED;
            } else {
            PG8_LDB(B0, 0, 0); PG8_SCHED; PG8_LDA(At, 0, 0); PG8_STAGE(PG8_SA(1, 1), a1 + hstep, voffA);
            PG8_WAIT_L(8); PG8_BAR; PG8_WAIT_L(0); PG8_MMA(0, 0, At, B0); PG8_BAR; PG8_SCHED;
            PG8_LDB(B1, 0, 1); PG8_STAGE(PG8_SB(0, 0), b2, voffB);
            PG8_BAR; PG8_WAIT_L(0); PG8_MMA(0, 1, At, B1); PG8_BAR;
            PG8_LDA(At, 0, 1); PG8_STAGE(PG8_SA(0, 0), a2, voffA);
            PG8_BAR; PG8_WAIT_L(0); PG8_MMA(1, 0, At, B0); PG8_BAR; PG8_SCHED;
            PG8_STAGE(PG8_SB(0, 1), b2 + hstep, voffB);
            PG8_WAIT_V(6); PG8_BAR; PG8_MMA(1, 1, At, B1); PG8_BAR;
            PG8_LDB(B0, 1, 0); PG8_SCHED; PG8_LDA(At, 1, 0); PG8_STAGE(PG8_SA(0, 1), a2 + hstep, voffA);
            PG8_WAIT_L(8); PG8_BAR; PG8_WAIT_L(0); PG8_MMA(0, 0, At, B0); PG8_BAR; PG8_SCHED;
            PG8_LDB(B1, 1, 1); PG8_STAGE(PG8_SB(1, 0), b3, voffB);
            PG8_BAR; PG8_WAIT_L(0); PG8_MMA(0, 1, At, B1); PG8_BAR;
            PG8_LDA(At, 1, 1); PG8_STAGE(PG8_SA(1, 0), a3, voffA);
            PG8_BAR; PG8_WAIT_L(0); PG8_MMA(1, 0, At, B0); PG8_BAR; PG8_SCHED;
            PG8_STAGE(PG8_SB(1, 1), b3 + hstep, voffB);
            PG8_WAIT_V(6); PG8_BAR; PG8_MMA(1, 1, At, B1); PG8_BAR;
            }
        }
        if constexpr (ALIGN_EPI) { if (wr == 0) PG8_BAR; }
        if constexpr (!Epi::AFTER_DRAIN) { E(acc, cur, wr, wc, fr, fq); S.done(cur); }
        if (!has_next) break;
#pragma unroll
        for (int a = 0; a < 2; ++a)
#pragma unroll
            for (int b = 0; b < 2; ++b)
#pragma unroll
                for (int m = 0; m < 4; ++m)
#pragma unroll
                    for (int n = 0; n < 2; ++n) acc[a][b][m][n] = (f32x4){0.f, 0.f, 0.f, 0.f};
        cur = nxt; cA = nA; cB = nB; ++ui;
        if constexpr (ALIGN_EPI) { if (wr == 1) PG8_BAR; }
    }
    PG8_WAIT_V(0);
    if constexpr (!ALIGN_EPI) { if (wr == 0) PG8_BAR; }
    PG8_BAR;
    if constexpr (Epi::AFTER_DRAIN) { E.fused(acc, cur, wr, wc, fr, fq, lds, wid, lane); S.done(cur); }
#undef PG8_SA
#undef PG8_SB
#undef PG8_STAGE
#undef PG8_LDA
#undef PG8_LDB
#undef PG8_MMA
#undef PG8_WAIT_V
#undef PG8_WAIT_L
#undef PG8_BAR
#undef PG8_SCHED
}
}

#define GAS __attribute__((address_space(1)))
#define LAS __attribute__((address_space(3)))
typedef GAS unsigned gu32;
typedef GAS unsigned long long gu64;
#define RLX_AGENT __ATOMIC_RELAXED, __HIP_MEMORY_SCOPE_AGENT
#define LDS_WAIT() asm volatile("s_waitcnt lgkmcnt(0)" ::: "memory")
#define VM_WAIT() asm volatile("s_waitcnt vmcnt(0)" ::: "memory")
__device__ __forceinline__ unsigned long long rt() { return __builtin_amdgcn_s_memrealtime(); }
#define XB_TMO      128
#define XB_XCNT(j)  (256  + 64 * (j))
#define XB_XSUB(j)  (1280 + 64 * (j))
#define XB_XGEN(j)  (2304 + 64 * (j))
#define XB_TOP      3328
#define XB_TOPGEN   3392
#define XCD_BAR_WORDS 3456
#define XB_SPIN_CAP (1u << 20)

__device__ __forceinline__ unsigned xb_ld(unsigned* p)              { return __hip_atomic_load(p, __ATOMIC_RELAXED, __HIP_MEMORY_SCOPE_AGENT); }
__device__ __forceinline__ unsigned xb_add(unsigned* p, unsigned v) { return __hip_atomic_fetch_add(p, v, __ATOMIC_RELAXED, __HIP_MEMORY_SCOPE_AGENT); }
__device__ __forceinline__ unsigned xb_xcc_id() { return (unsigned)__builtin_amdgcn_s_getreg((3 << 11) | 20) & 0xFu; }
#define XB_SPIN(cond, bar) do { unsigned _sp = 0; while (cond) { __builtin_amdgcn_s_sleep(1); \
    if ((++_sp & 255u) == 0u) { if (xb_ld(&(bar)[XB_TMO])) break; if (_sp > XB_SPIN_CAP) { atomicAdd(&(bar)[XB_TMO], 1u); break; } } } } while (0)

struct XcdBarrier {
    unsigned* bar; unsigned x;
    volatile LAS unsigned* st;
};

__device__ __forceinline__ XcdBarrier xcd_barrier_post(unsigned* bar, volatile LAS unsigned* st) {
    XcdBarrier b; b.bar = bar; b.x = xb_xcc_id(); b.st = st;
    if (threadIdx.x == 0) (void)xb_add(&bar[XB_XCNT(b.x)], 1u);
    return b;
}
__device__ __forceinline__ void xcd_barrier_complete(unsigned* bar, unsigned x, unsigned& nloc, unsigned& nx) {
    const unsigned G = gridDim.x * gridDim.y * gridDim.z;
    unsigned sum, cnt, mine, sp = 0u;
    for (;;) {
        sum = 0u; cnt = 0u; mine = 0u;
#pragma unroll
        for (unsigned j = 0; j < 16; ++j) { const unsigned c = xb_ld(&bar[XB_XCNT(j)]); sum += c; cnt += (c > 0u) ? 1u : 0u; mine = (j == x) ? c : mine; }
        if (sum == G) break;
        __builtin_amdgcn_s_sleep(1);
        if ((++sp & 255u) == 0u) { if (xb_ld(&bar[XB_TMO])) break; if (sp > XB_SPIN_CAP) { atomicAdd(&bar[XB_TMO], 1u); break; } }
    }
    nloc = mine > 0u ? mine : 1u; nx = cnt > 0u ? cnt : 1u;
}

__device__ __forceinline__ void xcd_barrier(const XcdBarrier& b) {
    asm volatile("s_waitcnt vmcnt(0)" ::: "memory");
    __syncthreads();
    if (threadIdx.x == 0) {
        unsigned* bar = b.bar;
        __builtin_amdgcn_s_waitcnt(0);
        unsigned nloc = b.st[0], nx = b.st[1];
        if (nloc == 0u) { xcd_barrier_complete(bar, b.x, nloc, nx); b.st[0] = nloc; b.st[1] = nx; }
        const unsigned old = xb_add(&bar[XB_XSUB(b.x)], 1u);
        const unsigned gen = old / nloc;
        if (old + 1u == (gen + 1u) * nloc) {
            __builtin_amdgcn_fence(__ATOMIC_RELEASE, "agent");
            asm volatile("s_waitcnt vmcnt(0)" ::: "memory");
            const unsigned og = xb_add(&bar[XB_TOP], 1u);
            const unsigned tg = og / nx;
            if (og + 1u == (tg + 1u) * nx) xb_add(&bar[XB_TOPGEN], 1u);
            else XB_SPIN(xb_ld(&bar[XB_TOPGEN]) == tg, bar);
            __builtin_amdgcn_fence(__ATOMIC_ACQUIRE, "agent");
            xb_add(&bar[XB_XGEN(b.x)], 1u);
            asm volatile("s_waitcnt vmcnt(0)" ::: "memory");
        } else {
            XB_SPIN(xb_ld(&bar[XB_XGEN(b.x)]) == gen, bar);
            __builtin_amdgcn_fence(__ATOMIC_ACQUIRE, "agent");
            asm volatile("s_waitcnt vmcnt(0)" ::: "memory");
        }
    }
    __syncthreads();
}


#define DI __device__ __forceinline__
typedef unsigned short bf16;
typedef short bf16x8 __attribute__((ext_vector_type(8)));
typedef short s16x4 __attribute__((ext_vector_type(4)));
typedef float f32x4 __attribute__((ext_vector_type(4)));
typedef float f32x16 __attribute__((ext_vector_type(16)));
typedef unsigned u32x4 __attribute__((ext_vector_type(4)));
typedef unsigned u32x2 __attribute__((ext_vector_type(2)));
typedef float f32x2_t __attribute__((ext_vector_type(2)));
typedef __bf16 bf16x2_t __attribute__((ext_vector_type(2)));

constexpr int DM = 1024, NB = 8, SEQ = 4096, CTXL = 256;
constexpr int ML = NB * SEQ;
constexpr int MC = NB * CTXL;
constexpr int MT = ML + MC;
constexpr int DFF = 2816;
constexpr int NZ0 = 2560;
constexpr int NZ1 = 2304;
constexpr int ZQKV = 0, ZGATE = 1536, ZA = 2048, ZBT = 2064, ZQD = 2080, ZKVD = 2336, ZKPE = 2464;
constexpr int Z1_NAQ = 0, Z1_NAK = 512, Z1_NAV = 1024, Z1_GQ = 1536, Z1_GK = 2048, Z1_GV = 2176;
constexpr float EPS = 1e-6f;
constexpr float LOG2E = 1.4426950408889634f;
constexpr int NTHREADS = 512, NWAVES = 8;
constexpr int LDS_BYTES = 147456;

constexpr size_t MiB = 1048576;
constexpr size_t WS_WIN0 = 0;
constexpr size_t WS_WOUT0 = 5 * MiB;
constexpr size_t WS_WGU0 = 7 * MiB;
constexpr size_t WS_WDN0 = 18 * MiB;
constexpr size_t WS_WQUP = 24 * MiB;
constexpr size_t WS_WKVUP = 24 * MiB + 512 * 1024;
constexpr size_t WS_WIN1 = 25 * MiB;
constexpr size_t WS_WOUT1 = 30 * MiB;
constexpr size_t WS_WGU1 = 32 * MiB;
constexpr size_t WS_WDN1 = 43 * MiB;
constexpr size_t WS_MOD = 49 * MiB;
constexpr size_t WS_HC = 50 * MiB;
constexpr size_t WS_CTL = 60 * MiB;
constexpr size_t WS_QCTR = 60 * MiB + 14336;
constexpr size_t WS_CTL2 = 60 * MiB + 16384;
constexpr size_t WS_SUBCNT = 60 * MiB + 13824;
constexpr size_t WS_ROPE16 = 60 * MiB + 65536;
constexpr size_t WS_ROPE8 = 60 * MiB + 65536 + 8192;
constexpr size_t WS_U = 64 * MiB;
constexpr size_t WS_Z = 132 * MiB;
constexpr size_t WS_S = 320 * MiB;
constexpr size_t WS_TINV = WS_S;
constexpr size_t WS_QN = WS_U;
constexpr size_t WS_KVN = WS_U + 17 * MiB;
constexpr size_t WS_QMLA = 388 * MiB;
constexpr size_t WS_KVMLA = 439 * MiB;
constexpr size_t WS_KPE = 507 * MiB;
constexpr size_t WS_GB = 302 * MiB;
constexpr size_t WS_OBHI = 307 * MiB;
constexpr int OB_SPLIT = 26624;
constexpr size_t OUT_OBLO = 102 * MiB;
constexpr size_t WS_Y = WS_S;
constexpr size_t WS_GQ = WS_S + 70 * MiB;
constexpr size_t WS_GKK = WS_S + 104 * MiB;
constexpr size_t WS_GKV = WS_S + 70 * MiB;
constexpr size_t WS_HB = 436 * MiB;
constexpr size_t WS_END = 510 * MiB;

struct KParams {
    const float* in[28];
    float* out;
    unsigned char* ws;
};

DI float bflo(unsigned w) { return __uint_as_float(w << 16); }
DI float bfhi(unsigned w) { return __uint_as_float(w & 0xffff0000u); }
DI float bf2f(bf16 b) { return __uint_as_float(((unsigned)b) << 16); }
DI unsigned pk2(float lo, float hi) { f32x2_t v = {lo, hi}; bf16x2_t b = __builtin_convertvector(v, bf16x2_t); return __builtin_bit_cast(unsigned, b); }
DI bf16 f2bf(float x) { return (bf16)(pk2(x, 0.f) & 0xffffu); }
DI void unpack8(const u32x4 w, float* f) {
    f[0] = bflo(w.x); f[1] = bfhi(w.x); f[2] = bflo(w.y); f[3] = bfhi(w.y); f[4] = bflo(w.z); f[5] = bfhi(w.z); f[6] = bflo(w.w); f[7] = bfhi(w.w);
}
DI u32x4 pack8(const float* f) { u32x4 w; w.x = pk2(f[0], f[1]); w.y = pk2(f[2], f[3]); w.z = pk2(f[4], f[5]); w.w = pk2(f[6], f[7]); return w; }
DI float wave_sum(float v) {
#pragma unroll
    for (int o = 1; o < 64; o <<= 1) v += __shfl_xor(v, o);
    return v;
}
DI float silu_f(float x) { return x * __builtin_amdgcn_rcpf(1.f + __expf(-x)); }
DI float sigmoid_f(float x) { return 1.f / (1.f + __expf(-x)); }
DI float softplus_f(float x) { return x > 20.f ? x : log1pf(expf(x)); }
DI int crow(int r, int hi) { return (r & 3) + 8 * (r >> 2) + 4 * hi; }
DI int batch_of(int m) { return m < ML ? (m >> 12) : 8; }
DI const float* modp(const KParams& p, int layer, int m) { return (const float*)(p.ws + WS_MOD) + (size_t)(layer * 9 + batch_of(m)) * 6144; }

struct TDesc { int src, src_off, K, N, ldw; unsigned dst_off_kb; int grp, gstride, goff; int nitems; };
constexpr int NTD = 14;
static constexpr TDesc g_td[NTD] = {
    {13, 0, 1024, 2496, 2496, (unsigned)(WS_WIN0 / 1024), 1 << 20, 0, 0, 16 * 39},
    {14, 0, 1024, 1024, 1024, (unsigned)(WS_WOUT0 / 1024), 1 << 20, 0, 0, 16 * 16},
    {10, 0, 1024, 2816, 2816, (unsigned)(WS_WGU0 / 1024), 128, 256, 0, 16 * 44},
    {11, 0, 1024, 2816, 2816, (unsigned)(WS_WGU0 / 1024), 128, 256, 128, 16 * 44},
    {12, 0, 2816, 1024, 1024, (unsigned)(WS_WDN0 / 1024), 1 << 20, 0, 0, 44 * 16},
    {20, 0, 256, 768, 768, (unsigned)(WS_WQUP / 1024), 1 << 20, 0, 0, 4 * 12},
    {22, 0, 128, 1024, 1024, (unsigned)(WS_WKVUP / 1024), 1 << 20, 0, 0, 2 * 16},
    {23, 0, 1024, 2304, 2304, (unsigned)(WS_WIN1 / 1024), 1 << 20, 0, 0, 16 * 36},
    {24, 0, 1024, 1024, 1024, (unsigned)(WS_WOUT1 / 1024), 1 << 20, 0, 0, 16 * 16},
    {10, 1024 * 2816, 1024, 2816, 2816, (unsigned)(WS_WGU1 / 1024), 128, 256, 0, 16 * 44},
    {11, 1024 * 2816, 1024, 2816, 2816, (unsigned)(WS_WGU1 / 1024), 128, 256, 128, 16 * 44},
    {12, 2816 * 1024, 2816, 1024, 1024, (unsigned)(WS_WDN1 / 1024), 1 << 20, 0, 0, 44 * 16},
    {0, 0, 0, 0, 0, 0, 1, 0, 0, 0},
    {0, 0, 0, 0, 0, 0, 1, 0, 0, 0},
};
constexpr int NTD_USED = 12;

DI void transpose_item(const float* W, int K, int N, bf16* WT, int grp, int gstride, int goff, float* scr_, int item, int lane) {
    unsigned* scr = (unsigned*)scr_;
    const int nblk = N / 64, kb = item / nblk, nb = item % nblk, k0 = 64 * kb, n0 = 64 * nb;
    const float* src = W + (size_t)k0 * N + n0 + lane;
#pragma unroll
    for (int hf = 0; hf < 2; ++hf) {
        float w[32];
#pragma unroll
        for (int i = 0; i < 32; ++i) w[i] = src[(size_t)(32 * hf + i) * N];
#pragma unroll
        for (int i = 0; i < 16; ++i) scr[(16 * hf + i) * 66 + lane] = pk2(w[2 * i], w[2 * i + 1]);
    }
    asm volatile("s_waitcnt lgkmcnt(0)" ::: "memory");
    asm volatile("" ::: "memory");
    const int c = lane & 7;
#pragma unroll
    for (int j = 0; j < 8; ++j) {
        const int n = (lane >> 3) + 8 * j; const unsigned* s = scr + (4 * c) * 66 + n;
        u32x4 o; o.x = s[0]; o.y = s[66]; o.z = s[132]; o.w = s[198];
        const int nn = n0 + n; const int drow = (nn / grp) * gstride + (nn % grp) + goff;
        *(u32x4*)(WT + (size_t)drow * K + k0 + 8 * c) = o;
    }
    asm volatile("s_waitcnt lgkmcnt(0)" ::: "memory");
}
constexpr unsigned TD_EARLY = (1u << 0) | (1u << 5) | (1u << 6);
constexpr unsigned TD_LATE = ((1u << NTD_USED) - 1u) & ~TD_EARLY;
constexpr unsigned TD_T2 = (1u << 1) | (1u << 2) | (1u << 3) | (1u << 4) | (1u << 7) | (1u << 8);
constexpr unsigned TD_T12 = (1u << 9) | (1u << 10);
constexpr unsigned TD_T15 = (1u << 11);
static_assert((TD_T2 | TD_T12 | TD_T15) == TD_LATE && (TD_T2 & TD_T12) == 0 && (TD_T2 & TD_T15) == 0 && (TD_T12 & TD_T15) == 0, "weight conversion split");
template <unsigned MASK> DI void weight_transposes(const KParams& p, unsigned char* lds, int gw, int NGW) {
    const int tid = tid_fresh(), lane = tid & 63, wave = tid >> 6;
    float* scr = (float*)(lds + 57344 + wave * 8448);
    int total = 0;
#pragma unroll
    for (int d = 0; d < NTD_USED; ++d) if ((MASK >> d) & 1u) total += g_td[d].nitems;
    for (int it = gw; it < total; it += NGW) {
        int r = it;
#pragma unroll
        for (int d = 0; d < NTD_USED; ++d) if ((MASK >> d) & 1u) {
            if (r >= 0 && r < g_td[d].nitems)
                transpose_item(p.in[g_td[d].src] + g_td[d].src_off, g_td[d].K, g_td[d].N, (bf16*)(p.ws + (size_t)g_td[d].dst_off_kb * 1024), g_td[d].grp, g_td[d].gstride, g_td[d].goff, scr, r, lane);
            r -= g_td[d].nitems;
        }
    }
}
template <unsigned MASK> DI void tail_weight_transposes(const KParams& p, unsigned char* lds, int nunits) {
    const int G = (int)gridDim.x, first = nunits % G;
    if ((int)blockIdx.x >= first) {
        asm volatile("s_waitcnt vmcnt(0) lgkmcnt(0)" ::: "memory"); __syncthreads();
        weight_transposes<MASK>(p, lds, ((int)blockIdx.x - first) * NWAVES + (int)(tid_fresh() >> 6), (G - first) * NWAVES);
    }
}

DI void phase_prologue(const KParams& p, unsigned char* lds) {
    const int tid = tid_fresh(), lane = tid & 63, wave = tid >> 6;
    const int G = gridDim.x;
    float* sc = (float*)lds;
    float* red = (float*)(lds + 36864);
    bool have_sc = false;
    for (int it = blockIdx.x; it < 192; it += G) {
        if (!have_sc) {
            for (int i = tid; i < 9 * 1024; i += NTHREADS) {
                const int bb = i >> 10, k = i & 1023;
                const float cv = bb < 8 ? p.in[1][bb * 1024 + k] : p.in[3][k];
                sc[i] = cv / (1.f + expf(-cv));
            }
            have_sc = true;
        }
        __syncthreads();
        const int layer = it / 96, n0 = (it % 96) * 64;
        const int col = tid & 63, ks = tid >> 6;
        const float* W = p.in[4] + (size_t)layer * 1024 * 6144 + n0 + col;
        float acc[9];
#pragma unroll
        for (int b = 0; b < 9; ++b) acc[b] = 0.f;
        for (int k0 = ks * 128; k0 < ks * 128 + 128; k0 += 32) {
            float w[32];
#pragma unroll
            for (int kk = 0; kk < 32; ++kk) w[kk] = W[(size_t)(k0 + kk) * 6144];
#pragma unroll
            for (int kk = 0; kk < 32; ++kk)
#pragma unroll
                for (int b = 0; b < 9; ++b) acc[b] += sc[b * 1024 + k0 + kk] * w[kk];
        }
#pragma unroll
        for (int b = 0; b < 9; ++b) red[(ks * 9 + b) * 64 + col] = acc[b];
        __syncthreads();
        for (int i = tid; i < 576; i += NTHREADS) {
            const int b = i >> 6, c2 = i & 63; float s = 0.f;
#pragma unroll
            for (int k2 = 0; k2 < 8; ++k2) s += red[(k2 * 9 + b) * 64 + c2];
            s += p.in[5][layer * 6144 + n0 + c2];
            ((float*)(p.ws + WS_MOD))[(size_t)(layer * 9 + b) * 6144 + n0 + c2] = s;
        }
        __syncthreads();
    }
    __syncthreads();
#ifdef ALL_W_EARLY
    weight_transposes<TD_EARLY | TD_LATE>(p, lds, blockIdx.x * NWAVES + wave, G * NWAVES);
#else
    weight_transposes<TD_EARLY>(p, lds, blockIdx.x * NWAVES + wave, G * NWAVES);
#endif
    if (blockIdx.x == G - 1) {
        float2* t16 = (float2*)(p.ws + WS_ROPE16); float2* t8 = (float2*)(p.ws + WS_ROPE8);
        for (int i = tid; i < 1024; i += NTHREADS) {
            const float invf = exp2f(-(float)(i & 15) * (13.287712379549449f / 16.f));
            float sn, cs; sincosf((float)(i >> 4) * invf, &sn, &cs); t16[i] = make_float2(cs, sn);
        }
        {
            const int i = tid;
            const float invf8[8] = {1.f, 0.31622776601683794f, 0.1f, 0.031622776601683794f, 0.01f, 0.0031622776601683794f, 0.001f, 0.00031622776601683794f};
            float iv = invf8[0];
#pragma unroll
            for (int e = 1; e < 8; ++e) iv = ((i & 7) == e) ? invf8[e] : iv;
            float sn, cs; sincosf((float)(i >> 3) * iv, &sn, &cs); t8[i] = make_float2(cs, sn);
        }
    }
    {
        u32x4* z = (u32x4*)(p.ws + WS_WIN0 + (size_t)2496 * 1024 * 2);
        const u32x4 zero = {0u, 0u, 0u, 0u};
        for (int i = blockIdx.x * NTHREADS + tid; i < 64 * 1024 * 2 / 16; i += G * NTHREADS) z[i] = zero;
    }
}

DI void ld8f(const float* p, float* f) { const f32x4 a = *(const f32x4*)p, b2 = *(const f32x4*)(p + 4); f[0] = a.x; f[1] = a.y; f[2] = a.z; f[3] = a.w; f[4] = b2.x; f[5] = b2.y; f[6] = b2.z; f[7] = b2.w; }
DI void st8f(float* p, const float* f) { *(f32x4*)p = (f32x4){f[0], f[1], f[2], f[3]}; *(f32x4*)(p + 4) = (f32x4){f[4], f[5], f[6], f[7]}; }

DI void wave_pair_range(int npairs, int gw, int NGW, int& p0, int& np) {
    const int base = npairs / NGW, rem = npairs % NGW;
    np = base + (gw < rem ? 1 : 0); p0 = gw * base + (gw < rem ? gw : rem);
}
DI void phase_modnorm0(const KParams& p) {
    const int tid_ = tid_fresh(); const int lane = tid_ & 63, wave = tid_ >> 6;
    const int gw = blockIdx.x * NWAVES + wave, NGW = gridDim.x * NWAVES;
    const float* g = p.in[6];
    bf16* U = (bf16*)(p.ws + WS_U);
    float gg[2][8], sh[2][8], scl[2][8];
#pragma unroll
    for (int j = 0; j < 2; ++j) ld8f(g + 8 * lane + 512 * j, gg[j]);
    int p0, np; wave_pair_range(MT / 2, gw, NGW, p0, np);
    int cur_b = -1;
    for (int i = 0; i < np; ++i) {
        const int m0 = 2 * (p0 + i);
        float v[2][2][8];
#pragma unroll
        for (int r = 0; r < 2; ++r) {
            const int m = m0 + r;
            const float* src = m < ML ? p.in[0] + (size_t)m * DM : p.in[2] + (size_t)(m - ML) * DM;
#pragma unroll
            for (int j = 0; j < 2; ++j) ld8f(src + 8 * lane + 512 * j, v[r][j]);
        }
        const int bb = batch_of(m0);
        if (bb != cur_b) {
            cur_b = bb; const float* md = modp(p, 0, m0);
#pragma unroll
            for (int j = 0; j < 2; ++j) { ld8f(md + 8 * lane + 512 * j, sh[j]); ld8f(md + 1024 + 8 * lane + 512 * j, scl[j]); }
        }
#pragma unroll
        for (int r = 0; r < 2; ++r) {
            const int m = m0 + r;
            float ss = 0.f;
#pragma unroll
            for (int j = 0; j < 2; ++j)
#pragma unroll
                for (int e = 0; e < 8; ++e) ss += v[r][j][e] * v[r][j][e];
            const float rstd = rsqrtf(wave_sum(ss) * (1.f / DM) + EPS);
#pragma unroll
            for (int j = 0; j < 2; ++j) {
                float o[8];
#pragma unroll
                for (int e = 0; e < 8; ++e) o[e] = (v[r][j][e] * rstd * gg[j][e]) * (1.f + scl[j][e]) + sh[j][e];
                *(u32x4*)(U + (size_t)m * DM + 8 * lane + 512 * j) = pack8(o);
            }
        }
    }
}

DI void phase_post(const KParams& p, int row0, int rows, const bf16* Y, int first_layer_input, int layer, int gate_chunk,
                   const float* gpost, const float* g2, int nlayer, int nshift_chunk, bf16* Udst, int wg0, int nwg) {
    const int tid_ = tid_fresh(); const int lane = tid_ & 63, wave = tid_ >> 6;
    const int gw = ((int)blockIdx.x - wg0) * NWAVES + wave, NGW = nwg * NWAVES;
    bf16* HB = (bf16*)(p.ws + WS_HB);
    float gp[2][8], gg[2][8], gt[2][8], sh[2][8], scl[2][8];
#pragma unroll
    for (int j = 0; j < 2; ++j) {
        ld8f(gpost + 8 * lane + 512 * j, gp[j]);
        if (Udst) ld8f(g2 + 8 * lane + 512 * j, gg[j]);
    }
    int p0, np; wave_pair_range((rows - row0) / 2, gw, NGW, p0, np);
    int cur_b = -1;
    u32x4 yn[2][2], hn4[2][4];
    auto fetch = [&](int m0) __attribute__((always_inline)) {
#pragma unroll
        for (int r = 0; r < 2; ++r) {
            const int m = m0 + r;
#pragma unroll
            for (int j = 0; j < 2; ++j) yn[r][j] = *(const u32x4*)(Y + (size_t)m * DM + 8 * lane + 512 * j);
            if (first_layer_input) {
                const float* hsrc = m < ML ? p.in[0] + (size_t)m * DM : p.in[2] + (size_t)(m - ML) * DM;
#pragma unroll
                for (int j = 0; j < 2; ++j) { hn4[r][2 * j] = *(const u32x4*)(hsrc + 8 * lane + 512 * j); hn4[r][2 * j + 1] = *(const u32x4*)(hsrc + 8 * lane + 512 * j + 4); }
            } else {
#pragma unroll
                for (int j = 0; j < 2; ++j) hn4[r][2 * j] = *(const u32x4*)(HB + (size_t)m * DM + 8 * lane + 512 * j);
            }
        }
    };
    if (np > 0) fetch(row0 + 2 * p0);
    for (int i = 0; i < np; ++i) {
        const int m0 = row0 + 2 * (p0 + i);
        u32x4 yw[2][2]; float hv[2][2][8];
#pragma unroll
        for (int r = 0; r < 2; ++r)
#pragma unroll
            for (int j = 0; j < 2; ++j) {
                yw[r][j] = yn[r][j];
                if (first_layer_input) {
                    const u32x4 a = hn4[r][2 * j], b2 = hn4[r][2 * j + 1];
                    hv[r][j][0] = __uint_as_float(a.x); hv[r][j][1] = __uint_as_float(a.y); hv[r][j][2] = __uint_as_float(a.z); hv[r][j][3] = __uint_as_float(a.w);
                    hv[r][j][4] = __uint_as_float(b2.x); hv[r][j][5] = __uint_as_float(b2.y); hv[r][j][6] = __uint_as_float(b2.z); hv[r][j][7] = __uint_as_float(b2.w);
                } else unpack8(hn4[r][2 * j], hv[r][j]);
            }
        if (i + 1 < np) fetch(m0 + 2);
        const int bb = batch_of(m0);
        if (bb != cur_b) {
            cur_b = bb; const float* md = modp(p, layer, m0); const float* md2 = modp(p, nlayer, m0);
#pragma unroll
            for (int j = 0; j < 2; ++j) {
                ld8f(md + gate_chunk * 1024 + 8 * lane + 512 * j, gt[j]);
                if (Udst) { ld8f(md2 + nshift_chunk * 1024 + 8 * lane + 512 * j, sh[j]); ld8f(md2 + (nshift_chunk + 1) * 1024 + 8 * lane + 512 * j, scl[j]); }
            }
        }
#pragma unroll
        for (int r = 0; r < 2; ++r) {
            const int m = m0 + r;
            float yy[2][8]; float ss = 0.f;
#pragma unroll
            for (int j = 0; j < 2; ++j) {
                unpack8(yw[r][j], yy[j]);
#pragma unroll
                for (int e = 0; e < 8; ++e) ss += yy[j][e] * yy[j][e];
            }
            const float rstd = rsqrtf(wave_sum(ss) * (1.f / DM) + EPS);
            float hn[2][8]; float ss2 = 0.f;
#pragma unroll
            for (int j = 0; j < 2; ++j) {
                const int c = 8 * lane + 512 * j;
#pragma unroll
                for (int e = 0; e < 8; ++e) { hn[j][e] = hv[r][j][e] + gt[j][e] * (yy[j][e] * rstd * gp[j][e]); ss2 += hn[j][e] * hn[j][e]; }
                if (Udst) *(u32x4*)(HB + (size_t)m * DM + c) = pack8(hn[j]);
                else st8f(p.out + (size_t)m * DM + c, hn[j]);
            }
            if (Udst) {
                const float rstd2 = rsqrtf(wave_sum(ss2) * (1.f / DM) + EPS);
#pragma unroll
                for (int j = 0; j < 2; ++j) {
                    float o[8];
#pragma unroll
                    for (int e = 0; e < 8; ++e) o[e] = (hn[j][e] * rstd2 * gg[j][e]) * (1.f + scl[j][e]) + sh[j][e];
                    *(u32x4*)(Udst + (size_t)m * DM + 8 * lane + 512 * j) = pack8(o);
                }
            }
        }
    }
}

struct EpiSwiglu {
    static constexpr bool PERM = true, AFTER_DRAIN = false;
    bf16* O; int ldc;
    __device__ __forceinline__ void operator()(const pg8::f32x4 (&acc)[2][2][4][2], const pg8::Unit& u, int wr, int wc, int fr, int fq) const {
        const int row0 = u.pm * 256 + wr * 64 + fr; const int col0 = u.pn * 128 + wc * 32 + 8 * fq;
#pragma unroll
        for (int ai = 0; ai < 2; ++ai)
#pragma unroll
            for (int m = 0; m < 4; ++m) {
                bf16* rowp = O + (size_t)(row0 + ai * 128 + m * 16) * ldc + col0;
                const pg8::f32x4 g0 = acc[ai][0][m][0], g1 = acc[ai][0][m][1], u0 = acc[ai][1][m][0], u1 = acc[ai][1][m][1];
                u32x4 w;
                w.x = pk2(silu_f(g0[0]) * u0[0], silu_f(g0[1]) * u0[1]); w.y = pk2(silu_f(g0[2]) * u0[2], silu_f(g0[3]) * u0[3]);
                w.z = pk2(silu_f(g1[0]) * u1[0], silu_f(g1[1]) * u1[1]); w.w = pk2(silu_f(g1[2]) * u1[2], silu_f(g1[3]) * u1[3]);
                *(u32x4*)rowp = w;
            }
    }
};

DI void gemm_store_sub(unsigned char* lds, const bf16* A, const bf16* Bt, int M, int N, int K, bf16* O, int ldc, int wg0, int nwg) {
    pg8::Gemm g{A, Bt, M, N, K}; pg8::StaticOrder S; S.init(M, N, nwg, (int)blockIdx.x - wg0);
    pg8::EpiBf16<0> E{O, ldc, nullptr, 0, 0, 1.f};
    pg8::gemm_phase<pg8::EpiBf16<0>, pg8::StaticOrder, true, true>((PG8_LAS unsigned char*)lds, g, S, E);
}
DI void gemm_store(unsigned char* lds, const bf16* A, const bf16* Bt, int M, int N, int K, bf16* O, int ldc) {
    gemm_store_sub(lds, A, Bt, M, N, K, O, ldc, 0, (int)gridDim.x);
}
DI void gemm_store_rot(unsigned char* lds, const bf16* A, const bf16* Bt, int M, int N, int K, bf16* O, int ldc, int rot) {
    const int G = (int)gridDim.x;
    pg8::Gemm g{A, Bt, M, N, K}; pg8::StaticOrder S; S.init(M, N, G, ((int)blockIdx.x - rot % G + G) % G);
    pg8::EpiBf16<0> E{O, ldc, nullptr, 0, 0, 1.f};
    pg8::gemm_phase<pg8::EpiBf16<0>, pg8::StaticOrder, true, true>((PG8_LAS unsigned char*)lds, g, S, E);
}
DI void sub_barrier(unsigned* cnt, unsigned n) {
    asm volatile("s_waitcnt vmcnt(0)" ::: "memory");
    __syncthreads();
    if (threadIdx.x == 0) {
        __threadfence();
        __hip_atomic_fetch_add(cnt, 1u, __ATOMIC_RELAXED, __HIP_MEMORY_SCOPE_AGENT);
        unsigned spins = 0;
        while (__hip_atomic_load(cnt, __ATOMIC_RELAXED, __HIP_MEMORY_SCOPE_AGENT) < n) { __builtin_amdgcn_s_sleep(2); if (++spins > (1u << 22)) break; }
        __threadfence();
        asm volatile("s_waitcnt vmcnt(0)" ::: "memory");
    }
    __syncthreads();
}
DI void gemm_swiglu(unsigned char* lds, const bf16* A, const bf16* Bt, int M, bf16* O) {
    pg8::Gemm g{A, Bt, M, 2 * DFF, DM}; pg8::StaticOrder S; S.init(M, 2 * DFF, (int)gridDim.x, (int)blockIdx.x);
    EpiSwiglu E{O, DFF};
    pg8::gemm_phase<EpiSwiglu, pg8::StaticOrder, true, true>((PG8_LAS unsigned char*)lds, g, S, E);
}

DI void phase_prep0(const KParams& p) {
    const int tid_ = tid_fresh(); const int lane = tid_ & 63, wave = tid_ >> 6;
    const int gw = blockIdx.x * NWAVES + wave, NGW = gridDim.x * NWAVES;
    const bf16* Z = (const bf16*)(p.ws + WS_Z);
    bf16* QKVC = (bf16*)p.out;
    float* GB = (float*)(p.ws + WS_GB);
    bf16* QN = (bf16*)(p.ws + WS_QN); bf16* KVN = (bf16*)(p.ws + WS_KVN); bf16* KPE = (bf16*)(p.ws + WS_KPE);
    const float* convw = p.in[15];
    const int rows_per_wave = (MT + NGW - 1) / NGW;
#pragma unroll 1
    for (int i = 0; i < 3; ++i) {
        float cw[5][8];
#pragma unroll
        for (int j = 0; j < 5; ++j)
#pragma unroll
            for (int e = 0; e < 8; ++e) cw[j][e] = convw[j * 1536 + 8 * (lane + 64 * i) + e];
        u32x4 wv[5], wn[3];
        for (int ri = 0; ri < rows_per_wave; ++ri) {
            const int m = gw * rows_per_wave + ri;
            if (m >= MT) break;
            int base, L, t;
            if (m < ML) { base = m & ~4095; L = 4096; t = m & 4095; } else { base = ML + ((m - ML) & ~255); L = 256; t = (m - ML) & 255; }
            const bf16* zc = Z + ZQKV + 8 * (lane + 64 * i);
            auto ldrow = [&](int pos) -> u32x4 { pos = pos < 0 ? 0 : (pos > L - 1 ? L - 1 : pos); return *(const u32x4*)(zc + (size_t)(base + pos) * NZ0); };
            if (ri == 0 || t == 0) {
#pragma unroll
                for (int j = 0; j < 5; ++j) wv[j] = ldrow(t + j - 2);
                wn[0] = ldrow(t + 3); wn[1] = ldrow(t + 4); wn[2] = ldrow(t + 5);
            } else {
#pragma unroll
                for (int j = 0; j < 4; ++j) wv[j] = wv[j + 1];
                wv[4] = wn[0]; wn[0] = wn[1]; wn[1] = wn[2];
                wn[2] = ldrow(t + 5);
            }
            float acc[8];
#pragma unroll
            for (int e = 0; e < 8; ++e) acc[e] = 0.f;
            if (t >= 2 && t < L - 2) {
#pragma unroll
                for (int j = 0; j < 5; ++j) {
                    float f[8]; unpack8(wv[j], f);
#pragma unroll
                    for (int e = 0; e < 8; ++e) acc[e] += cw[j][e] * f[e];
                }
            } else {
#pragma unroll
                for (int j = 0; j < 5; ++j) {
                    const int pos = t + j - 2;
                    const float valid = (pos >= 0 && pos < L) ? 1.f : 0.f;
                    float f[8]; unpack8(wv[j], f);
#pragma unroll
                    for (int e = 0; e < 8; ++e) acc[e] += (cw[j][e] * valid) * f[e];
                }
            }
            float ss = 0.f;
#pragma unroll
            for (int e = 0; e < 8; ++e) { acc[e] = acc[e] * __builtin_amdgcn_rcpf(1.f + __expf(-acc[e])); ss += acc[e] * acc[e]; }
            if (i < 2) {
                ss += __shfl_xor(ss, 1); ss += __shfl_xor(ss, 2); ss += __shfl_xor(ss, 4);
                const float inv = rsqrtf(ss + EPS) * (i == 0 ? 0.125f : 1.f);
#pragma unroll
                for (int e = 0; e < 8; ++e) acc[e] *= inv;
            }
            *(u32x4*)(QKVC + (size_t)m * 1536 + 8 * (lane + 64 * i)) = pack8(acc);
        }
    }
    {
        float nrm[8];
#pragma unroll
        for (int e = 0; e < 8; ++e) nrm[e] = lane < 32 ? p.in[19][8 * lane + e] : (lane < 48 ? p.in[21][8 * (lane - 32) + e] : 0.f);
        const float negA = lane < 16 ? -expf(p.in[16][lane]) : 0.f, dtb = lane < 16 ? p.in[17][lane] : 0.f;
        const int col1 = lane < 32 ? ZQD + 8 * lane : (lane < 48 ? ZKVD + 8 * (lane - 32) : ZKPE + 8 * (lane & 1));
        const int col2 = ZKPE + 16 + 8 * (lane & 1);
        const int colg = lane < 16 ? lane : 0;
        u32x4 d1n, d2n; bf16 zan, zbn;
        auto fetch = [&](int m) { const bf16* zr = Z + (size_t)m * NZ0; d1n = *(const u32x4*)(zr + col1); d2n = *(const u32x4*)(zr + col2); zan = zr[ZA + colg]; zbn = zr[ZBT + colg]; };
        const int mfirst = gw * rows_per_wave;
        if (mfirst < MT) fetch(mfirst);
        for (int ri = 0; ri < rows_per_wave; ++ri) {
            const int m = mfirst + ri;
            if (m >= MT) break;
            const int t = m < ML ? (m & 4095) : ((m - ML) & 255);
            const u32x4 d1 = d1n, d2 = d2n; const bf16 za = zan, zb = zbn;
            if (ri + 1 < rows_per_wave && m + 1 < MT) fetch(m + 1);
            if (lane < 16) {
                GB[(size_t)m * 32 + lane] = negA * softplus_f(bf2f(za) + dtb);
                GB[(size_t)m * 32 + 16 + lane] = __builtin_amdgcn_rcpf(1.f + __expf(-bf2f(zb)));
            }
            float f[8]; unpack8(d1, f);
            float ss = 0.f;
#pragma unroll
            for (int e = 0; e < 8; ++e) ss += f[e] * f[e];
            const float sq = wave_sum(lane < 32 ? ss : 0.f), skv = wave_sum((lane >= 32 && lane < 48) ? ss : 0.f);
            if (lane < 48) {
                const float r = lane < 32 ? rsqrtf(sq * (1.f / 256.f) + EPS) : rsqrtf(skv * (1.f / 128.f) + EPS);
#pragma unroll
                for (int e = 0; e < 8; ++e) f[e] = f[e] * r * nrm[e];
                if (lane < 32) *(u32x4*)(QN + (size_t)m * 256 + 8 * lane) = pack8(f);
                else *(u32x4*)(KVN + (size_t)m * 128 + 8 * (lane - 32)) = pack8(f);
            } else if (lane < 50) {
                const int hh = lane - 48;
                float x2[8]; unpack8(d2, x2);
                if (m < ML) {
                    const float2* rt = (const float2*)(p.ws + WS_ROPE8) + (hh ? (t & 63) : (t >> 6)) * 8;
#pragma unroll
                    for (int e = 0; e < 8; ++e) {
                        const float2 cssn = rt[e]; const float cs = cssn.x, sn = cssn.y;
                        const float a = f[e], b2 = x2[e];
                        f[e] = a * cs - b2 * sn; x2[e] = b2 * cs + a * sn;
                    }
                }
                *(u32x4*)(KPE + (size_t)m * 32 + 8 * hh) = pack8(f);
                *(u32x4*)(KPE + (size_t)m * 32 + 16 + 8 * hh) = pack8(x2);
            }
        }
    }
}

DI void phase_prep1(const KParams& p) {
    const int tid_ = tid_fresh(); const int lane = tid_ & 63, wave = tid_ >> 6;
    const int gw = blockIdx.x * NWAVES + wave, NGW = gridDim.x * NWAVES;
    const bf16* Z = (const bf16*)(p.ws + WS_Z);
    bf16* GKV = (bf16*)(p.ws + WS_GKV);
    const float* kn = p.in[27];
    const int l32 = lane & 31, l16 = lane & 15, q8 = lane & 7, rsub = lane >> 5;
    const bool isv = l32 >= 16;
    const int fbase = (8 * (q8 & 3)) & 15;
    const bool use_col = (q8 & 3) >= 2;
    float gk[8];
#pragma unroll
    for (int e = 0; e < 8; ++e) gk[e] = kn[8 * q8 + e];
    for (int m0 = 2 * gw; m0 < MT; m0 += 2 * NGW) {
        const int m = m0 + rsub;
        const bool lat = m < ML;
        const int t = m & 4095;
        const u32x4 raw = *(const u32x4*)(Z + (size_t)m * NZ1 + (isv ? Z1_GV : Z1_GK) + 8 * l16);
        float f[8]; unpack8(raw, f);
        float ss = 0.f;
#pragma unroll
        for (int e = 0; e < 8; ++e) ss += f[e] * f[e];
        ss += __shfl_xor(ss, 1); ss += __shfl_xor(ss, 2); ss += __shfl_xor(ss, 4);
        const float r = rsqrtf(ss * (1.f / 64.f) + EPS);
#pragma unroll
        for (int e = 0; e < 8; ++e) f[e] = f[e] * r * gk[e];
        float o[8];
        const float2* rt = (const float2*)(p.ws + WS_ROPE16) + (use_col ? (t & 63) : (t >> 6)) * 16 + fbase;
#pragma unroll
        for (int e = 0; e < 8; ++e) {
            const float other = __shfl_xor(f[e], 4);
            const float2 v = rt[e];
            o[e] = (q8 < 4) ? f[e] * v.x - other * v.y : f[e] * v.x + other * v.y;
        }
        if (lat) {
#pragma unroll
            for (int e = 0; e < 8; ++e) f[e] = o[e];
        }
        *(u32x4*)(GKV + (size_t)m * 256 + 8 * l32) = isv ? raw : pack8(f);
    }
}

DI void gdn_combine_run(const KParams& p, int p0, int np) {
    const int tid_ = tid_fresh(); const int lane = tid_ & 63;
    const bf16* Z = (const bf16*)(p.ws + WS_Z);
    bf16* MIX = (bf16*)(p.ws + WS_U);
    float on[8];
#pragma unroll
    for (int e = 0; e < 8; ++e) on[e] = p.in[18][8 * (lane & 7) + e];
    u32x4 wa[2], wb[2], wg[2], na[2], nb[2], ng[2];
    auto fetch = [&](int m0, u32x4 (&xa)[2], u32x4 (&xb)[2], u32x4 (&xg)[2]) __attribute__((always_inline)) {
#pragma unroll
        for (int r = 0; r < 2; ++r) {
            const int m = m0 + r;
            const bf16* obp = m < OB_SPLIT ? (const bf16*)((const unsigned char*)p.out + OUT_OBLO) + (size_t)m * 512 : (const bf16*)(p.ws + WS_OBHI) + (size_t)(m - OB_SPLIT) * 512;
            xa[r] = *(const u32x4*)(MIX + (size_t)m * DM + 8 * lane);
            xb[r] = *(const u32x4*)(obp + 8 * lane);
            xg[r] = *(const u32x4*)(Z + (size_t)m * NZ0 + ZGATE + 8 * lane);
        }
    };
    if (np > 0) fetch(2 * p0, na, nb, ng);
    for (int i = 0; i < np; ++i) {
        const int m0 = 2 * (p0 + i);
#pragma unroll
        for (int r = 0; r < 2; ++r) { wa[r] = na[r]; wb[r] = nb[r]; wg[r] = ng[r]; }
        if (i + 1 < np) fetch(m0 + 2, na, nb, ng);
#pragma unroll
        for (int r = 0; r < 2; ++r) {
            const int m = m0 + r;
            float a[8], b2[8], g[8];
            unpack8(wa[r], a); unpack8(wb[r], b2); unpack8(wg[r], g);
            float ss = 0.f;
#pragma unroll
            for (int e = 0; e < 8; ++e) { a[e] += b2[e]; ss += a[e] * a[e]; }
            ss += __shfl_xor(ss, 1); ss += __shfl_xor(ss, 2); ss += __shfl_xor(ss, 4);
            const float rr = rsqrtf(ss * (1.f / 64.f) + EPS);
#pragma unroll
            for (int e = 0; e < 8; ++e) a[e] = a[e] * rr * on[e] * (g[e] * __builtin_amdgcn_rcpf(1.f + __expf(-g[e])));
            *(u32x4*)(MIX + (size_t)m * DM + 8 * lane) = pack8(a);
        }
    }
}
DI void phase_gdn_combine(const KParams& p) {
    const int tid_ = tid_fresh(); const int wave = tid_ >> 6;
    int p0, np; wave_pair_range(MT / 2, blockIdx.x * NWAVES + wave, gridDim.x * NWAVES, p0, np);
    gdn_combine_run(p, p0, np);
}

DI int gdn_row(int b, int dir, int ci, int i) {
    if (ci < 4) { int s = 64 * ci + i; if (dir) s = 255 - s; return ML + b * 256 + s; }
    int t = 64 * (ci - 4) + i; if (dir) t = 4095 - t; return b * 4096 + t;
}
DI float wave_incl_scan(float x, int lane) {
#pragma unroll
    for (int off = 1; off < 64; off <<= 1) { const float v = __shfl_up(x, off); if (lane >= off) x += v; }
    return x;
}


constexpr int tinv_segidx(int i, int sg) { return ((i <= 33) ? i : 33 + 2 * (i - 33)) + sg; }
constexpr int tinv_nseg(int i) { return (i > 32) ? 2 : 1; }
template <int I>
DI void tinv_step(float (&acc)[64], const float* Mt) {
    if constexpr (I < 63) {
        typedef float f32x2p __attribute__((ext_vector_type(2)));
        const float ti = acc[I];
        const f32x2p nt2 = {-ti, -ti};
#pragma unroll
        for (int jq = (I + 1) / 4; jq < 16; ++jq) {
            const f32x4 mv = *(const f32x4*)(Mt + I * 64 + 4 * jq);
            const int r0 = 4 * jq;
            if (r0 > I) {
                f32x2p a01 = {acc[r0], acc[r0 + 1]}, a23 = {acc[r0 + 2], acc[r0 + 3]};
                a01 = __builtin_elementwise_fma((f32x2p){mv.x, mv.y}, nt2, a01);
                a23 = __builtin_elementwise_fma((f32x2p){mv.z, mv.w}, nt2, a23);
                acc[r0] = a01.x; acc[r0 + 1] = a01.y; acc[r0 + 2] = a23.x; acc[r0 + 3] = a23.y;
            } else {
                if (r0 + 1 > I) acc[r0 + 1] -= mv.y * ti;
                if (r0 + 2 > I) acc[r0 + 2] -= mv.z * ti;
                if (r0 + 3 > I) acc[r0 + 3] -= mv.w * ti;
            }
        }
        tinv_step<I + 1>(acc, Mt);
    }
}

template <int I>
DI void tinv32_step(float (&acc)[32], const float* blk) {
    if constexpr (I < 31) {
        typedef float f32x2p __attribute__((ext_vector_type(2)));
        const float ti = acc[I];
        const f32x2p nt2 = {-ti, -ti};
#pragma unroll
        for (int jq = (I + 1) / 4; jq < 8; ++jq) {
            const f32x4 mv = *(const f32x4*)(blk + I * 32 + 4 * jq);
            const int r0 = 4 * jq;
            if (r0 > I) {
                f32x2p a01 = {acc[r0], acc[r0 + 1]}, a23 = {acc[r0 + 2], acc[r0 + 3]};
                a01 = __builtin_elementwise_fma((f32x2p){mv.x, mv.y}, nt2, a01);
                a23 = __builtin_elementwise_fma((f32x2p){mv.z, mv.w}, nt2, a23);
                acc[r0] = a01.x; acc[r0 + 1] = a01.y; acc[r0 + 2] = a23.x; acc[r0 + 3] = a23.y;
            } else {
                if (r0 + 1 > I) acc[r0 + 1] -= mv.y * ti;
                if (r0 + 2 > I) acc[r0 + 2] -= mv.z * ti;
                if (r0 + 3 > I) acc[r0 + 3] -= mv.w * ti;
            }
        }
        tinv32_step<I + 1>(acc, blk);
    }
}

DI void phase_tinv(const KParams& p, unsigned char* lds, bool dry = false) {
    const int tid_ = tid_fresh(); const int lane = tid_ & 63, wave = tid_ >> 6, r32 = lane & 31, hi = lane >> 5;
    const int gw = blockIdx.x * NWAVES + wave, NGW = gridDim.x * NWAVES;
    float* Mw = (float*)(lds + wave * 17408);
    float* gcs = Mw + 4096; float* bts = gcs + 64;
    const bf16* QKVC = (const bf16*)p.out;
    const float* GB = (const float*)(p.ws + WS_GB);
    bf16* TINV = (bf16*)(p.ws + WS_TINV);
    unsigned* lctr = (unsigned*)(lds + NWAVES * 17408);
    if (threadIdx.x == 0) *lctr = 0u;
    __syncthreads();
    const int per_wg = (8704 + (int)gridDim.x - 1) / (int)gridDim.x;
    auto grab = [&]() -> int {
        int li = 0;
        if (lane == 0) li = (int)__hip_atomic_fetch_add(lctr, 1u, __ATOMIC_RELAXED, __HIP_MEMORY_SCOPE_WORKGROUP);
        li = __builtin_amdgcn_readfirstlane(li);
        const int inst = (int)blockIdx.x * per_wg + li;
        return (li < per_wg && inst < 8704) ? inst : -1;
    };
    bf16x8 kfN[2][4]; float giN = 0.f, biN = 0.f;
    auto issue = [&](int inst) __attribute__((always_inline)) {
        const int ci = inst % 68, bhd = inst / 68, dir = bhd & 1, h = (bhd >> 1) & 7, b = bhd >> 4;
        const int mi = gdn_row(b, dir, ci, lane);
        giN = GB[(size_t)mi * 32 + dir * 8 + h]; biN = GB[(size_t)mi * 32 + 16 + dir * 8 + h];
#pragma unroll
        for (int a = 0; a < 2; ++a) {
            const int mt = gdn_row(b, dir, ci, 32 * a + r32);
#pragma unroll
            for (int s = 0; s < 4; ++s) kfN[a][s] = *(const bf16x8*)(QKVC + (size_t)mt * 1536 + 512 + h * 64 + 16 * s + 8 * hi);
        }
    };
    int inst = grab();
    if (inst >= 0) issue(inst);
    while (inst >= 0) {
        const int ci = inst % 68, bhd = inst / 68, dir = bhd & 1, h = (bhd >> 1) & 7, b = bhd >> 4;
        const int mi = gdn_row(b, dir, ci, lane);
        const float gi = giN, bi = biN;
        const float gc = wave_incl_scan(gi, lane);
        gcs[lane] = gc; bts[lane] = bi;
        if (!dry) ((float*)(p.ws + WS_GB))[(size_t)mi * 32 + dir * 8 + h] = gc;
        bf16x8 kf[2][4];
#pragma unroll
        for (int a = 0; a < 2; ++a)
#pragma unroll
            for (int s = 0; s < 4; ++s) kf[a][s] = kfN[a][s];
        f32x16 g00, g10, g11;
#pragma unroll
        for (int r = 0; r < 16; ++r) { g00[r] = 0.f; g10[r] = 0.f; g11[r] = 0.f; }
#pragma unroll
        for (int s = 0; s < 4; ++s) {
            g00 = __builtin_amdgcn_mfma_f32_32x32x16_bf16(kf[0][s], kf[0][s], g00, 0, 0, 0);
            g10 = __builtin_amdgcn_mfma_f32_32x32x16_bf16(kf[0][s], kf[1][s], g10, 0, 0, 0);
            g11 = __builtin_amdgcn_mfma_f32_32x32x16_bf16(kf[1][s], kf[1][s], g11, 0, 0, 0);
        }
        const int inst_next = grab();
        if (inst_next >= 0) issue(inst_next);
        asm volatile("s_waitcnt lgkmcnt(0)" ::: "memory");
        float* blk11 = Mw; float* blk22 = Mw + 1024;
        unsigned char* m21img = (unsigned char*)(Mw + 2048);
        unsigned char* t11img = m21img + 2560;
        {
            const int i0 = r32, i1 = 32 + r32;
            const float b0 = bts[i0], b1 = bts[i1], gc0 = gcs[i0], gc1 = gcs[i1];
#pragma unroll
            for (int r = 0; r < 16; ++r) {
                const int j0 = crow(r, hi), j1 = 32 + j0;
                blk11[j0 * 32 + r32] = (i0 > j0) ? b0 * g00[r] * __expf(gc0 - gcs[j0]) : 0.f;
                blk22[j0 * 32 + r32] = (i1 > j1) ? b1 * g11[r] * __expf(gc1 - gcs[j1]) : 0.f;
                *(bf16*)(m21img + r32 * 80 + j0 * 2) = f2bf(b1 * g10[r] * __expf(gc1 - gcs[j0]));
            }
        }
        asm volatile("s_waitcnt lgkmcnt(0)" ::: "memory");
        float T[32];
#pragma unroll
        for (int r = 0; r < 32; ++r) T[r] = (r32 == r) ? 1.f : 0.f;
        tinv32_step<0>(T, hi ? blk22 : blk11);
        if (hi == 0) {
#pragma unroll
            for (int q = 0; q < 4; ++q) *(u32x4*)(t11img + r32 * 80 + q * 16) = pack8(&T[8 * q]);
        }
        asm volatile("s_waitcnt lgkmcnt(0)" ::: "memory");
        f32x16 X;
#pragma unroll
        for (int r = 0; r < 16; ++r) X[r] = 0.f;
#pragma unroll
        for (int s = 0; s < 2; ++s) {
            const bf16x8 af = *(const bf16x8*)(m21img + r32 * 80 + (16 * s + 8 * hi) * 2);
            const bf16x8 bfr = *(const bf16x8*)(t11img + r32 * 80 + (16 * s + 8 * hi) * 2);
            X = __builtin_amdgcn_mfma_f32_32x32x16_bf16(af, bfr, X, 0, 0, 0);
        }
        bf16* Tb = (bf16*)Mw;
#pragma unroll
        for (int r = 0; r < 32; ++r) Tb[(32 * hi + r) * 64 + 32 * hi + r32] = f2bf(T[r]);
        {
            const u32x4 z4 = {0u, 0u, 0u, 0u};
#pragma unroll
            for (int q = 0; q < 2; ++q) { const int idx = q * 64 + lane; *(u32x4*)(Tb + (idx >> 2) * 64 + 32 + (idx & 3) * 8) = z4; }
        }
        asm volatile("s_waitcnt lgkmcnt(0)" ::: "memory");
        f32x16 Y;
#pragma unroll
        for (int r = 0; r < 16; ++r) Y[r] = 0.f;
#pragma unroll
        for (int s = 0; s < 2; ++s) {
            const bf16* trow = Tb + (32 + r32) * 64 + 32 + 16 * s + 4 * hi;
            const u32x2 a_lo = *(const u32x2*)(trow), a_hi = *(const u32x2*)(trow + 8);
            const u32x4 aw = {a_lo.x, a_lo.y, a_hi.x, a_hi.y};
            const u32x4 bw = {pk2(X[8 * s + 0], X[8 * s + 1]), pk2(X[8 * s + 2], X[8 * s + 3]), pk2(X[8 * s + 4], X[8 * s + 5]), pk2(X[8 * s + 6], X[8 * s + 7])};
            Y = __builtin_amdgcn_mfma_f32_32x32x16_bf16(__builtin_bit_cast(bf16x8, aw), __builtin_bit_cast(bf16x8, bw), Y, 0, 0, 0);
        }
#pragma unroll
        for (int r = 0; r < 16; ++r) Tb[(32 + crow(r, hi)) * 64 + r32] = f2bf(-Y[r]);
        asm volatile("s_waitcnt lgkmcnt(0)" ::: "memory");
#pragma unroll
        for (int q = 0; q < 8; ++q) {
            const u32x4 v = *(const u32x4*)(Tb + (q * 64 + lane) * 8);
            if (!dry) *(u32x4*)(TINV + (size_t)inst * 4096 + (q * 64 + lane) * 8) = v; else asm volatile("" :: "v"(v));
        }
        asm volatile("s_waitcnt lgkmcnt(0)" ::: "memory");
        inst = inst_next;
    }
}

constexpr int GP = 144;
constexpr int GIMG = 64 * GP;
constexpr int G_CB = 5 * GIMG;
constexpr int G_QK = 0, G_KDT = GIMG, G_T = 2 * GIMG, G_KBGT = 3 * GIMG, G_VBT = 4 * GIMG;
constexpr int G_Q = 2 * G_CB;
constexpr int G_K = G_Q + GIMG;
constexpr int G_ARR = G_K + GIMG;
static_assert(G_ARR + 2 * 1024 <= LDS_BYTES - 64, "GDN scan LDS map");

#define LDS_BAR() do { asm volatile("s_waitcnt lgkmcnt(0)" ::: "memory"); __builtin_amdgcn_s_barrier(); asm volatile("" ::: "memory"); } while (0)
DI bf16x8 ldsfrag(const unsigned char* base, int row, int colbyte) { return *(const bf16x8*)(base + row * GP + colbyte); }
typedef short gv4i16_t __attribute__((ext_vector_type(4)));
DI bf16x8 trfrag(const unsigned char* img, int k0, int k1, int n0, int l15) {
    const int q = l15 >> 2, pp = l15 & 3;
    const unsigned char* a = img + (k0 + q) * GP + (n0 + 4 * pp) * 2;
    const unsigned char* b2 = img + (k1 + q) * GP + (n0 + 4 * pp) * 2;
    const s16x4 lo = __builtin_bit_cast(s16x4, __builtin_amdgcn_ds_read_tr16_b64_v4i16((__attribute__((address_space(3))) gv4i16_t*)a));
    const s16x4 hi4 = __builtin_bit_cast(s16x4, __builtin_amdgcn_ds_read_tr16_b64_v4i16((__attribute__((address_space(3))) gv4i16_t*)b2));
    const bf16x8 r = {lo[0], lo[1], lo[2], lo[3], hi4[0], hi4[1], hi4[2], hi4[3]};
    return r;
}
DI bf16x8 ldsfrag_perm(const unsigned char* base, int row, int c0) {
    const u32x2 a = *(const u32x2*)(base + row * GP + c0 * 2), b2 = *(const u32x2*)(base + row * GP + (c0 + 16) * 2);
    const u32x4 w = {a.x, a.y, b2.x, b2.y};
    return __builtin_bit_cast(bf16x8, w);
}
typedef float f32x4v __attribute__((ext_vector_type(4)));
DI bf16x8 pack_b(const f32x4v& lo, const f32x4v& hi4) {
    const u32x4 w = {pk2(lo[0], lo[1]), pk2(lo[2], lo[3]), pk2(hi4[0], hi4[1]), pk2(hi4[2], hi4[3])};
    return __builtin_bit_cast(bf16x8, w);
}

#ifdef SCAN_PROBE_A
#define SCAN_REP_A(x) do { asm volatile("" ::: "memory"); x; } while (0)
#else
#define SCAN_REP_A(x) do { } while (0)
#endif
#ifdef SCAN_PROBE_B
#define SCAN_REP_B(x) do { asm volatile("" ::: "memory"); x; } while (0)
#else
#define SCAN_REP_B(x) do { } while (0)
#endif
DI void gdn_scan_unit(const KParams& p, int b, int h, int dir, unsigned char* lds) {
    const int tid = tid_fresh(), lane = tid & 63, wid = tid >> 6, l15 = lane & 15, lq = lane >> 4;
    const bf16* QKVC = (const bf16*)p.out;
    const float* GB = (const float*)(p.ws + WS_GB);
    const bf16* TINV = (const bf16*)(p.ws + WS_TINV);
    const size_t inst0 = (size_t)((b * 8 + h) * 2 + dir) * 68;
    __syncthreads();
    if (wid >= 4) {
        const int ptid = tid - 256, pw = wid - 4;
        struct PF { u32x4 rq[2], rk[2], rv[2], rt[2]; float rg, rb; };
        PF RA, RB;
        auto prefetch = [&](int ci, PF& R) __attribute__((always_inline)) {
#pragma unroll
            for (int e = 0; e < 2; ++e) {
                const int pi = ptid + 256 * e, sj = pi >> 3, sp = pi & 7;
                const int mj = gdn_row(b, dir, ci, sj);
                const bf16* src = QKVC + (size_t)mj * 1536 + h * 64 + 8 * sp;
                R.rq[e] = *(const u32x4*)(src); R.rk[e] = *(const u32x4*)(src + 512); R.rv[e] = *(const u32x4*)(src + 1024);
                R.rt[e] = *(const u32x4*)(TINV + (inst0 + ci) * 4096 + sj * 64 + 8 * sp);
            }
            const int mi = gdn_row(b, dir, ci, lane);
            R.rg = GB[(size_t)mi * 32 + dir * 8 + h]; R.rb = GB[(size_t)mi * 32 + 16 + dir * 8 + h];
        };
        auto stage = [&](int ci, const PF& R) __attribute__((always_inline)) {
            unsigned char* cb = lds + (ci & 1) * G_CB;
            float* gcA = (float*)(lds + G_ARR + (ci & 1) * 1024); float* btA = gcA + 64; float* egA = btA + 64;
            const float gsc = R.rg;
            const float gcl = __shfl(gsc, 63);
#pragma unroll
            for (int e = 0; e < 2; ++e) {
                const int pi = ptid + 256 * e, sj = pi >> 3, sp = pi & 7;
                const float gcj = __shfl(gsc, sj), btj = __shfl(R.rb, sj);
                *(u32x4*)(lds + G_Q + sj * GP + sp * 16) = R.rq[e];
                *(u32x4*)(lds + G_K + sj * GP + sp * 16) = R.rk[e];
                *(u32x4*)(cb + G_T + sj * GP + sp * 16) = R.rt[e];
                float kf8[8], vf8[8], kb8[8], kd8[8]; unpack8(R.rk[e], kf8); unpack8(R.rv[e], vf8);
                const float ekb = btj * __expf(gcj), ekd = __expf(gcl - gcj);
#pragma unroll
                for (int x = 0; x < 8; ++x) { kb8[x] = -(kf8[x] * ekb); kd8[x] = kf8[x] * ekd; vf8[x] *= btj; }
                *(u32x4*)(cb + G_KBGT + sj * GP + sp * 16) = pack8(kb8);
                *(u32x4*)(cb + G_KDT + sj * GP + sp * 16) = pack8(kd8);
                *(u32x4*)(cb + G_VBT + sj * GP + sp * 16) = pack8(vf8);
            }
            if (pw == 0) { gcA[lane] = gsc; btA[lane] = R.rb; egA[lane] = __expf(gsc); }
        };
        auto mma_step = [&](int ci) {
            unsigned char* cb = lds + (ci & 1) * G_CB;
            const float* gcA = (const float*)(lds + G_ARR + (ci & 1) * 1024);
            const int mt = pw;
            const bf16x8 qb0 = ldsfrag(lds + G_Q, 16 * mt + l15, 16 * lq), qb1 = ldsfrag(lds + G_Q, 16 * mt + l15, 64 + 16 * lq);
            const int icol = 16 * mt + l15;
            const float gci = gcA[icol];
#pragma unroll
            for (int nt = 0; nt < 4; ++nt) {
                f32x4v acc = {0.f, 0.f, 0.f, 0.f};
                if (nt <= mt) {
                    const bf16x8 a0 = ldsfrag(lds + G_K, 16 * nt + l15, 16 * lq), a1 = ldsfrag(lds + G_K, 16 * nt + l15, 64 + 16 * lq);
                    acc = __builtin_amdgcn_mfma_f32_16x16x32_bf16(a0, qb0, acc, 0, 0, 0);
                    acc = __builtin_amdgcn_mfma_f32_16x16x32_bf16(a1, qb1, acc, 0, 0, 0);
                }
                float v[4];
#pragma unroll
                for (int r = 0; r < 4; ++r) { const int j = 16 * nt + 4 * lq + r; v[r] = (icol >= j) ? acc[r] * __expf(gci - gcA[j]) : 0.f; }
                u32x2 w; w.x = pk2(v[0], v[1]); w.y = pk2(v[2], v[3]);
                *(u32x2*)(cb + G_QK + icol * GP + (16 * nt + 4 * lq) * 2) = w;
            }
        };
        prefetch(0, RA); prefetch(1, RB);
        stage(0, RA);
        prefetch(2, RA);
        LDS_BAR();
        mma_step(0);
        LDS_BAR();
        for (int k = 0; k < 68; k += 2) {
            stage(k + 1, RB); SCAN_REP_A(stage(k + 1, RB)); if (k + 3 < 68) prefetch(k + 3, RB);
            LDS_BAR();
            mma_step(k + 1); SCAN_REP_B(mma_step(k + 1));
            LDS_BAR();
            if (k + 2 < 68) { stage(k + 2, RA); SCAN_REP_A(stage(k + 2, RA)); if (k + 4 < 68) prefetch(k + 4, RA); }
            LDS_BAR();
            if (k + 2 < 68) { mma_step(k + 2); SCAN_REP_B(mma_step(k + 2)); }
            LDS_BAR();
        }
    } else {
        f32x4v sacc[4];
#pragma unroll
        for (int mt = 0; mt < 4; ++mt) sacc[mt] = (f32x4v){0.f, 0.f, 0.f, 0.f};
        const int rstep = dir ? -1 : 1;
        bf16x8 qfr[4][2];
        auto load_q = [&]() {
#pragma unroll
            for (int mt = 0; mt < 4; ++mt)
#pragma unroll
                for (int ks = 0; ks < 2; ++ks) qfr[mt][ks] = ldsfrag_perm(lds + G_Q, 16 * mt + l15, 32 * ks + 4 * lq);
        };
        LDS_BAR();
        LDS_BAR();
        load_q();
        for (int k = 0; k < 68; ++k) {
            const unsigned char* cb = lds + (k & 1) * G_CB;
            const float* gcA = (const float*)(lds + G_ARR + (k & 1) * 1024); const float* egA = gcA + 128;
            const float gl = __expf(gcA[63]);
            const bf16x8 sb0 = pack_b(sacc[0], sacc[1]), sb1 = pack_b(sacc[2], sacc[3]);
            f32x4v rr[4], vn[4];
#pragma unroll
            for (int mt = 0; mt < 4; ++mt) {
                const int q = l15 >> 2, pp = l15 & 3;
                const s16x4 vw = __builtin_bit_cast(s16x4, __builtin_amdgcn_ds_read_tr16_b64_v4i16((__attribute__((address_space(3))) gv4i16_t*)(cb + G_VBT + (16 * mt + 4 * lq + q) * GP + (16 * wid + 4 * pp) * 2)));
                f32x4v acc = {bf2f((bf16)vw[0]), bf2f((bf16)vw[1]), bf2f((bf16)vw[2]), bf2f((bf16)vw[3])};
                acc = __builtin_amdgcn_mfma_f32_16x16x32_bf16(ldsfrag_perm(cb + G_KBGT, 16 * mt + l15, 4 * lq), sb0, acc, 0, 0, 0);
                acc = __builtin_amdgcn_mfma_f32_16x16x32_bf16(ldsfrag_perm(cb + G_KBGT, 16 * mt + l15, 32 + 4 * lq), sb1, acc, 0, 0, 0);
                rr[mt] = acc;
            }
            const bf16x8 rb0 = pack_b(rr[0], rr[1]), rb1 = pack_b(rr[2], rr[3]);
#pragma unroll
            for (int mt = 0; mt < 4; ++mt) {
                f32x4v acc = {0.f, 0.f, 0.f, 0.f};
                acc = __builtin_amdgcn_mfma_f32_16x16x32_bf16(ldsfrag_perm(cb + G_T, 16 * mt + l15, 4 * lq), rb0, acc, 0, 0, 0);
                acc = __builtin_amdgcn_mfma_f32_16x16x32_bf16(ldsfrag_perm(cb + G_T, 16 * mt + l15, 32 + 4 * lq), rb1, acc, 0, 0, 0);
                vn[mt] = acc;
            }
            const bf16x8 vb0 = pack_b(vn[0], vn[1]), vb1 = pack_b(vn[2], vn[3]);
#pragma unroll
            for (int mt = 0; mt < 4; ++mt) {
                f32x4v sn = sacc[mt] * gl;
                sn = __builtin_amdgcn_mfma_f32_16x16x32_bf16(trfrag(cb + G_KDT, 4 * lq, 16 + 4 * lq, 16 * mt, l15), vb0, sn, 0, 0, 0);
                sn = __builtin_amdgcn_mfma_f32_16x16x32_bf16(trfrag(cb + G_KDT, 32 + 4 * lq, 48 + 4 * lq, 16 * mt, l15), vb1, sn, 0, 0, 0);
                sacc[mt] = sn;
            }
            f32x4v oo[4];
#pragma unroll
            for (int mt = 0; mt < 4; ++mt) {
                f32x4v o = {0.f, 0.f, 0.f, 0.f};
                o = __builtin_amdgcn_mfma_f32_16x16x32_bf16(qfr[mt][0], sb0, o, 0, 0, 0);
                o = __builtin_amdgcn_mfma_f32_16x16x32_bf16(qfr[mt][1], sb1, o, 0, 0, 0);
#pragma unroll
                for (int r = 0; r < 4; ++r) o[r] *= egA[16 * mt + 4 * lq + r];
                o = __builtin_amdgcn_mfma_f32_16x16x32_bf16(ldsfrag_perm(cb + G_QK, 16 * mt + l15, 4 * lq), vb0, o, 0, 0, 0);
                o = __builtin_amdgcn_mfma_f32_16x16x32_bf16(ldsfrag_perm(cb + G_QK, 16 * mt + l15, 32 + 4 * lq), vb1, o, 0, 0, 0);
                oo[mt] = o;
            }
            LDS_BAR();
            if (k + 1 < 68) load_q();
            {
                const int m0 = gdn_row(b, dir, k, 0);
                bf16* ob; long pitch;
                if (dir == 0) { ob = (bf16*)(p.ws + WS_U) + (long)m0 * 1024; pitch = 1024; }
                else if (m0 < OB_SPLIT) { ob = (bf16*)((unsigned char*)p.out + OUT_OBLO) + (long)m0 * 512; pitch = 512; }
                else { ob = (bf16*)(p.ws + WS_OBHI) + (long)(m0 - OB_SPLIT) * 512; pitch = 512; }
                bf16* op = ob + (long)rstep * (4 * lq) * pitch + h * 64 + 16 * wid + l15;
                const long rsp = (long)rstep * pitch;
#pragma unroll
                for (int mt = 0; mt < 4; ++mt)
#pragma unroll
                    for (int r = 0; r < 4; ++r) op[rsp * (16 * mt + r)] = f2bf(oo[mt][r]);
#ifdef SCAN_PROBE_D
                asm volatile("" ::: "memory");
#pragma unroll
                for (int mt = 0; mt < 4; ++mt)
#pragma unroll
                    for (int r = 0; r < 4; ++r) op[rsp * (16 * mt + r)] = f2bf(oo[mt][r]);
#endif
            }
            LDS_BAR();
        }
    }
}


template <int MODE> struct AttnCfg { static constexpr int DQK = (MODE <= 1) ? 96 : 64; };
typedef short v4i16_t __attribute__((ext_vector_type(4)));
DI s16x4 lds_tr16(const unsigned char* p) { return __builtin_bit_cast(s16x4, __builtin_amdgcn_ds_read_tr16_b64_v4i16((__attribute__((address_space(3))) v4i16_t*)p)); }
DI float fmax3(float a, float b, float c) { return __builtin_fmaxf(__builtin_fmaxf(a, b), c); }
#ifndef ATT_THR_VAL
#define ATT_THR_VAL 8.f
#endif
constexpr float ATT_THR = ATT_THR_VAL;

template <int MODE>
DI void attn_unit(const KParams& p, int b, int h, int qb, unsigned char* lds) {
    constexpr int DQK = AttnCfg<MODE>::DQK, NS = DQK / 16;
    constexpr int KP = DQK * 2 + 16;
    constexpr int VP = 64 * 2 + 16;
    constexpr int KBUF = 64 * KP, VBUF = 64 * VP, BUF = KBUF + VBUF;
    constexpr int KCH = DQK / 8;
    const int tid = tid_fresh(), lane = tid & 63, wid = tid >> 6, r32 = lane & 31, hi = lane >> 5;
    float* rpbL = (float*)(lds + 3 * BUF);

    int mq;
    int qr = 0, qc = 0;
    if (MODE == 0 || MODE == 2) mq = b * 4096 + qb * 256 + wid * 32 + r32;
    else if (MODE == 1) mq = ML + b * 256 + wid * 32 + r32;
    else { qr = 4 * qb + (wid >> 1); qc = 32 * (wid & 1) + r32; mq = b * 4096 + qr * 64 + qc; }
    const bf16* Qp; float sl2;
    if (MODE <= 1) { Qp = (const bf16*)(p.ws + WS_QMLA) + (size_t)mq * 768 + h * 96; sl2 = 0.10206207261596577f * LOG2E; }
    else if (MODE == 2) { Qp = (const bf16*)(p.ws + WS_Z) + (size_t)mq * NZ1 + Z1_GQ + h * 64; sl2 = 0.125f * LOG2E; }
    else { Qp = (const bf16*)(p.ws + WS_Z) + (size_t)mq * NZ1 + Z1_NAQ + h * 64; sl2 = 0.125f * LOG2E; }
    u32x4 qraw[NS];
#pragma unroll
    for (int s = 0; s < NS; ++s) qraw[s] = *(const u32x4*)(Qp + 16 * s + 8 * hi);
    bf16x8 qf[NS];
    int NT, kr_lo = 0;
    if (MODE == 0 || MODE == 2) NT = 68; else if (MODE == 1) NT = 4;
    else { kr_lo = 4 * qb - 4; if (kr_lo < 0) kr_lo = 0; int last = 4 * qb - 1; if (last < 0) last = 0; if (last > 56) last = 56; NT = 4 + (last + 7 - kr_lo + 1); }
    int rs = 0, cs0 = 0;
    if (MODE == 3) {
        rs = qr - 4; if (rs < 0) rs = 0; if (rs > 56) rs = 56;
        cs0 = qc - 8; if (cs0 < 0) cs0 = 0; if (cs0 > 48) cs0 = 48;
        for (int i = tid; i < 15 * 31; i += NTHREADS) rpbL[i] = p.in[25][h * 465 + i] * LOG2E;
    }
    unsigned cmask = 0u; const float* rpbB = rpbL;
    if (MODE == 3) {
#pragma unroll
        for (int r = 0; r < 16; ++r) {
            const int kc0 = crow(r, hi), kc1 = 32 + kc0;
            if (kc0 >= cs0 && kc0 <= cs0 + 15) cmask |= 1u << r;
            if (kc1 >= cs0 && kc1 <= cs0 + 15) cmask |= 1u << (16 + r);
        }
        rpbB = rpbL + (4 * hi - qc + 15);
    }
    const int kkey0 = tid / KCH, kpart0 = tid % KCH;
    const int kkey1 = (tid + 512) / KCH, kpart1 = (tid + 512) % KCH;
    const bool k1act = (KCH == 12) && (tid + 512 < 64 * KCH);
    const int vkey = tid >> 3, vpart = tid & 7;
    auto keyrow = [&](int t, int i) -> int {
        if (t < 4) return ML + b * 256 + 64 * t + i;
        if (MODE == 3) return b * 4096 + (kr_lo + t - 4) * 64 + i;
        return b * 4096 + 64 * (t - 4) + i;
    };
    auto kchunk = [&](int row, int part) -> u32x4 {
        if (MODE <= 1) {
            if (part < 8) return *(const u32x4*)((const bf16*)(p.ws + WS_KVMLA) + (size_t)row * 1024 + h * 128 + 8 * part);
            return *(const u32x4*)((const bf16*)(p.ws + WS_KPE) + (size_t)row * 32 + 8 * (part - 8));
        } else if (MODE == 2) return *(const u32x4*)((const bf16*)(p.ws + WS_GKV) + (size_t)row * 256 + (h >> 2) * 64 + 8 * part);
        else return *(const u32x4*)((const bf16*)(p.ws + WS_Z) + (size_t)row * NZ1 + Z1_NAK + h * 64 + 8 * part);
    };
    auto vchunk = [&](int row, int part) -> u32x4 {
        if (MODE <= 1) return *(const u32x4*)((const bf16*)(p.ws + WS_KVMLA) + (size_t)row * 1024 + h * 128 + 64 + 8 * part);
        else if (MODE == 2) return *(const u32x4*)((const bf16*)(p.ws + WS_GKV) + (size_t)row * 256 + 128 + (h >> 2) * 64 + 8 * part);
        else return *(const u32x4*)((const bf16*)(p.ws + WS_Z) + (size_t)row * NZ1 + Z1_NAV + h * 64 + 8 * part);
    };
    u32x4 rk0, rk1 = {0u, 0u, 0u, 0u}, rv;
    auto load_tile = [&](int t) {
        rk0 = kchunk(keyrow(t, kkey0), kpart0);
        if (k1act) rk1 = kchunk(keyrow(t, kkey1), kpart1);
        rv = vchunk(keyrow(t, vkey), vpart);
    };
    auto write_tile = [&](int buf) {
        unsigned char* kb = lds + buf * BUF; unsigned char* vb = kb + KBUF;
        *(u32x4*)(kb + kkey0 * KP + kpart0 * 16) = rk0;
        if (k1act) *(u32x4*)(kb + kkey1 * KP + kpart1 * 16) = rk1;
        *(u32x4*)(vb + vkey * VP + vpart * 16) = rv;
    };
    const int vtr_base = (4 * hi + ((lane & 15) >> 2)) * VP + (16 * ((lane >> 4) & 1) + 4 * (lane & 3)) * 2;
    f32x16 o0, o1, ol, negm;
#pragma unroll
    for (int r = 0; r < 16; ++r) { o0[r] = 0.f; o1[r] = 0.f; ol[r] = 0.f; negm[r] = 0.f; }
    asm volatile("" : "+v"(negm));
    const bf16x8 ones = {(short)0x3F80, (short)0x3F80, (short)0x3F80, (short)0x3F80, (short)0x3F80, (short)0x3F80, (short)0x3F80, (short)0x3F80};
    float m_run = 0.f;
    auto tile_active = [&](int t) -> bool { if (MODE != 3 || t < 4) return true; const int kr = kr_lo + t - 4; return (kr >= rs) && (kr <= rs + 7); };
    auto qk_tile = [&](int slot, f32x16& s0, f32x16& s1) __attribute__((always_inline)) {
        const unsigned char* kb = lds + slot * BUF;
#pragma unroll
        for (int s = 0; s < NS; ++s) {
            const bf16x8 k0 = *(const bf16x8*)(kb + r32 * KP + (16 * s + 8 * hi) * 2);
            const bf16x8 k1 = *(const bf16x8*)(kb + (32 + r32) * KP + (16 * s + 8 * hi) * 2);
            s0 = __builtin_amdgcn_mfma_f32_32x32x16_bf16(k0, qf[s], s == 0 ? negm : s0, 0, 0, 0);
            s1 = __builtin_amdgcn_mfma_f32_32x32x16_bf16(k1, qf[s], s == 0 ? negm : s1, 0, 0, 0);
        }
    };
    int slot = 0;
    auto step = [&](const bool first, int t, f32x16& c0, f32x16& c1, f32x16& n0, f32x16& n1) __attribute__((always_inline)) {
        const int slot1 = (slot == 2) ? 0 : slot + 1, slot2 = (slot1 == 2) ? 0 : slot1 + 1;
        if (t + 2 < NT) load_tile(t + 2);
        const bool act_n = (t + 1 < NT) && tile_active(t + 1);
        if (act_n) qk_tile(slot1, n0, n1);
        if (tile_active(t)) {
            const unsigned char* vb = lds + slot * BUF + KBUF;
            if (MODE == 3 && t >= 4) {
                const int kr = kr_lo + t - 4;
                const float* bp = rpbB + (kr - qr + 7) * 31;
#pragma unroll
                for (int r = 0; r < 16; ++r) {
                    const float b0 = bp[(r & 3) + 8 * (r >> 2)], b1 = bp[32 + (r & 3) + 8 * (r >> 2)];
                    c0[r] = ((cmask >> r) & 1u) ? c0[r] + b0 : -INFINITY;
                    c1[r] = ((cmask >> (16 + r)) & 1u) ? c1[r] + b1 : -INFINITY;
                }
            }
            float mloc;
            {
                float a = fmax3(c0[0], c0[1], c1[0]), c2 = fmax3(c0[2], c0[3], c1[1]);
                a = fmax3(a, c1[2], c1[3]);
#pragma unroll
                for (int r = 4; r < 16; r += 4) { a = fmax3(a, c0[r], c0[r + 1]); c2 = fmax3(c2, c0[r + 2], c0[r + 3]); a = fmax3(a, c1[r], c1[r + 1]); c2 = fmax3(c2, c1[r + 2], c1[r + 3]); }
                mloc = __builtin_fmaxf(a, c2);
                auto rr = __builtin_amdgcn_permlane32_swap(__float_as_uint(mloc), __float_as_uint(mloc), false, false);
                mloc = __builtin_fmaxf(__uint_as_float(rr[0]), __uint_as_float(rr[1]));
            }
            if (first || __builtin_expect(__any(mloc > ATT_THR), 0)) {
                float dl = first ? mloc : __builtin_fmaxf(mloc, 0.f);
                asm volatile("" : "+v"(dl));
                m_run += dl;
#pragma unroll
                for (int r = 0; r < 16; ++r) { c0[r] -= dl; c1[r] -= dl; negm[r] = -m_run; }
                asm volatile("" : "+v"(negm));
                if (act_n) {
#pragma unroll
                    for (int r = 0; r < 16; ++r) { n0[r] -= dl; n1[r] -= dl; }
                }
                if (!first) {
                    const float alpha = __builtin_amdgcn_exp2f(-dl);
#pragma unroll
                    for (int r = 0; r < 16; ++r) { o0[r] *= alpha; o1[r] *= alpha; ol[r] *= alpha; }
                }
            }
#pragma unroll
            for (int r = 0; r < 16; ++r) { c0[r] = __builtin_amdgcn_exp2f(c0[r]); c1[r] = __builtin_amdgcn_exp2f(c1[r]); }
#pragma unroll
            for (int kt = 0; kt < 2; ++kt)
#pragma unroll
                for (int s = 0; s < 2; ++s) {
                    const f32x16& pp = kt ? c1 : c0;
                    u32x4 pw;
                    pw.x = pk2(pp[8 * s + 0], pp[8 * s + 1]); pw.y = pk2(pp[8 * s + 2], pp[8 * s + 3]);
                    pw.z = pk2(pp[8 * s + 4], pp[8 * s + 5]); pw.w = pk2(pp[8 * s + 6], pp[8 * s + 7]);
                    const bf16x8 pf = __builtin_bit_cast(bf16x8, pw);
                    const unsigned char* vp = vb + vtr_base + (32 * kt + 16 * s) * VP;
                    const s16x4 a0 = lds_tr16(vp), a1 = lds_tr16(vp + 8 * VP);
                    const s16x4 e0 = lds_tr16(vp + 64), e1 = lds_tr16(vp + 8 * VP + 64);
                    const bf16x8 va = {a0[0], a0[1], a0[2], a0[3], a1[0], a1[1], a1[2], a1[3]};
                    const bf16x8 vc = {e0[0], e0[1], e0[2], e0[3], e1[0], e1[1], e1[2], e1[3]};
                    o0 = __builtin_amdgcn_mfma_f32_32x32x16_bf16(va, pf, o0, 0, 0, 0);
                    o1 = __builtin_amdgcn_mfma_f32_32x32x16_bf16(vc, pf, o1, 0, 0, 0);
                    ol = __builtin_amdgcn_mfma_f32_32x32x16_bf16(ones, pf, ol, 0, 0, 0);
                }
        }
#ifdef ATT_SGB
#pragma unroll
        for (int i = 0; i < 2 * NS + 12; ++i) {
            __builtin_amdgcn_sched_group_barrier(0x8, 1, 0);
            __builtin_amdgcn_sched_group_barrier(0x100, 1, 0);
            __builtin_amdgcn_sched_group_barrier(0x2, ATT_SGB, 0);
        }
#endif
        if (t + 2 < NT) write_tile(slot2);
        slot = slot1;
        __syncthreads();
    };

    load_tile(0);
    const u32x4 t0a = rk0, t0b = rk1, t0c = rv;
    load_tile(1);
    const u32x4 t1a = rk0, t1b = rk1, t1c = rv;
    {
        float qx[NS][8];
#pragma unroll
        for (int s = 0; s < NS; ++s) unpack8(qraw[s], qx[s]);
        if (MODE == 0) {
            const int t = mq & 4095; const float2* rt = (const float2*)(p.ws + WS_ROPE8) + (hi ? (t & 63) : (t >> 6)) * 8;
#pragma unroll
            for (int e = 0; e < 8; ++e) { const float2 v = rt[e]; const float cs = v.x, sn = v.y; const float a = qx[4][e], c2 = qx[5][e]; qx[4][e] = a * cs - c2 * sn; qx[5][e] = c2 * cs + a * sn; }
        }
        if (MODE == 2) {
            float ss = 0.f;
#pragma unroll
            for (int s = 0; s < NS; ++s)
#pragma unroll
                for (int e = 0; e < 8; ++e) ss += qx[s][e] * qx[s][e];
            ss += __shfl_xor(ss, 32);
            const float r = rsqrtf(ss * (1.f / 64.f) + EPS);
            const float* qn = p.in[26];
#pragma unroll
            for (int s = 0; s < NS; ++s)
#pragma unroll
                for (int e = 0; e < 8; ++e) qx[s][e] *= r * qn[16 * s + 8 * hi + e];
            const int t = mq & 4095;
#pragma unroll
            for (int s = 0; s < 2; ++s) {
                const float2* rt = (const float2*)(p.ws + WS_ROPE16) + (s ? (t & 63) : (t >> 6)) * 16 + 8 * hi;
#pragma unroll
                for (int e = 0; e < 8; ++e) { const float2 v = rt[e]; const float a1 = qx[s][e], a2 = qx[s + 2][e]; qx[s][e] = a1 * v.x - a2 * v.y; qx[s + 2][e] = a2 * v.x + a1 * v.y; }
            }
        }
#pragma unroll
        for (int s = 0; s < NS; ++s) {
#pragma unroll
            for (int e = 0; e < 8; ++e) qx[s][e] *= sl2;
            qf[s] = __builtin_bit_cast(bf16x8, pack8(qx[s]));
        }
    }
    __syncthreads();
    rk0 = t0a; rk1 = t0b; rv = t0c; write_tile(0);
    rk0 = t1a; rk1 = t1b; rv = t1c; write_tile(1);
    __syncthreads();
    f32x16 sA0, sA1, sB0, sB1;
    qk_tile(0, sA0, sA1);
    step(true, 0, sA0, sA1, sB0, sB1);
    int t = 1;
    for (; t + 1 < NT; t += 2) {
        step(false, t, sB0, sB1, sA0, sA1);
        step(false, t + 1, sA0, sA1, sB0, sB1);
    }
    if (t < NT) step(false, t, sB0, sB1, sA0, sA1);
    const float l_run = ol[0];
    const float il = 1.f / l_run;
    bf16* Ob;
    {
        const int mq0 = mq - r32;
        if (MODE == 3) Ob = (bf16*)(p.ws + WS_U) + (size_t)mq0 * DM + h * 64;
        else Ob = (bf16*)(p.ws + WS_U) + (size_t)mq0 * DM + 512 + h * 64;
    }
    unsigned char* stg = lds + 3 * BUF + 2048 + wid * (32 * 144);
#pragma unroll
    for (int g = 0; g < 4; ++g) {
        u32x2 w0, w1;
        w0.x = pk2(o0[4 * g] * il, o0[4 * g + 1] * il); w0.y = pk2(o0[4 * g + 2] * il, o0[4 * g + 3] * il);
        w1.x = pk2(o1[4 * g] * il, o1[4 * g + 1] * il); w1.y = pk2(o1[4 * g + 2] * il, o1[4 * g + 3] * il);
        *(u32x2*)(stg + r32 * 144 + (8 * g + 4 * hi) * 2) = w0;
        *(u32x2*)(stg + r32 * 144 + (32 + 8 * g + 4 * hi) * 2) = w1;
    }
    asm volatile("s_waitcnt lgkmcnt(0)" ::: "memory");
#pragma unroll
    for (int i = 0; i < 4; ++i) {
        const int row = 8 * i + (lane >> 3), ch = lane & 7;
        const u32x4 v = *(const u32x4*)(stg + row * 144 + ch * 16);
        *(u32x4*)(Ob + (size_t)row * DM + ch * 8) = v;
    }
}

template <int MODE> DI void attn_unit3(const KParams& p, int b, int h, int qb, unsigned char* lds);
#ifdef ATT_PIPE3
#define ATTN_FN attn_unit3
#else
#define ATTN_FN attn_unit
#endif
DI void phase_scan_attn0(const KParams& p, unsigned char* lds) {
    unsigned* ctl2 = (unsigned*)(p.ws + WS_CTL2);
    for (int su = blockIdx.x; su < 128; su += gridDim.x) {
        gdn_scan_unit(p, su >> 4, (su >> 1) & 7, su & 1, lds);
#ifndef COMBINE_PHASE
        asm volatile("s_waitcnt vmcnt(0)" ::: "memory"); __syncthreads();
        if (threadIdx.x == 0) { __builtin_amdgcn_fence(__ATOMIC_RELEASE, "agent"); asm volatile("s_waitcnt vmcnt(0)" ::: "memory"); (void)xb_add(ctl2, 1u); }
#endif
    }
    unsigned* qbase = (unsigned*)(p.ws + WS_QCTR);
    volatile int* nxt = (volatile int*)(lds + LDS_BYTES - 128);
    const int x0 = (int)(xb_xcc_id() & 7u);
    int tries = 0;
    for (;;) {
        __syncthreads();
        if (threadIdx.x == 0) {
            int t = tries, li = 0;
            for (; t < 8; ++t) {
                li = (int)__hip_atomic_fetch_add(qbase + 64 * ((x0 + t) & 7), 1u, __ATOMIC_RELAXED, __HIP_MEMORY_SCOPE_AGENT);
                if (li < 136) break;
            }
            nxt[0] = t; nxt[1] = li;
        }
        __syncthreads();
        tries = nxt[0];
        if (tries >= 8) break;
        const int li = nxt[1], x = (x0 + tries) & 7;
        if (li < 128) { const int bh = (li >> 4) * 8 + x, j = li & 15; ATTN_FN<0>(p, bh >> 3, bh & 7, j, lds); }
        else { const int bh = (li - 128) * 8 + x; ATTN_FN<1>(p, bh >> 3, bh & 7, 0, lds); }
    }
#ifndef COMBINE_PHASE
    __syncthreads();
    if (threadIdx.x == 0) {
        unsigned* bar = (unsigned*)(p.ws + WS_CTL);
        XB_SPIN(xb_ld(ctl2) < 128u, bar);
        __builtin_amdgcn_fence(__ATOMIC_ACQUIRE, "agent"); asm volatile("s_waitcnt vmcnt(0)" ::: "memory");
    }
    for (;;) {
        __syncthreads();
        if (threadIdx.x == 0) nxt[0] = (int)__hip_atomic_fetch_add(ctl2 + 64, 1u, __ATOMIC_RELAXED, __HIP_MEMORY_SCOPE_AGENT);
        __syncthreads();
        const int it = nxt[0];
        if (it >= MT / 128) break;
        gdn_combine_run(p, it * 64 + (int)(tid_fresh() >> 6) * 8, 8);
    }
#endif
}
template <int MODE>
DI void attn_unit3(const KParams& p, int b, int h, int qb, unsigned char* lds) {
    static_assert(MODE <= 2, "attn_unit3: MLA / GQA only");
    constexpr int DQK = AttnCfg<MODE>::DQK, NS = DQK / 16;
    constexpr int KP = DQK * 2 + 16, VP = 64 * 2 + 16, KBUF = 64 * KP, VBUF = 64 * VP, BUF = KBUF + VBUF, KCH = DQK / 8;
    const int tid = tid_fresh(), lane = tid & 63, wid = tid >> 6, r32 = lane & 31, hi = lane >> 5;
    int mq;
    if (MODE == 0 || MODE == 2) mq = b * 4096 + qb * 256 + wid * 32 + r32; else mq = ML + b * 256 + wid * 32 + r32;
    const bf16* Qp; float sl2;
    if (MODE <= 1) { Qp = (const bf16*)(p.ws + WS_QMLA) + (size_t)mq * 768 + h * 96; sl2 = 0.10206207261596577f * LOG2E; }
    else { Qp = (const bf16*)(p.ws + WS_Z) + (size_t)mq * NZ1 + Z1_GQ + h * 64; sl2 = 0.125f * LOG2E; }
    u32x4 qraw[NS];
#pragma unroll
    for (int s = 0; s < NS; ++s) qraw[s] = *(const u32x4*)(Qp + 16 * s + 8 * hi);
    bf16x8 qf[NS];
    const int NT = (MODE == 1) ? 4 : 68;
    const int kkey0 = tid / KCH, kpart0 = tid % KCH;
    const int kkey1 = (tid + 512) / KCH, kpart1 = (tid + 512) % KCH;
    const bool k1act = (KCH == 12) && (tid + 512 < 64 * KCH);
    const int vkey = tid >> 3, vpart = tid & 7;
    auto keyrow = [&](int t, int i) -> int { return t < 4 ? ML + b * 256 + 64 * t + i : b * 4096 + 64 * (t - 4) + i; };
    auto kchunk = [&](int row, int part) -> u32x4 {
        if (MODE <= 1) {
            if (part < 8) return *(const u32x4*)((const bf16*)(p.ws + WS_KVMLA) + (size_t)row * 1024 + h * 128 + 8 * part);
            return *(const u32x4*)((const bf16*)(p.ws + WS_KPE) + (size_t)row * 32 + 8 * (part - 8));
        } else return *(const u32x4*)((const bf16*)(p.ws + WS_GKV) + (size_t)row * 256 + (h >> 2) * 64 + 8 * part);
    };
    auto vchunk = [&](int row, int part) -> u32x4 {
        if (MODE <= 1) return *(const u32x4*)((const bf16*)(p.ws + WS_KVMLA) + (size_t)row * 1024 + h * 128 + 64 + 8 * part);
        else return *(const u32x4*)((const bf16*)(p.ws + WS_GKV) + (size_t)row * 256 + 128 + (h >> 2) * 64 + 8 * part);
    };
    u32x4 rk0, rk1 = {0u, 0u, 0u, 0u}, rv;
    auto load_tile = [&](int t) { rk0 = kchunk(keyrow(t, kkey0), kpart0); if (k1act) rk1 = kchunk(keyrow(t, kkey1), kpart1); rv = vchunk(keyrow(t, vkey), vpart); };
    auto write_tile = [&](int sl) {
        unsigned char* kb = lds + sl * BUF; unsigned char* vb = kb + KBUF;
        *(u32x4*)(kb + kkey0 * KP + kpart0 * 16) = rk0;
        if (k1act) *(u32x4*)(kb + kkey1 * KP + kpart1 * 16) = rk1;
        *(u32x4*)(vb + vkey * VP + vpart * 16) = rv;
    };
    const int vtr_base = (4 * hi + ((lane & 15) >> 2)) * VP + (16 * ((lane >> 4) & 1) + 4 * (lane & 3)) * 2;
    f32x16 o0, o1, ol, negm;
    {
        float zf = 0.f; asm volatile("" : "+v"(zf));
#pragma unroll
        for (int r = 0; r < 16; ++r) { o0[r] = zf; o1[r] = zf; ol[r] = zf; negm[r] = zf; }
    }
    asm volatile("" : "+v"(negm));
    const bf16x8 ones = {(short)0x3F80, (short)0x3F80, (short)0x3F80, (short)0x3F80, (short)0x3F80, (short)0x3F80, (short)0x3F80, (short)0x3F80};
    float m_run = 0.f;
    auto qk_tile = [&](int sl, f32x16& s0, f32x16& s1) __attribute__((always_inline)) {
        const unsigned char* kb = lds + sl * BUF;
#pragma unroll
        for (int s = 0; s < NS; ++s) {
            const bf16x8 k0 = *(const bf16x8*)(kb + r32 * KP + (16 * s + 8 * hi) * 2);
            const bf16x8 k1 = *(const bf16x8*)(kb + (32 + r32) * KP + (16 * s + 8 * hi) * 2);
            s0 = __builtin_amdgcn_mfma_f32_32x32x16_bf16(k0, qf[s], s == 0 ? negm : s0, 0, 0, 0);
            s1 = __builtin_amdgcn_mfma_f32_32x32x16_bf16(k1, qf[s], s == 0 ? negm : s1, 0, 0, 0);
        }
    };
    auto pv_tile = [&](int sl, const bf16x8 (&pk)[4]) __attribute__((always_inline)) {
        const unsigned char* vb = lds + sl * BUF + KBUF + vtr_base;
#pragma unroll
        for (int c = 0; c < 4; ++c) {
            const unsigned char* vp = vb + (16 * c) * VP;
            const s16x4 a0 = lds_tr16(vp), a1 = lds_tr16(vp + 8 * VP), e0 = lds_tr16(vp + 64), e1 = lds_tr16(vp + 8 * VP + 64);
            const bf16x8 va = {a0[0], a0[1], a0[2], a0[3], a1[0], a1[1], a1[2], a1[3]};
            const bf16x8 vc = {e0[0], e0[1], e0[2], e0[3], e1[0], e1[1], e1[2], e1[3]};
            o0 = __builtin_amdgcn_mfma_f32_32x32x16_bf16(va, pk[c], o0, 0, 0, 0);
            o1 = __builtin_amdgcn_mfma_f32_32x32x16_bf16(vc, pk[c], o1, 0, 0, 0);
            ol = __builtin_amdgcn_mfma_f32_32x32x16_bf16(ones, pk[c], ol, 0, 0, 0);
        }
    };
    auto step = [&](const bool first, int t, f32x16& c0, f32x16& c1, f32x16& n0, f32x16& n1, const bf16x8 (&pprev)[4], bf16x8 (&pcur)[4]) __attribute__((always_inline)) {
        if (t + 2 < NT) load_tile(t + 2);
        const bool has_n = t + 1 < NT;
        if (has_n) qk_tile((t + 1) & 3, n0, n1);
        if (!first) pv_tile((t - 1) & 3, pprev);
        float mloc;
        {
            float a = fmax3(c0[0], c0[1], c1[0]), c2 = fmax3(c0[2], c0[3], c1[1]);
            a = fmax3(a, c1[2], c1[3]);
#pragma unroll
            for (int r = 4; r < 16; r += 4) { a = fmax3(a, c0[r], c0[r + 1]); c2 = fmax3(c2, c0[r + 2], c0[r + 3]); a = fmax3(a, c1[r], c1[r + 1]); c2 = fmax3(c2, c1[r + 2], c1[r + 3]); }
            mloc = __builtin_fmaxf(a, c2);
            auto rr = __builtin_amdgcn_permlane32_swap(__float_as_uint(mloc), __float_as_uint(mloc), false, false);
            mloc = __builtin_fmaxf(__uint_as_float(rr[0]), __uint_as_float(rr[1]));
        }
        if (first || __builtin_expect(__any(mloc > ATT_THR), 0)) {
            float dl = first ? mloc : __builtin_fmaxf(mloc, 0.f);
            asm volatile("" : "+v"(dl));
            m_run += dl;
#pragma unroll
            for (int r = 0; r < 16; ++r) { c0[r] -= dl; c1[r] -= dl; negm[r] = -m_run; }
            asm volatile("" : "+v"(negm));
            if (has_n) {
#pragma unroll
                for (int r = 0; r < 16; ++r) { n0[r] -= dl; n1[r] -= dl; }
            }
            if (!first) {
                const float alpha = __builtin_amdgcn_exp2f(-dl);
#pragma unroll
                for (int r = 0; r < 16; ++r) { o0[r] *= alpha; o1[r] *= alpha; ol[r] *= alpha; }
            }
        }
#pragma unroll
        for (int r = 0; r < 16; ++r) { c0[r] = __builtin_amdgcn_exp2f(c0[r]); c1[r] = __builtin_amdgcn_exp2f(c1[r]); }
#pragma unroll
        for (int kt = 0; kt < 2; ++kt)
#pragma unroll
            for (int s = 0; s < 2; ++s) {
                const f32x16& pp = kt ? c1 : c0;
                u32x4 pw;
                pw.x = pk2(pp[8 * s + 0], pp[8 * s + 1]); pw.y = pk2(pp[8 * s + 2], pp[8 * s + 3]);
                pw.z = pk2(pp[8 * s + 4], pp[8 * s + 5]); pw.w = pk2(pp[8 * s + 6], pp[8 * s + 7]);
                pcur[2 * kt + s] = __builtin_bit_cast(bf16x8, pw);
            }
        if (t + 2 < NT) write_tile((t + 2) & 3);
        __syncthreads();
    };
    u32x4 t0a = {0u, 0u, 0u, 0u}, t0b = t0a, t0c = t0a, t1a = t0a, t1b = t0a, t1c = t0a;
    if (MODE != 2) { load_tile(0); t0a = rk0; t0b = rk1; t0c = rv; load_tile(1); t1a = rk0; t1b = rk1; t1c = rv; }
    {
        float qx[NS][8];
#pragma unroll
        for (int s = 0; s < NS; ++s) unpack8(qraw[s], qx[s]);
        if (MODE == 0) {
            const int t = mq & 4095; const float2* rt = (const float2*)(p.ws + WS_ROPE8) + (hi ? (t & 63) : (t >> 6)) * 8;
#pragma unroll
            for (int e = 0; e < 8; ++e) { const float2 v = rt[e]; const float cs = v.x, sn = v.y; const float a1 = qx[4][e], c2 = qx[5][e]; qx[4][e] = a1 * cs - c2 * sn; qx[5][e] = c2 * cs + a1 * sn; }
        }
        if (MODE == 2) {
            float ss = 0.f;
#pragma unroll
            for (int s = 0; s < NS; ++s)
#pragma unroll
                for (int e = 0; e < 8; ++e) ss += qx[s][e] * qx[s][e];
            ss += __shfl_xor(ss, 32);
            const float r = rsqrtf(ss * (1.f / 64.f) + EPS);
            const float* qn = p.in[26];
#pragma unroll
            for (int s = 0; s < NS; ++s)
#pragma unroll
                for (int e = 0; e < 8; ++e) qx[s][e] *= r * qn[16 * s + 8 * hi + e];
            const int t = mq & 4095;
#pragma unroll
            for (int s = 0; s < 2; ++s) {
                const float2* rt = (const float2*)(p.ws + WS_ROPE16) + (s ? (t & 63) : (t >> 6)) * 16 + 8 * hi;
#pragma unroll
                for (int e = 0; e < 8; ++e) { const float2 v = rt[e]; const float a1 = qx[s][e], a2 = qx[s + 2][e]; qx[s][e] = a1 * v.x - a2 * v.y; qx[s + 2][e] = a2 * v.x + a1 * v.y; }
            }
        }
#pragma unroll
        for (int s = 0; s < NS; ++s) {
#pragma unroll
            for (int e = 0; e < 8; ++e) qx[s][e] *= sl2;
            qf[s] = __builtin_bit_cast(bf16x8, pack8(qx[s]));
        }
    }
    if (MODE == 2) { load_tile(0); t0a = rk0; t0b = rk1; t0c = rv; load_tile(1); t1a = rk0; t1b = rk1; t1c = rv; }
    __syncthreads();
    rk0 = t0a; rk1 = t0b; rv = t0c; write_tile(0);
    rk0 = t1a; rk1 = t1b; rv = t1c; write_tile(1);
    __syncthreads();
    f32x16 sA0, sA1, sB0, sB1;
    bf16x8 pA[4], pB[4];
    qk_tile(0, sA0, sA1);
    step(true, 0, sA0, sA1, sB0, sB1, pB, pA);
    int t = 1;
    for (; t + 1 < NT; t += 2) {
        step(false, t, sB0, sB1, sA0, sA1, pA, pB);
        step(false, t + 1, sA0, sA1, sB0, sB1, pB, pA);
    }
    if (t < NT) { step(false, t, sB0, sB1, sA0, sA1, pA, pB); pv_tile((NT - 1) & 3, pB); }
    else pv_tile((NT - 1) & 3, pA);
    const float il = 1.f / ol[0];
    bf16* Ob = (bf16*)(p.ws + WS_U) + (size_t)(mq - r32) * DM + 512 + h * 64;
    unsigned char* stg = lds + 4 * BUF + wid * (32 * 144);
#pragma unroll
    for (int g = 0; g < 4; ++g) {
        u32x2 w0, w1;
        w0.x = pk2(o0[4 * g] * il, o0[4 * g + 1] * il); w0.y = pk2(o0[4 * g + 2] * il, o0[4 * g + 3] * il);
        w1.x = pk2(o1[4 * g] * il, o1[4 * g + 1] * il); w1.y = pk2(o1[4 * g + 2] * il, o1[4 * g + 3] * il);
        *(u32x2*)(stg + r32 * 144 + (8 * g + 4 * hi) * 2) = w0;
        *(u32x2*)(stg + r32 * 144 + (32 + 8 * g + 4 * hi) * 2) = w1;
    }
    asm volatile("s_waitcnt lgkmcnt(0)" ::: "memory");
#pragma unroll
    for (int i = 0; i < 4; ++i) {
        const int row = 8 * i + (lane >> 3), ch = lane & 7;
        const u32x4 v = *(const u32x4*)(stg + row * 144 + ch * 16);
        *(u32x4*)(Ob + (size_t)row * DM + ch * 8) = v;
    }
    __syncthreads();
}

DI void na_unit(const KParams& p, int b, int h, int qb, unsigned char* lds) {
    constexpr int KP = 144, VP = 144, KBUF = 64 * KP, BUF = 2 * KBUF;
    const int tid = tid_fresh(), lane = tid & 63, wid = tid >> 6, r32 = lane & 31, hi = lane >> 5;
    float* rpbL = (float*)(lds + 2 * BUF + 256);
    const int ra = 4 * qb + 2 * (wid >> 2), c0 = 16 * (wid & 3);
    const int qrow = ra + (r32 >> 4), qcol = c0 + (r32 & 15);
    const int mq = b * 4096 + qrow * 64 + qcol;
    const bf16* Z = (const bf16*)(p.ws + WS_Z);
    bf16x8 qf[4];
    {
        const bf16* Qp = Z + (size_t)mq * NZ1 + Z1_NAQ + h * 64;
#pragma unroll
        for (int s = 0; s < 4; ++s) {
            float qx[8]; unpack8(*(const u32x4*)(Qp + 16 * s + 8 * hi), qx);
#pragma unroll
            for (int e = 0; e < 8; ++e) qx[e] *= 0.125f * LOG2E;
            qf[s] = __builtin_bit_cast(bf16x8, pack8(qx));
        }
    }
    int rs_l = qrow - 4; rs_l = rs_l < 0 ? 0 : (rs_l > 56 ? 56 : rs_l);
    int cs_l = qcol - 8; cs_l = cs_l < 0 ? 0 : (cs_l > 48 ? 48 : cs_l);
    int start = c0 - 8; start = start < 0 ? 0 : start; start = start > 32 ? 32 : start;
    int wlo = ra - 4; wlo = wlo < 0 ? 0 : (wlo > 56 ? 56 : wlo);
    int whi = ra + 1 - 4; whi = whi < 0 ? 0 : (whi > 56 ? 56 : whi); whi += 7;
    int kr_lo = 4 * qb - 4; if (kr_lo < 0) kr_lo = 0;
    int last = 4 * qb - 1; if (last < 0) last = 0; if (last > 56) last = 56;
    const int NT = 4 + (last + 7 - kr_lo + 1);
    unsigned cmask = 0u;
#pragma unroll
    for (int r = 0; r < 16; ++r) { const int kc = start + crow(r, hi); if (kc >= cs_l && kc <= cs_l + 15) cmask |= 1u << r; }
    const float* rpbB = rpbL + (start + 4 * hi - qcol + 15);
    for (int i = tid; i < 15 * 31; i += NTHREADS) rpbL[i] = p.in[25][h * 465 + i] * LOG2E;
    const int skey = tid >> 3, spart = tid & 7;
    auto keyrow = [&](int t) -> int { return t < 4 ? ML + b * 256 + 64 * t + skey : b * 4096 + (kr_lo + t - 4) * 64 + skey; };
    u32x4 rk, rv;
    auto load_tile = [&](int t) { const bf16* src = Z + (size_t)keyrow(t) * NZ1 + h * 64 + 8 * spart; rk = *(const u32x4*)(src + Z1_NAK); rv = *(const u32x4*)(src + Z1_NAV); };
    auto write_tile = [&](int buf) { *(u32x4*)(lds + buf * BUF + skey * KP + spart * 16) = rk; *(u32x4*)(lds + buf * BUF + KBUF + skey * VP + spart * 16) = rv; };
    const int vtr_base = (4 * hi + ((lane & 15) >> 2)) * VP + (16 * ((lane >> 4) & 1) + 4 * (lane & 3)) * 2;
    f32x16 o0, o1, ol, negm;
#pragma unroll
    for (int r = 0; r < 16; ++r) { o0[r] = 0.f; o1[r] = 0.f; ol[r] = 0.f; negm[r] = 0.f; }
    asm volatile("" : "+v"(negm));
    const bf16x8 ones = {(short)0x3F80, (short)0x3F80, (short)0x3F80, (short)0x3F80, (short)0x3F80, (short)0x3F80, (short)0x3F80, (short)0x3F80};
    float m_run = 0.f;
    auto span = [&](const unsigned char* kb, const unsigned char* vb, int koff, bool first, bool local, int kr) __attribute__((always_inline)) {
        f32x16 sc;
#pragma unroll
        for (int s = 0; s < 4; ++s) {
            const bf16x8 kf = *(const bf16x8*)(kb + (koff + r32) * KP + (16 * s + 8 * hi) * 2);
            sc = __builtin_amdgcn_mfma_f32_32x32x16_bf16(kf, qf[s], s == 0 ? negm : sc, 0, 0, 0);
        }
        if (local) {
            const bool rowok = (kr >= rs_l) && (kr <= rs_l + 7);
            const float* bp = rpbB + (kr - qrow + 7) * 31;
#pragma unroll
            for (int r = 0; r < 16; ++r) { const float bv = bp[(r & 3) + 8 * (r >> 2)]; sc[r] = (rowok && ((cmask >> r) & 1u)) ? sc[r] + bv : -INFINITY; }
        }
        float mloc;
        {
            float a = fmax3(sc[0], sc[1], sc[2]), c2 = fmax3(sc[3], sc[4], sc[5]);
            a = fmax3(a, sc[6], sc[7]); c2 = fmax3(c2, sc[8], sc[9]); a = fmax3(a, sc[10], sc[11]); c2 = fmax3(c2, sc[12], sc[13]); a = fmax3(a, sc[14], sc[15]);
            mloc = __builtin_fmaxf(a, c2);
            auto rr = __builtin_amdgcn_permlane32_swap(__float_as_uint(mloc), __float_as_uint(mloc), false, false);
            mloc = __builtin_fmaxf(__uint_as_float(rr[0]), __uint_as_float(rr[1]));
        }
        if (first || __builtin_expect(__any(mloc > ATT_THR), 0)) {
            float dl = first ? mloc : __builtin_fmaxf(mloc, 0.f);
            asm volatile("" : "+v"(dl));
            m_run += dl;
#pragma unroll
            for (int r = 0; r < 16; ++r) { sc[r] -= dl; negm[r] = -m_run; }
            asm volatile("" : "+v"(negm));
            if (!first) {
                const float alpha = __builtin_amdgcn_exp2f(-dl);
#pragma unroll
                for (int r = 0; r < 16; ++r) { o0[r] *= alpha; o1[r] *= alpha; ol[r] *= alpha; }
            }
        }
#pragma unroll
        for (int r = 0; r < 16; ++r) sc[r] = __builtin_amdgcn_exp2f(sc[r]);
#pragma unroll
        for (int s = 0; s < 2; ++s) {
            u32x4 pw;
            pw.x = pk2(sc[8 * s + 0], sc[8 * s + 1]); pw.y = pk2(sc[8 * s + 2], sc[8 * s + 3]);
            pw.z = pk2(sc[8 * s + 4], sc[8 * s + 5]); pw.w = pk2(sc[8 * s + 6], sc[8 * s + 7]);
            const bf16x8 pf = __builtin_bit_cast(bf16x8, pw);
            const unsigned char* vp = vb + vtr_base + (koff + 16 * s) * VP;
            const s16x4 a0 = lds_tr16(vp), a1 = lds_tr16(vp + 8 * VP), e0 = lds_tr16(vp + 64), e1 = lds_tr16(vp + 8 * VP + 64);
            const bf16x8 va = {a0[0], a0[1], a0[2], a0[3], a1[0], a1[1], a1[2], a1[3]};
            const bf16x8 vc = {e0[0], e0[1], e0[2], e0[3], e1[0], e1[1], e1[2], e1[3]};
            o0 = __builtin_amdgcn_mfma_f32_32x32x16_bf16(va, pf, o0, 0, 0, 0);
            o1 = __builtin_amdgcn_mfma_f32_32x32x16_bf16(vc, pf, o1, 0, 0, 0);
            ol = __builtin_amdgcn_mfma_f32_32x32x16_bf16(ones, pf, ol, 0, 0, 0);
        }
    };
    __syncthreads();
    load_tile(0); write_tile(0);
    __syncthreads();
    for (int t = 0; t < NT; ++t) {
        const int buf = t & 1;
        if (t + 1 < NT) load_tile(t + 1);
        const unsigned char* kb = lds + buf * BUF; const unsigned char* vb = kb + KBUF;
        if (t < 4) { span(kb, vb, 0, t == 0, false, 0); span(kb, vb, 32, false, false, 0); }
        else { const int kr = kr_lo + t - 4; if (kr >= wlo && kr <= whi) span(kb, vb, start, false, true, kr); }
        if (t + 1 < NT) write_tile(buf ^ 1);
        __syncthreads();
    }
    const float il = 1.f / ol[0];
    unsigned char* stg = lds + 2 * BUF + 4096 + wid * (32 * 144);
#pragma unroll
    for (int g = 0; g < 4; ++g) {
        u32x2 w0, w1;
        w0.x = pk2(o0[4 * g] * il, o0[4 * g + 1] * il); w0.y = pk2(o0[4 * g + 2] * il, o0[4 * g + 3] * il);
        w1.x = pk2(o1[4 * g] * il, o1[4 * g + 1] * il); w1.y = pk2(o1[4 * g + 2] * il, o1[4 * g + 3] * il);
        *(u32x2*)(stg + r32 * 144 + (8 * g + 4 * hi) * 2) = w0;
        *(u32x2*)(stg + r32 * 144 + (32 + 8 * g + 4 * hi) * 2) = w1;
    }
    asm volatile("s_waitcnt lgkmcnt(0)" ::: "memory");
#pragma unroll
    for (int i = 0; i < 4; ++i) {
        const int row = 8 * i + (lane >> 3), ch = lane & 7;
        const u32x4 v = *(const u32x4*)(stg + row * 144 + ch * 16);
        const int mrow = b * 4096 + (ra + (row >> 4)) * 64 + c0 + (row & 15);
        *(u32x4*)((bf16*)(p.ws + WS_U) + (size_t)mrow * DM + h * 64 + ch * 8) = v;
    }
}

DI void phase_attn1(const KParams& p, unsigned char* lds) {
    const int G = gridDim.x; const int vcu = (G % 8 == 0) ? (blockIdx.x % 8) * (G / 8) + blockIdx.x / 8 : blockIdx.x;
#ifndef NO_GQA
    for (int u = vcu; u < 1024; u += G) { const int bh = u >> 4, j = u & 15; ATTN_FN<2>(p, bh >> 3, bh & 7, j, lds); }
#endif
#if defined(NO_NA)
#elif defined(NA_OLD)
    for (int u = vcu; u < 1024; u += G) { const int bh = u >> 4, j = u & 15; attn_unit<3>(p, bh >> 3, bh & 7, j, lds); }
#else
    for (int u = vcu; u < 1024; u += G) { const int bh = u >> 4, j = u & 15; na_unit(p, bh >> 3, bh & 7, j, lds); }
#endif
#ifdef NA_PROBE
    for (int u = vcu; u < 1024; u += G) { const int bh = u >> 4, j = u & 15; na_unit(p, bh >> 3, bh & 7, j, lds); }
#endif
}

#ifndef PHMASK
#define PHMASK 0xffffffffu
#endif
typedef const __attribute__((address_space(4))) KParams* KArgPtr;
DI KParams load_params(KArgPtr kp) {
    KParams p;
#pragma unroll
    for (int i = 0; i < 28; ++i) p.in[i] = kp->in[i];
    p.out = kp->out; p.ws = kp->ws; return p;
}
__global__ void __launch_bounds__(NTHREADS, 2) fwd_megakernel(KParams p_unused) {
    extern __shared__ __attribute__((aligned(16))) unsigned char lds[];
    cg::grid_group grid = cg::this_grid();
    KArgPtr kp0 = (KArgPtr)__builtin_amdgcn_kernarg_segment_ptr();
    volatile LAS unsigned* bst = (volatile LAS unsigned*)((LAS unsigned char*)lds + (LDS_BYTES - 64));
    if (threadIdx.x == 0) { bst[0] = 0u; bst[1] = 0u; }
    __syncthreads();
    const XcdBarrier bar = xcd_barrier_post((unsigned*)(kp0->ws + WS_CTL), bst);
#ifdef USE_CG_SYNC
#define SYNC() grid.sync()
#else
#define SYNC() xcd_barrier(bar)
#endif
    constexpr int NSUB = 32;
#define PH1(n, ...) { KArgPtr kp = kp0; asm volatile("" : "+s"(kp)); const KParams p = load_params(kp); unsigned char* ws = p.ws; \
        bf16* U = (bf16*)(ws + WS_U); bf16* Zb = (bf16*)(ws + WS_Z); bf16* Yb = (bf16*)(ws + WS_Y); (void)U; (void)Zb; (void)Yb; __VA_ARGS__; }
#ifndef PHREP
#define PHREP 0u
#endif
#define PH(n, ...) if ((PHMASK >> (n)) & 1u) { PH1(n, __VA_ARGS__) if ((PHREP >> (n)) & 1u) { SYNC(); PH1(n, __VA_ARGS__) } }

    PH(0, phase_prologue(p, lds))
    if (__builtin_expect(gridDim.x > 65535u, 0)) grid.sync();
    SYNC();
    PH(1, phase_modnorm0(p))
    SYNC();
#ifdef ALL_W_EARLY
    PH(2, gemm_store(lds, U, (const bf16*)(ws + WS_WIN0), MT, NZ0, DM, Zb, NZ0))
#else
    PH(2, { gemm_store(lds, U, (const bf16*)(ws + WS_WIN0), MT, NZ0, DM, Zb, NZ0); tail_weight_transposes<TD_LATE>(p, lds, (MT / 256) * (NZ0 / 256)); })
#endif
    SYNC();
    PH(3, phase_prep0(p))
    SYNC();
    PH(4, gemm_store(lds, (const bf16*)(ws + WS_QN), (const bf16*)(ws + WS_WQUP), MT, 768, 256, (bf16*)(ws + WS_QMLA), 768))
    PH(5, gemm_store_rot(lds, (const bf16*)(ws + WS_KVN), (const bf16*)(ws + WS_WKVUP), MT, 1024, 128, (bf16*)(ws + WS_KVMLA), 1024, (MT / 256) * 3))
    { asm volatile("s_waitcnt vmcnt(0) lgkmcnt(0)" ::: "memory"); __syncthreads(); }
    PH(7, phase_tinv(p, lds))
    SYNC();
#ifdef TINV_PROBE
    PH(7, phase_tinv(p, lds, true))
    SYNC();
#endif
    PH(6, phase_scan_attn0(p, lds))
    SYNC();
#ifdef COMBINE_PHASE
    PH(9, phase_gdn_combine(p))
    SYNC();
#endif
    PH(10, gemm_store(lds, U, (const bf16*)(ws + WS_WOUT0), ML, DM, DM, Yb, DM))
    SYNC();
    PH(11, { if (blockIdx.x < NSUB) { gemm_store_sub(lds, U + (size_t)ML * DM, (const bf16*)(ws + WS_WOUT0), MC, DM, DM, Yb + (size_t)ML * DM, DM, 0, NSUB);
                                      sub_barrier((unsigned*)(ws + WS_SUBCNT), NSUB);
                                      phase_post(p, ML, MT, Yb, 1, 0, 2, p.in[7], p.in[8], 0, 3, U, 0, NSUB); }
             else phase_post(p, 0, ML, Yb, 1, 0, 2, p.in[7], p.in[8], 0, 3, U, NSUB, (int)gridDim.x - NSUB); })
    SYNC();
#ifdef ALL_W_EARLY
    PH(12, gemm_swiglu(lds, U, (const bf16*)(ws + WS_WGU0), MT, Zb))
#else
    PH(12, gemm_swiglu(lds, U, (const bf16*)(ws + WS_WGU0), MT, Zb))
#endif
    SYNC();
    PH(13, gemm_store(lds, Zb, (const bf16*)(ws + WS_WDN0), ML, DM, DFF, Yb, DM))
    SYNC();
    PH(14, { if (blockIdx.x < NSUB) { gemm_store_sub(lds, Zb + (size_t)ML * DFF, (const bf16*)(ws + WS_WDN0), MC, DM, DFF, Yb + (size_t)ML * DM, DM, 0, NSUB);
                                      sub_barrier((unsigned*)(ws + WS_SUBCNT) + 64, NSUB);
                                      phase_post(p, ML, MT, Yb, 0, 0, 5, p.in[9], p.in[6] + 1024, 1, 0, U, 0, NSUB); }
             else phase_post(p, 0, ML, Yb, 0, 0, 5, p.in[9], p.in[6] + 1024, 1, 0, U, NSUB, (int)gridDim.x - NSUB); })
    SYNC();
#ifdef ALL_W_EARLY
    PH(15, gemm_store(lds, U, (const bf16*)(ws + WS_WIN1), MT, NZ1, DM, Zb, NZ1))
#else
    PH(15, gemm_store(lds, U, (const bf16*)(ws + WS_WIN1), MT, NZ1, DM, Zb, NZ1))
#endif
    SYNC();
    PH(16, phase_prep1(p))
    SYNC();
    PH(17, phase_attn1(p, lds))
    SYNC();
    PH(18, gemm_store(lds, U, (const bf16*)(ws + WS_WOUT1), ML, DM, DM, Yb, DM))
    SYNC();
    PH(19, phase_post(p, 0, ML, Yb, 0, 1, 2, p.in[7] + 1024, p.in[8] + 1024, 1, 3, U, 0, (int)gridDim.x))
    SYNC();
    PH(20, gemm_swiglu(lds, U, (const bf16*)(ws + WS_WGU1), ML, Zb))
    SYNC();
    PH(21, gemm_store(lds, Zb, (const bf16*)(ws + WS_WDN1), ML, DM, DFF, Yb, DM))
    SYNC();
    PH(22, phase_post(p, 0, ML, Yb, 0, 1, 5, p.in[9] + 1024, nullptr, 1, 0, nullptr, 0, (int)gridDim.x))
#undef SYNC
#undef PH
#undef PH1
}

extern "C" void kernel_launch(void* const* d_in, const int* in_sizes, int n_in, void* d_out, int out_size,
                              void* d_ws, size_t ws_size, hipStream_t stream) {
    static int grid_blocks = 0;
    if (grid_blocks == 0) {
        int dev = 0, cus = 0, per_cu = 0;
        (void)hipGetDevice(&dev);
        (void)hipDeviceGetAttribute(&cus, hipDeviceAttributeMultiprocessorCount, dev);
        (void)hipFuncSetAttribute((const void*)fwd_megakernel, hipFuncAttributeMaxDynamicSharedMemorySize, LDS_BYTES);
        (void)hipOccupancyMaxActiveBlocksPerMultiprocessor(&per_cu, (const void*)fwd_megakernel, NTHREADS, LDS_BYTES);
        if (per_cu < 1) { fprintf(stderr, "kernel_launch: occupancy query says %d blocks/CU\n", per_cu); per_cu = 1; }
        grid_blocks = cus;
        if (n_in != 28 || ws_size < WS_END) fprintf(stderr, "kernel_launch: unexpected n_in %d / ws_size %zu (need %zu)\n", n_in, ws_size, (size_t)WS_END);
    }
    (void)hipMemsetAsync((unsigned char*)d_ws + WS_CTL, 0, 16384 + 1024, stream);
    KParams p{};
    for (int i = 0; i < 28; ++i) p.in[i] = (const float*)d_in[i];
    p.out = (float*)d_out; p.ws = (unsigned char*)d_ws;
    void* args[] = {&p};
    hipError_t e = hipLaunchCooperativeKernel((void*)fwd_megakernel, dim3(grid_blocks), dim3(NTHREADS), args, LDS_BYTES, stream);
    if (e != hipSuccess) fprintf(stderr, "cooperative launch failed: %s (grid %d)\n", hipGetErrorString(e), grid_blocks);
}
```

```cpp
#include <hip/hip_runtime.h>
#include <hip/hip_cooperative_groups.h>
#include <cstdio>
#include <cstdint>
namespace cg = cooperative_groups;
__device__ __forceinline__ int tid_fresh() { int t = threadIdx.x; asm volatile("" : "+v"(t)); return t; }
namespace pg8 {
#define PG8_LAS __attribute__((address_space(3)))
typedef unsigned short bf16_t;
typedef short bf16x8 __attribute__((ext_vector_type(8)));
typedef float f32x4 __attribute__((ext_vector_type(4)));
typedef unsigned u32x4 __attribute__((ext_vector_type(4)));
constexpr int BM = 256, BK = 64, HALF = 128, HTB = HALF * BK * 2  , STAGE_BYTES = 8 * HTB, NXCD = 8, WGM = 8;

__host__ __device__ __forceinline__ int lds_byte(int r, int c) { const int st = (r >> 4) * 2 + (c >> 5), rr = r & 15, cc = c & 31, ob = rr * 64 + cc * 2; return st * 1024 + (ob ^ (((ob >> 9) & 1) << 5)); }
__host__ __device__ __forceinline__ void stage_rc(int b, int& R, int& C) { const int st = b / 1024, sb = b % 1024, swz = sb ^ (((sb >> 9) & 1) << 5); R = (st >> 1) * 16 + swz / 64; C = (st & 1) * 32 + (swz % 64) / 2; }
__host__ __device__ __forceinline__ int perm32(int rho) { const int n = rho >> 4, i = rho & 15; return 8 * (i >> 2) + 4 * n + (i & 3); }

struct Unit { int pm, pn; };
struct Gemm { const bf16_t* A; const bf16_t* Bt; int M, N, K; int ld = 0; };

struct StaticOrder {
    int nM, nN, nwg, G, c;
    __host__ __device__ void init(int M, int N, int G_, int c_) { nM = M / BM; nN = N / BM; nwg = nM * nN; G = G_; c = c_; }
    __host__ __device__ bool next(int i, Unit& u) const {
        const long L = (long)i * G + c; if (L >= nwg) return false;
        int wgid = (int)L; { const int q = nwg / NXCD, r = nwg % NXCD, xcd = wgid % NXCD, off = wgid / NXCD; wgid = (xcd < r ? xcd * (q + 1) : r * (q + 1) + (xcd - r) * q) + off; }
        const int nig = WGM * nN, gid = wgid / nig, fm = gid * WGM, gsz = (nM - fm) < WGM ? (nM - fm) : WGM;
        u.pm = fm + ((wgid % nig) % gsz); u.pn = (wgid % nig) / gsz; return true;
    }
    __device__ __forceinline__ void a_ready(const Unit&) const {}
    __device__ __forceinline__ void done(const Unit&) const {}
};

__device__ __forceinline__ unsigned cvt_pk_bf16(float lo, float hi) { unsigned r; asm volatile("v_cvt_pk_bf16_f32 %0, %1, %2" : "=v"(r) : "v"(lo), "v"(hi)); return r; }
typedef float f32x2 __attribute__((ext_vector_type(2)));
__device__ __forceinline__ f32x2 gelu_pk(f32x2 v) {
    const f32x2 av = __builtin_elementwise_abs(v), d = av * 0.2316418882f + 1.0f;
    f32x2 t; t.x = __builtin_amdgcn_rcpf(d.x); t.y = __builtin_amdgcn_rcpf(d.y);
    f32x2 q = t * 0.5307027145f + (-0.7265760135f); q = q * t + 0.7107068705f; q = q * t + (-0.142248368f); q = q * t + 0.127414796f; q = q * t;
    const f32x2 s = (v * v) * (-0.72134752044f);
    f32x2 e; e.x = __builtin_amdgcn_exp2f(s.x); e.y = __builtin_amdgcn_exp2f(s.y);
    const f32x2 m = v * (q * e), r = v - m;
    f32x2 o; o.x = v.x < 0.f ? m.x : r.x; o.y = v.y < 0.f ? m.y : r.y; return o;
}

template <int ACT  > struct EpiBf16 {
    static constexpr bool PERM = true, AFTER_DRAIN = false; static_assert(ACT == 0 || ACT == 1, "EpiBf16: ACT is 0 (none) or 1 (gelu_pk)");
    bf16_t* O; int ldc; const float* bias; int split_cols; size_t split_stride; float scale0;
    __device__ __forceinline__ void operator()(const f32x4 (&acc)[2][2][4][2], const Unit& u, int wr, int wc, int fr, int fq) const {
        const int row0 = u.pm * BM + wr * 64 + fr; int colt = u.pn * BM; bf16_t* base = O;
        float sc = 1.f; if (split_cols) { const int t = colt / split_cols; base += (size_t)t * split_stride; colt -= t * split_cols; if (t == 0) sc = scale0; }
        const int col0 = colt + wc * 32 + 8 * fq, bcol0 = u.pn * BM + wc * 32 + 8 * fq;
        f32x4 bv[2][2];
#pragma unroll
        for (int bj = 0; bj < 2; ++bj)
#pragma unroll
            for (int n = 0; n < 2; ++n) bv[bj][n] = bias ? *(const f32x4*)(bias + bcol0 + bj * HALF + 4 * n) : (f32x4){0.f, 0.f, 0.f, 0.f};
#pragma unroll
        for (int ai = 0; ai < 2; ++ai)
#pragma unroll
            for (int m = 0; m < 4; ++m) { bf16_t* rowp = base + (size_t)(row0 + ai * HALF + m * 16) * ldc + col0;
#pragma unroll
                for (int bj = 0; bj < 2; ++bj) { f32x4 v0 = acc[ai][bj][m][0] + bv[bj][0], v1 = acc[ai][bj][m][1] + bv[bj][1];
                    if (ACT == 1) { f32x2 a = gelu_pk((f32x2){v0[0], v0[1]}), b = gelu_pk((f32x2){v0[2], v0[3]}), c = gelu_pk((f32x2){v1[0], v1[1]}), d = gelu_pk((f32x2){v1[2], v1[3]});
                        v0 = (f32x4){a.x, a.y, b.x, b.y}; v1 = (f32x4){c.x, c.y, d.x, d.y}; }
                    v0 = v0 * sc; v1 = v1 * sc; u32x4 w; w.x = cvt_pk_bf16(v0[0], v0[1]); w.y = cvt_pk_bf16(v0[2], v0[3]); w.z = cvt_pk_bf16(v1[0], v1[1]); w.w = cvt_pk_bf16(v1[2], v1[3]);
                    *(u32x4*)(rowp + bj * HALF) = w; } }
    }
};

struct PanelStats {
    unsigned* xbuf;
    unsigned* cnt;
    unsigned* tmo;
    int ntn; float eps;
    unsigned code;
    __device__ __forceinline__ bool run(const f32x4 (&v)[2][2][4][2], const Unit& u, int wr, int wc, int fr, int fq, PG8_LAS unsigned char* lds, int wid, int lane) const {
        typedef float f32x2v __attribute__((ext_vector_type(2)));
        PG8_LAS f32x2v* P = (PG8_LAS f32x2v*)lds;
        PG8_LAS f32x2v* S = (PG8_LAS f32x2v*)(lds + 8192);
        PG8_LAS unsigned* flag = (PG8_LAS unsigned*)(lds + 8192 + 2048);
#pragma unroll
        for (int ai = 0; ai < 2; ++ai)
#pragma unroll
            for (int m = 0; m < 4; ++m) {
                float s = 0.f;
#pragma unroll
                for (int bj = 0; bj < 2; ++bj)
#pragma unroll
                    for (int n = 0; n < 2; ++n) { const f32x4 x = v[ai][bj][m][n]; s += (x[0] + x[1]) + (x[2] + x[3]); }
                s += __shfl_xor(s, 16); s += __shfl_xor(s, 32);
                const float mw = s * (1.0f / 64.0f); float q = 0.f;
#pragma unroll
                for (int bj = 0; bj < 2; ++bj)
#pragma unroll
                    for (int n = 0; n < 2; ++n) { const f32x4 d = v[ai][bj][m][n] - mw; q += (d[0] * d[0] + d[1] * d[1]) + (d[2] * d[2] + d[3] * d[3]); }
                q += __shfl_xor(q, 16); q += __shfl_xor(q, 32);
                if (fq == 0) P[(ai * HALF + wr * 64 + m * 16 + fr) * 4 + wc] = (f32x2v){mw, q};
            }
        asm volatile("s_waitcnt lgkmcnt(0)" ::: "memory"); __builtin_amdgcn_s_barrier(); asm volatile("" ::: "memory");
#if defined(BROKEN_EXCHANGE_NO_WAIT)
#warning BROKEN CONTROL BUILD: the row-statistics exchange does not wait; results are wrong by design
        if (blockIdx.x >= 64) { const long long t0_ = clock64(); while (clock64() - t0_ < 60000) __builtin_amdgcn_s_sleep(8); }
#endif
        const int row = wid * 32 + (lane & 31);
        if (lane < 32) {
            const f32x2v a = P[row * 4 + 0], b = P[row * 4 + 1], c = P[row * 4 + 2], d = P[row * 4 + 3];
            const float mt = (a.x + b.x + c.x + d.x) * 0.25f;
            const float da = a.x - mt, db = b.x - mt, dc = c.x - mt, dd = d.x - mt;
            const float m2 = (a.y + b.y) + (c.y + d.y) + 64.0f * ((da * da + db * db) + (dc * dc + dd * dd));
            unsigned long long* slot = (unsigned long long*)xbuf + ((size_t)(u.pm * BM + row) * 4 + u.pn);
            __hip_atomic_store(slot, ((unsigned long long)__float_as_uint(m2) << 32) | __float_as_uint(mt), __ATOMIC_RELAXED, __HIP_MEMORY_SCOPE_AGENT);
        }
        asm volatile("s_waitcnt vmcnt(0)" ::: "memory");
        if (lane == 0) __hip_atomic_fetch_add(cnt + 64 * u.pm, 1u, __ATOMIC_RELAXED, __HIP_MEMORY_SCOPE_AGENT);
        if (wid == 0) {
            bool dead = false; const unsigned long long t0 = __builtin_amdgcn_s_memrealtime(); const unsigned want = 8u * (unsigned)ntn;
            for (;;) {
#if defined(BROKEN_EXCHANGE_NO_WAIT)
                break;
#endif
                if ((unsigned)__builtin_amdgcn_readfirstlane(__hip_atomic_load(cnt + 64 * u.pm, __ATOMIC_RELAXED, __HIP_MEMORY_SCOPE_AGENT)) >= want) break;
                if (__builtin_amdgcn_s_memrealtime() - t0 > 2000000ull) {
                    if (lane == 0) { unsigned expect = 0u; __hip_atomic_compare_exchange_strong(tmo + 1, &expect, code | (unsigned)(u.pm & 0xff), __ATOMIC_RELAXED, __ATOMIC_RELAXED, __HIP_MEMORY_SCOPE_AGENT);
                                     __hip_atomic_store(tmo, 1u, __ATOMIC_RELAXED, __HIP_MEMORY_SCOPE_AGENT); }
                    dead = true; break; }
                __builtin_amdgcn_s_sleep(2);
            }
            __builtin_amdgcn_fence(__ATOMIC_ACQUIRE, "agent");
            if (lane == 0) flag[0] = dead ? 1u : 0u;
        }
        asm volatile("s_waitcnt vmcnt(0) lgkmcnt(0)" ::: "memory"); __builtin_amdgcn_s_barrier(); asm volatile("" ::: "memory");
        const bool bad = flag[0] != 0u;
        if (lane < 32) {
            const unsigned long long* slot = (const unsigned long long*)xbuf + (size_t)(u.pm * BM + row) * 4; float mt[4], m2[4]; float ms = 0.f;
#pragma unroll
            for (int t = 0; t < 4; ++t) { if (t < ntn) { const unsigned long long w = __hip_atomic_load(slot + t, __ATOMIC_RELAXED, __HIP_MEMORY_SCOPE_AGENT); mt[t] = __uint_as_float((unsigned)w); m2[t] = __uint_as_float((unsigned)(w >> 32)); } else { mt[t] = 0.f; m2[t] = 0.f; } ms += mt[t]; }
            const float mean = ms / (float)ntn; float q = 0.f;
#pragma unroll
            for (int t = 0; t < 4; ++t) if (t < ntn) { const float dm = mt[t] - mean; q += m2[t] + 256.0f * dm * dm; }
            S[row] = (f32x2v){mean, 1.0f / sqrtf(q / (256.0f * (float)ntn) + eps)};
        }
        asm volatile("s_waitcnt lgkmcnt(0)" ::: "memory"); __builtin_amdgcn_s_barrier(); asm volatile("" ::: "memory");
        return bad;
    }
};
struct EpiLnRes {
    static constexpr bool PERM = false, AFTER_DRAIN = true;
    const float* base; float* out; int ldc; const float* bias; PanelStats st; unsigned poison;
    __device__ __forceinline__ void fused(f32x4 (&acc)[2][2][4][2], const Unit& u, int wr, int wc, int fr, int fq, PG8_LAS unsigned char* lds, int wid, int lane) const {
        typedef float f32x2v __attribute__((ext_vector_type(2)));
        const PG8_LAS f32x2v* S = (const PG8_LAS f32x2v*)(lds + 8192);
        const int col0 = u.pn * BM + wc * 32 + 4 * fq;
#pragma unroll
        for (int bj = 0; bj < 2; ++bj)
#pragma unroll
            for (int n = 0; n < 2; ++n) { const f32x4 bv = bias ? *(const f32x4*)(bias + col0 + bj * HALF + n * 16) : (f32x4){0.f, 0.f, 0.f, 0.f};
#pragma unroll
                for (int ai = 0; ai < 2; ++ai)
#pragma unroll
                    for (int m = 0; m < 4; ++m) acc[ai][bj][m][n] += bv; }
        f32x4 pre[4][2][2];
#pragma unroll
        for (int m = 0; m < 4; ++m) { const size_t off = (size_t)(u.pm * BM + wr * 64 + m * 16 + fr) * ldc + col0;
#pragma unroll
            for (int bj = 0; bj < 2; ++bj)
#pragma unroll
                for (int n = 0; n < 2; ++n) pre[m][bj][n] = *(const f32x4*)(base + off + bj * HALF + n * 16); }
        const bool bad = st.run(acc, u, wr, wc, fr, fq, lds, wid, lane) || poison != 0u;
        const float qnan = __builtin_nanf("");
#pragma unroll
        for (int ai = 0; ai < 2; ++ai)
#pragma unroll
            for (int m = 0; m < 4; ++m) { const int r = ai * HALF + wr * 64 + m * 16 + fr; const f32x2v sr = S[r]; const size_t off = (size_t)(u.pm * BM + r) * ldc + col0;
#pragma unroll
                for (int bj = 0; bj < 2; ++bj)
#pragma unroll
                    for (int n = 0; n < 2; ++n) { const f32x4 bs = ai == 0 ? pre[m][bj][n] : *(const f32x4*)(base + off + bj * HALF + n * 16); f32x4 o = bs + (acc[ai][bj][m][n] - sr.x) * sr.y;
                        if (bad) o = (f32x4){qnan, qnan, qnan, qnan}; *(f32x4*)(out + off + bj * HALF + n * 16) = o; }
                if (m & 1) asm volatile("" ::: "memory"); }
    }
};
struct EpiLnResLn {
    static constexpr bool PERM = false, AFTER_DRAIN = true;
    const float* base; float* out; bf16_t* xn; int ldc; const float* bias; PanelStats st1, st2; unsigned poison;
    __device__ __forceinline__ void fused(f32x4 (&acc)[2][2][4][2], const Unit& u, int wr, int wc, int fr, int fq, PG8_LAS unsigned char* lds, int wid, int lane) const {
        typedef float f32x2v __attribute__((ext_vector_type(2))); typedef unsigned u32x2v __attribute__((ext_vector_type(2)));
        const PG8_LAS f32x2v* S = (const PG8_LAS f32x2v*)(lds + 8192);
        const int col0 = u.pn * BM + wc * 32 + 4 * fq;
#pragma unroll
        for (int bj = 0; bj < 2; ++bj)
#pragma unroll
            for (int n = 0; n < 2; ++n) { const f32x4 bv = bias ? *(const f32x4*)(bias + col0 + bj * HALF + n * 16) : (f32x4){0.f, 0.f, 0.f, 0.f};
#pragma unroll
                for (int ai = 0; ai < 2; ++ai)
#pragma unroll
                    for (int m = 0; m < 4; ++m) acc[ai][bj][m][n] += bv; }
        bool bad = st1.run(acc, u, wr, wc, fr, fq, lds, wid, lane) || poison != 0u;
        const float qnan = __builtin_nanf("");
#pragma unroll
        for (int ai = 0; ai < 2; ++ai)
#pragma unroll
            for (int m = 0; m < 4; ++m) { const int r = ai * HALF + wr * 64 + m * 16 + fr; const f32x2v sr = S[r]; const size_t off = (size_t)(u.pm * BM + r) * ldc + col0;
#pragma unroll
                for (int bj = 0; bj < 2; ++bj)
#pragma unroll
                    for (int n = 0; n < 2; ++n) { const f32x4 bs = *(const f32x4*)(base + off + bj * HALF + n * 16); acc[ai][bj][m][n] = bs + (acc[ai][bj][m][n] - sr.x) * sr.y; }
                asm volatile("" : "+v"(acc[ai][0][m][0]), "+v"(acc[ai][0][m][1]), "+v"(acc[ai][1][m][0]), "+v"(acc[ai][1][m][1]));
                if (m & 1) asm volatile("" ::: "memory"); }
        const bool bad1 = bad;
        bad = st2.run(acc, u, wr, wc, fr, fq, lds, wid, lane) || bad;
#pragma unroll
        for (int ai = 0; ai < 2; ++ai)
#pragma unroll
            for (int m = 0; m < 4; ++m) { const int r = ai * HALF + wr * 64 + m * 16 + fr; const f32x2v sr = S[r]; const size_t off = (size_t)(u.pm * BM + r) * ldc + col0;
#pragma unroll
                for (int bj = 0; bj < 2; ++bj)
#pragma unroll
                    for (int n = 0; n < 2; ++n) { const f32x4 x1 = acc[ai][bj][m][n]; *(f32x4*)(out + off + bj * HALF + n * 16) = bad1 ? (f32x4){qnan, qnan, qnan, qnan} : x1;
                        const f32x4 o = (x1 - sr.x) * sr.y; u32x2v w; w.x = cvt_pk_bf16(o[0], o[1]); w.y = cvt_pk_bf16(o[2], o[3]);
                        if (bad) { w.x = 0x7fc07fc0u; w.y = 0x7fc07fc0u; } *(u32x2v*)(xn + off + bj * HALF + n * 16) = w; }
                asm volatile("" ::: "memory"); }
    }
};

template <class Epi, class Sched, bool ALIGN_EPI = false, bool SP2 = false>
__device__ __forceinline__ void gemm_phase(PG8_LAS unsigned char* lds, const Gemm g, const Sched& S, const Epi& E) {
    const int tid = ::tid_fresh(), wid = __builtin_amdgcn_readfirstlane(tid >> 6), lane = tid & 63, wr = wid >> 2, wc = wid & 3, fr = lane & 15, fq = lane >> 4;
    const int nt = g.K / BK, K = g.ld ? g.ld : g.K;
    unsigned voffA[2], voffB[2];
#pragma unroll
    for (int i = 0; i < 2; ++i) { int R, C; stage_rc(tid * 16 + i * 8192, R, C); const int Rb = Epi::PERM ? ((R & ~31) + perm32(R & 31)) : R;
        voffA[i] = (unsigned)(R * K + C) * 2u; voffB[i] = (unsigned)(Rb * K + C) * 2u; }
    const size_t kstep = (size_t)(BK * 2);
    const size_t hstep = (size_t)HALF * K * 2;
    const size_t tstep = 2 * hstep;
    const unsigned ldsw = (unsigned)wid * 1024u;
    const int aoff = lds_byte(wr * 64 + fr, fq * 8), boff = lds_byte(wc * 32 + fr, fq * 8);
#define PG8_SA(b, h) (((b) * 2 + (h)) * HTB)
#define PG8_SB(b, h) ((4 + (b) * 2 + (h)) * HTB)
#define PG8_STAGE(bufoff, gbase, voff) do { _Pragma("unroll") for (int _i = 0; _i < 2; ++_i) \
        __builtin_amdgcn_global_load_lds((const unsigned*)((const char*)(gbase) + (voff)[_i]), (PG8_LAS unsigned*)(lds + (bufoff) + ldsw + _i * 8192), 16, 0, 0); } while (0)
#define PG8_LDA(dst, b, h) do { _Pragma("unroll") for (int m = 0; m < 4; ++m) _Pragma("unroll") for (int k = 0; k < 2; ++k) dst[m][k] = *(const PG8_LAS bf16x8*)(lds + PG8_SA(b, h) + aoff + m * 2048 + k * 1024); } while (0)
#define PG8_LDB(dst, b, h) do { _Pragma("unroll") for (int n = 0; n < 2; ++n) _Pragma("unroll") for (int k = 0; k < 2; ++k) dst[n][k] = *(const PG8_LAS bf16x8*)(lds + PG8_SB(b, h) + boff + n * 2048 + k * 1024); } while (0)
#define PG8_MMA(ai, bj, At, Bt) do { __builtin_amdgcn_s_setprio(1); _Pragma("unroll") for (int m = 0; m < 4; ++m) _Pragma("unroll") for (int n = 0; n < 2; ++n) _Pragma("unroll") for (int k = 0; k < 2; ++k) \
        acc[ai][bj][m][n] = __builtin_amdgcn_mfma_f32_16x16x32_bf16(Bt[n][k], At[m][k], acc[ai][bj][m][n], 0, 0, 0); __builtin_amdgcn_s_setprio(0); } while (0)
#define PG8_WAIT_V(n) asm volatile("s_waitcnt vmcnt(" #n ")" ::: "memory")
#define PG8_WAIT_L(n) asm volatile("s_waitcnt lgkmcnt(" #n ")" ::: "memory")
#define PG8_BAR __builtin_amdgcn_s_barrier()
#define PG8_SCHED __builtin_amdgcn_sched_barrier(0)
    Unit cur, nxt; int ui = 0;
    if (!S.next(0, cur)) return;
    f32x4 acc[2][2][4][2];
#pragma unroll
    for (int a = 0; a < 2; ++a)
#pragma unroll
        for (int b = 0; b < 2; ++b)
#pragma unroll
            for (int m = 0; m < 4; ++m)
#pragma unroll
                for (int n = 0; n < 2; ++n) acc[a][b][m][n] = (f32x4){0.f, 0.f, 0.f, 0.f};
    bf16x8 At[4][2], B0[2][2], B1[2][2];
    const char* cA = (const char*)g.A + (size_t)cur.pm * tstep; const char* cB = (const char*)g.Bt + (size_t)cur.pn * tstep;
    S.a_ready(cur);
    if constexpr (SP2) {
        PG8_STAGE(PG8_SB(0, 0), cB, voffB); PG8_STAGE(PG8_SB(0, 1), cB + hstep, voffB); PG8_STAGE(PG8_SA(0, 0), cA, voffA); PG8_STAGE(PG8_SA(0, 1), cA + hstep, voffA);
        if (wr == 1) PG8_BAR;
        PG8_WAIT_V(2); PG8_BAR;
        PG8_STAGE(PG8_SB(1, 0), cB + kstep, voffB); PG8_STAGE(PG8_SA(1, 0), cA + kstep, voffA); PG8_STAGE(PG8_SB(1, 1), cB + hstep + kstep, voffB);
        PG8_WAIT_V(6); PG8_BAR;
    } else {
        PG8_STAGE(PG8_SB(0, 0), cB, voffB); PG8_STAGE(PG8_SA(0, 0), cA, voffA); PG8_STAGE(PG8_SB(0, 1), cB + hstep, voffB); PG8_STAGE(PG8_SA(0, 1), cA + hstep, voffA);
        if (wr == 1) PG8_BAR;
        PG8_WAIT_V(4); PG8_BAR;
        PG8_STAGE(PG8_SB(1, 0), cB + kstep, voffB); PG8_STAGE(PG8_SA(1, 0), cA + kstep, voffA); PG8_STAGE(PG8_SB(1, 1), cB + hstep + kstep, voffB);
        PG8_WAIT_V(6); PG8_BAR;
    }
    for (;;) {
        const bool has_next = S.next(ui + 1, nxt);
        const char* nA = has_next ? (const char*)g.A + (size_t)nxt.pm * tstep : cA; const char* nB = has_next ? (const char*)g.Bt + (size_t)nxt.pn * tstep : cB;
        for (int t = 0; t < nt; t += 2) {
            const bool last = (t == nt - 2);
            const char* a1 = cA + (size_t)(t + 1) * kstep;
            const char* a2 = last ? nA : cA + (size_t)(t + 2) * kstep; const char* b2 = last ? nB : cB + (size_t)(t + 2) * kstep;
            const char* a3 = a2 + kstep; const char* b3 = b2 + kstep;
            if (last && has_next) S.a_ready(nxt);
            if constexpr (SP2) {
            PG8_LDB(B0, 0, 0); PG8_LDB(B1, 0, 1); PG8_SCHED; PG8_LDA(At, 0, 0); PG8_STAGE(PG8_SA(1, 1), a1 + hstep, voffA);
            PG8_WAIT_V(8); PG8_WAIT_L(0); PG8_BAR; PG8_MMA(0, 0, At, B0); PG8_MMA(0, 1, At, B1); PG8_BAR; PG8_SCHED;
            PG8_LDA(At, 0, 1); PG8_STAGE(PG8_SB(0, 0), b2, voffB); PG8_STAGE(PG8_SB(0, 1), b2 + hstep, voffB); PG8_STAGE(PG8_SA(0, 0), a2, voffA);
            PG8_WAIT_V(8); PG8_WAIT_L(0); PG8_BAR; PG8_MMA(1, 0, At, B0); PG8_MMA(1, 1, At, B1); PG8_BAR; PG8_SCHED;
            PG8_LDB(B0, 1, 0); PG8_LDB(B1, 1, 1); PG8_SCHED; PG8_LDA(At, 1, 0); PG8_STAGE(PG8_SA(0, 1), a2 + hstep, voffA);
            PG8_WAIT_V(8); PG8_WAIT_L(0); PG8_BAR; PG8_MMA(0, 0, At, B0); PG8_MMA(0, 1, At, B1); PG8_BAR; PG8_SCHED;
            PG8_LDA(At, 1, 1); PG8_STAGE(PG8_SB(1, 0), b3, voffB); PG8_STAGE(PG8_SB(1, 1), b3 + hstep, voffB); PG8_STAGE(PG8_SA(1, 0), a3, voffA);
            PG8_WAIT_V(8); PG8_WAIT_L(0); PG8_BAR; PG8_MMA(1, 0, At, B0); PG8_MMA(1, 1, At, B1); PG8_BAR; PG8_SCHED;
            } else {
            PG8_LDB(B0, 0, 0); PG8_SCHED; PG8_LDA(At, 0, 0); PG8_STAGE(PG8_SA(1, 1), a1 + hstep, voffA);
            PG8_WAIT_L(8); PG8_BAR; PG8_WAIT_L(0); PG8_MMA(0, 0, At, B0); PG8_BAR; PG8_SCHED;
            PG8_LDB(B1, 0, 1); PG8_STAGE(PG8_SB(0, 0), b2, voffB);
            PG8_BAR; PG8_WAIT_L(0); PG8_MMA(0, 1, At, B1); PG8_BAR;
            PG8_LDA(At, 0, 1); PG8_STAGE(PG8_SA(0, 0), a2, voffA);
            PG8_BAR; PG8_WAIT_L(0); PG8_MMA(1, 0, At, B0); PG8_BAR; PG8_SCHED;
            PG8_STAGE(PG8_SB(0, 1), b2 + hstep, voffB);
            PG8_WAIT_V(6); PG8_BAR; PG8_MMA(1, 1, At, B1); PG8_BAR;
            PG8_LDB(B0, 1, 0); PG8_SCHED; PG8_LDA(At, 1, 0); PG8_STAGE(PG8_SA(0, 1), a2 + hstep, voffA);
            PG8_WAIT_L(8); PG8_BAR; PG8_WAIT_L(0); PG8_MMA(0, 0, At, B0); PG8_BAR; PG8_SCHED;
            PG8_LDB(B1, 1, 1); PG8_STAGE(PG8_SB(1, 0), b3, voffB);
            PG8_BAR; PG8_WAIT_L(0); PG8_MMA(0, 1, At, B1); PG8_BAR;
            PG8_LDA(At, 1, 1); PG8_STAGE(PG8_SA(1, 0), a3, voffA);
            PG8_BAR; PG8_WAIT_L(0); PG8_MMA(1, 0, At, B0); PG8_BAR; PG8_SCHED;
            PG8_STAGE(PG8_SB(1, 1), b3 + hstep, voffB);
            PG8_WAIT_V(6); PG8_BAR; PG8_MMA(1, 1, At, B1); PG8_BAR;
            }
        }
        if constexpr (ALIGN_EPI) { if (wr == 0) PG8_BAR; }
        if constexpr (!Epi::AFTER_DRAIN) { E(acc, cur, wr, wc, fr, fq); S.done(cur); }
        if (!has_next) break;
#pragma unroll
        for (int a = 0; a < 2; ++a)
#pragma unroll
            for (int b = 0; b < 2; ++b)
#pragma unroll
                for (int m = 0; m < 4; ++m)
#pragma unroll
                    for (int n = 0; n < 2; ++n) acc[a][b][m][n] = (f32x4){0.f, 0.f, 0.f, 0.f};
        cur = nxt; cA = nA; cB = nB; ++ui;
        if constexpr (ALIGN_EPI) { if (wr == 1) PG8_BAR; }
    }
    PG8_WAIT_V(0);
    if constexpr (!ALIGN_EPI) { if (wr == 0) PG8_BAR; }
    PG8_BAR;
    if constexpr (Epi::AFTER_DRAIN) { E.fused(acc, cur, wr, wc, fr, fq, lds, wid, lane); S.done(cur); }
#undef PG8_SA
#undef PG8_SB
#undef PG8_STAGE
#undef PG8_LDA
#undef PG8_LDB
#undef PG8_MMA
#undef PG8_WAIT_V
#undef PG8_WAIT_L
#undef PG8_BAR
#undef PG8_SCHED
}
}

#define GAS __attribute__((address_space(1)))
#define LAS __attribute__((address_space(3)))
typedef GAS unsigned gu32;
typedef GAS unsigned long long gu64;
#define RLX_AGENT __ATOMIC_RELAXED, __HIP_MEMORY_SCOPE_AGENT
#define LDS_WAIT() asm volatile("s_waitcnt lgkmcnt(0)" ::: "memory")
#define VM_WAIT() asm volatile("s_waitcnt vmcnt(0)" ::: "memory")
__device__ __forceinline__ unsigned long long rt() { return __builtin_amdgcn_s_memrealtime(); }
#define XB_TMO      128
#define XB_XCNT(j)  (256  + 64 * (j))
#define XB_XSUB(j)  (1280 + 64 * (j))
#define XB_XGEN(j)  (2304 + 64 * (j))
#define XB_TOP      3328
#define XB_TOPGEN   3392
#define XCD_BAR_WORDS 3456
#define XB_SPIN_CAP (1u << 20)

__device__ __forceinline__ unsigned xb_ld(unsigned* p)              { return __hip_atomic_load(p, __ATOMIC_RELAXED, __HIP_MEMORY_SCOPE_AGENT); }
__device__ __forceinline__ unsigned xb_add(unsigned* p, unsigned v) { return __hip_atomic_fetch_add(p, v, __ATOMIC_RELAXED, __HIP_MEMORY_SCOPE_AGENT); }
__device__ __forceinline__ unsigned xb_xcc_id() { return (unsigned)__builtin_amdgcn_s_getreg((3 << 11) | 20) & 0xFu; }
#define XB_SPIN(cond, bar) do { unsigned _sp = 0; while (cond) { __builtin_amdgcn_s_sleep(1); \
    if ((++_sp & 255u) == 0u) { if (xb_ld(&(bar)[XB_TMO])) break; if (_sp > XB_SPIN_CAP) { atomicAdd(&(bar)[XB_TMO], 1u); break; } } } } while (0)

struct XcdBarrier {
    unsigned* bar; unsigned x;
    volatile LAS unsigned* st;
};

__device__ __forceinline__ XcdBarrier xcd_barrier_post(unsigned* bar, volatile LAS unsigned* st) {
    XcdBarrier b; b.bar = bar; b.x = xb_xcc_id(); b.st = st;
    if (threadIdx.x == 0) (void)xb_add(&bar[XB_XCNT(b.x)], 1u);
    return b;
}
__device__ __forceinline__ void xcd_barrier_complete(unsigned* bar, unsigned x, unsigned& nloc, unsigned& nx) {
    const unsigned G = gridDim.x * gridDim.y * gridDim.z;
    unsigned sum, cnt, mine, sp = 0u;
    for (;;) {
        sum = 0u; cnt = 0u; mine = 0u;
#pragma unroll
        for (unsigned j = 0; j < 16; ++j) { const unsigned c = xb_ld(&bar[XB_XCNT(j)]); sum += c; cnt += (c > 0u) ? 1u : 0u; mine = (j == x) ? c : mine; }
        if (sum == G) break;
        __builtin_amdgcn_s_sleep(1);
        if ((++sp & 255u) == 0u) { if (xb_ld(&bar[XB_TMO])) break; if (sp > XB_SPIN_CAP) { atomicAdd(&bar[XB_TMO], 1u); break; } }
    }
    nloc = mine > 0u ? mine : 1u; nx = cnt > 0u ? cnt : 1u;
}

__device__ __forceinline__ void xcd_barrier(const XcdBarrier& b) {
    asm volatile("s_waitcnt vmcnt(0)" ::: "memory");
    __syncthreads();
    if (threadIdx.x == 0) {
        unsigned* bar = b.bar;
        __builtin_amdgcn_s_waitcnt(0);
        unsigned nloc = b.st[0], nx = b.st[1];
        if (nloc == 0u) { xcd_barrier_complete(bar, b.x, nloc, nx); b.st[0] = nloc; b.st[1] = nx; }
        const unsigned old = xb_add(&bar[XB_XSUB(b.x)], 1u);
        const unsigned gen = old / nloc;
        if (old + 1u == (gen + 1u) * nloc) {
            __builtin_amdgcn_fence(__ATOMIC_RELEASE, "agent");
            asm volatile("s_waitcnt vmcnt(0)" ::: "memory");
            const unsigned og = xb_add(&bar[XB_TOP], 1u);
            const unsigned tg = og / nx;
            if (og + 1u == (tg + 1u) * nx) xb_add(&bar[XB_TOPGEN], 1u);
            else XB_SPIN(xb_ld(&bar[XB_TOPGEN]) == tg, bar);
            __builtin_amdgcn_fence(__ATOMIC_ACQUIRE, "agent");
            xb_add(&bar[XB_XGEN(b.x)], 1u);
            asm volatile("s_waitcnt vmcnt(0)" ::: "memory");
        } else {
            XB_SPIN(xb_ld(&bar[XB_XGEN(b.x)]) == gen, bar);
            __builtin_amdgcn_fence(__ATOMIC_ACQUIRE, "agent");
            asm volatile("s_waitcnt vmcnt(0)" ::: "memory");
        }
    }
    __syncthreads();
}


#define DI __device__ __forceinline__
typedef unsigned short bf16;
typedef short bf16x8 __attribute__((ext_vector_type(8)));
typedef short s16x4 __attribute__((ext_vector_type(4)));
typedef float f32x4 __attribute__((ext_vector_type(4)));
typedef float f32x16 __attribute__((ext_vector_type(16)));
typedef unsigned u32x4 __attribute__((ext_vector_type(4)));
typedef unsigned u32x2 __attribute__((ext_vector_type(2)));
typedef float f32x2_t __attribute__((ext_vector_type(2)));
typedef __bf16 bf16x2_t __attribute__((ext_vector_type(2)));

constexpr int DM = 1024, NB = 8, SEQ = 4096, CTXL = 256;
constexpr int ML = NB * SEQ;
constexpr int MC = NB * CTXL;
constexpr int MT = ML + MC;
constexpr int DFF = 2816;
constexpr int NZ0 = 2560;
constexpr int NZ1 = 2304;
constexpr int ZQKV = 0, ZGATE = 1536, ZA = 2048, ZBT = 2064, ZQD = 2080, ZKVD = 2336, ZKPE = 2464;
constexpr int Z1_NAQ = 0, Z1_NAK = 512, Z1_NAV = 1024, Z1_GQ = 1536, Z1_GK = 2048, Z1_GV = 2176;
constexpr float EPS = 1e-6f;
constexpr float LOG2E = 1.4426950408889634f;
constexpr int NTHREADS = 512, NWAVES = 8;
constexpr int LDS_BYTES = 147456;

constexpr size_t MiB = 1048576;
constexpr size_t WS_WIN0 = 0;
constexpr size_t WS_WOUT0 = 5 * MiB;
constexpr size_t WS_WGU0 = 7 * MiB;
constexpr size_t WS_WDN0 = 18 * MiB;
constexpr size_t WS_WQUP = 24 * MiB;
constexpr size_t WS_WKVUP = 24 * MiB + 512 * 1024;
constexpr size_t WS_WIN1 = 25 * MiB;
constexpr size_t WS_WOUT1 = 30 * MiB;
constexpr size_t WS_WGU1 = 32 * MiB;
constexpr size_t WS_WDN1 = 43 * MiB;
constexpr size_t WS_MOD = 49 * MiB;
constexpr size_t WS_HC = 50 * MiB;
constexpr size_t WS_CTL = 60 * MiB;
constexpr size_t WS_QCTR = 60 * MiB + 14336;
constexpr size_t WS_CTL2 = 60 * MiB + 16384;
constexpr size_t WS_SUBCNT = 60 * MiB + 13824;
constexpr size_t WS_ROPE16 = 60 * MiB + 65536;
constexpr size_t WS_ROPE8 = 60 * MiB + 65536 + 8192;
constexpr size_t WS_U = 64 * MiB;
constexpr size_t WS_Z = 132 * MiB;
constexpr size_t WS_S = 320 * MiB;
constexpr size_t WS_TINV = WS_S;
constexpr size_t WS_QN = WS_U;
constexpr size_t WS_KVN = WS_U + 17 * MiB;
constexpr size_t WS_QMLA = 388 * MiB;
constexpr size_t WS_KVMLA = 439 * MiB;
constexpr size_t WS_KPE = 507 * MiB;
constexpr size_t WS_GB = 302 * MiB;
constexpr size_t WS_OBHI = 307 * MiB;
constexpr int OB_SPLIT = 26624;
constexpr size_t OUT_OBLO = 102 * MiB;
constexpr size_t WS_Y = WS_S;
constexpr size_t WS_GQ = WS_S + 70 * MiB;
constexpr size_t WS_GKK = WS_S + 104 * MiB;
constexpr size_t WS_GKV = WS_S + 70 * MiB;
constexpr size_t WS_Y2C = WS_S + 72 * MiB;
constexpr size_t WS_HB = 436 * MiB;
constexpr size_t WS_END = 510 * MiB;

struct KParams {
    const float* in[28];
    float* out;
    unsigned char* ws;
};

DI float bflo(unsigned w) { return __uint_as_float(w << 16); }
DI float bfhi(unsigned w) { return __uint_as_float(w & 0xffff0000u); }
DI float bf2f(bf16 b) { return __uint_as_float(((unsigned)b) << 16); }
DI unsigned pk2(float lo, float hi) { f32x2_t v = {lo, hi}; bf16x2_t b = __builtin_convertvector(v, bf16x2_t); return __builtin_bit_cast(unsigned, b); }
DI bf16 f2bf(float x) { return (bf16)(pk2(x, 0.f) & 0xffffu); }
DI void unpack8(const u32x4 w, float* f) {
    f[0] = bflo(w.x); f[1] = bfhi(w.x); f[2] = bflo(w.y); f[3] = bfhi(w.y); f[4] = bflo(w.z); f[5] = bfhi(w.z); f[6] = bflo(w.w); f[7] = bfhi(w.w);
}
DI u32x4 pack8(const float* f) { u32x4 w; w.x = pk2(f[0], f[1]); w.y = pk2(f[2], f[3]); w.z = pk2(f[4], f[5]); w.w = pk2(f[6], f[7]); return w; }
DI float wave_sum(float v) {
#pragma unroll
    for (int o = 1; o < 64; o <<= 1) v += __shfl_xor(v, o);
    return v;
}
DI float silu_f(float x) { return x * __builtin_amdgcn_rcpf(1.f + __expf(-x)); }
DI float sigmoid_f(float x) { return 1.f / (1.f + __expf(-x)); }
DI float softplus_f(float x) { return x > 20.f ? x : log1pf(expf(x)); }
DI int crow(int r, int hi) { return (r & 3) + 8 * (r >> 2) + 4 * hi; }
DI int batch_of(int m) { return m < ML ? (m >> 12) : 8; }
DI const float* modp(const KParams& p, int layer, int m) { return (const float*)(p.ws + WS_MOD) + (size_t)(layer * 9 + batch_of(m)) * 6144; }

struct TDesc { int src, src_off, K, N, ldw; unsigned dst_off_kb; int grp, gstride, goff; int nitems; };
constexpr int NTD = 14;
static constexpr TDesc g_td[NTD] = {
    {13, 0, 1024, 2496, 2496, (unsigned)(WS_WIN0 / 1024), 1 << 20, 0, 0, 16 * 39},
    {14, 0, 1024, 1024, 1024, (unsigned)(WS_WOUT0 / 1024), 1 << 20, 0, 0, 16 * 16},
    {10, 0, 1024, 2816, 2816, (unsigned)(WS_WGU0 / 1024), 128, 256, 0, 16 * 44},
    {11, 0, 1024, 2816, 2816, (unsigned)(WS_WGU0 / 1024), 128, 256, 128, 16 * 44},
    {12, 0, 2816, 1024, 1024, (unsigned)(WS_WDN0 / 1024), 1 << 20, 0, 0, 44 * 16},
    {20, 0, 256, 768, 768, (unsigned)(WS_WQUP / 1024), 1 << 20, 0, 0, 4 * 12},
    {22, 0, 128, 1024, 1024, (unsigned)(WS_WKVUP / 1024), 1 << 20, 0, 0, 2 * 16},
    {23, 0, 1024, 2304, 2304, (unsigned)(WS_WIN1 / 1024), 1 << 20, 0, 0, 16 * 36},
    {24, 0, 1024, 1024, 1024, (unsigned)(WS_WOUT1 / 1024), 1 << 20, 0, 0, 16 * 16},
    {10, 1024 * 2816, 1024, 2816, 2816, (unsigned)(WS_WGU1 / 1024), 128, 256, 0, 16 * 44},
    {11, 1024 * 2816, 1024, 2816, 2816, (unsigned)(WS_WGU1 / 1024), 128, 256, 128, 16 * 44},
    {12, 2816 * 1024, 2816, 1024, 1024, (unsigned)(WS_WDN1 / 1024), 1 << 20, 0, 0, 44 * 16},
    {0, 0, 0, 0, 0, 0, 1, 0, 0, 0},
    {0, 0, 0, 0, 0, 0, 1, 0, 0, 0},
};
constexpr int NTD_USED = 12;

DI void transpose_item(const float* W, int K, int N, bf16* WT, int grp, int gstride, int goff, float* scr_, int item, int lane) {
    unsigned* scr = (unsigned*)scr_;
    const int nblk = N / 64, kb = item / nblk, nb = item % nblk, k0 = 64 * kb, n0 = 64 * nb;
    const float* src = W + (size_t)k0 * N + n0 + lane;
#pragma unroll
    for (int hf = 0; hf < 2; ++hf) {
        float w[32];
#pragma unroll
        for (int i = 0; i < 32; ++i) w[i] = src[(size_t)(32 * hf + i) * N];
#pragma unroll
        for (int i = 0; i < 16; ++i) scr[(16 * hf + i) * 66 + lane] = pk2(w[2 * i], w[2 * i + 1]);
    }
    asm volatile("s_waitcnt lgkmcnt(0)" ::: "memory");
    asm volatile("" ::: "memory");
    const int c = lane & 7;
#pragma unroll
    for (int j = 0; j < 8; ++j) {
        const int n = (lane >> 3) + 8 * j; const unsigned* s = scr + (4 * c) * 66 + n;
        u32x4 o; o.x = s[0]; o.y = s[66]; o.z = s[132]; o.w = s[198];
        const int nn = n0 + n; const int drow = (nn / grp) * gstride + (nn % grp) + goff;
        *(u32x4*)(WT + (size_t)drow * K + k0 + 8 * c) = o;
    }
    asm volatile("s_waitcnt lgkmcnt(0)" ::: "memory");
}
constexpr unsigned TD_EARLY = (1u << 0) | (1u << 5) | (1u << 6);
constexpr unsigned TD_LATE = ((1u << NTD_USED) - 1u) & ~TD_EARLY;
constexpr unsigned TD_T2 = (1u << 1) | (1u << 2) | (1u << 3) | (1u << 4) | (1u << 7) | (1u << 8);
constexpr unsigned TD_T12 = (1u << 9) | (1u << 10);
constexpr unsigned TD_T15 = (1u << 11);
static_assert((TD_T2 | TD_T12 | TD_T15) == TD_LATE && (TD_T2 & TD_T12) == 0 && (TD_T2 & TD_T15) == 0 && (TD_T12 & TD_T15) == 0, "weight conversion split");
template <unsigned MASK> DI void weight_transposes(const KParams& p, unsigned char* lds, int gw, int NGW) {
    const int tid = tid_fresh(), lane = tid & 63, wave = tid >> 6;
    float* scr = (float*)(lds + 57344 + wave * 8448);
    int total = 0;
#pragma unroll
    for (int d = 0; d < NTD_USED; ++d) if ((MASK >> d) & 1u) total += g_td[d].nitems;
    for (int it = gw; it < total; it += NGW) {
        int r = it;
#pragma unroll
        for (int d = 0; d < NTD_USED; ++d) if ((MASK >> d) & 1u) {
            if (r >= 0 && r < g_td[d].nitems)
                transpose_item(p.in[g_td[d].src] + g_td[d].src_off, g_td[d].K, g_td[d].N, (bf16*)(p.ws + (size_t)g_td[d].dst_off_kb * 1024), g_td[d].grp, g_td[d].gstride, g_td[d].goff, scr, r, lane);
            r -= g_td[d].nitems;
        }
    }
}
template <unsigned MASK> DI void tail_weight_transposes(const KParams& p, unsigned char* lds, int nunits) {
    const int G = (int)gridDim.x, first = nunits % G;
    if ((int)blockIdx.x >= first) {
        asm volatile("s_waitcnt vmcnt(0) lgkmcnt(0)" ::: "memory"); __syncthreads();
        weight_transposes<MASK>(p, lds, ((int)blockIdx.x - first) * NWAVES + (int)(tid_fresh() >> 6), (G - first) * NWAVES);
    }
}

DI void phase_prologue(const KParams& p, unsigned char* lds) {
    const int tid = tid_fresh(), lane = tid & 63, wave = tid >> 6;
    const int G = gridDim.x;
    float* sc = (float*)lds;
    float* red = (float*)(lds + 36864);
    bool have_sc = false;
    for (int it = blockIdx.x; it < 192; it += G) {
        if (!have_sc) {
            for (int i = tid; i < 9 * 1024; i += NTHREADS) {
                const int bb = i >> 10, k = i & 1023;
                const float cv = bb < 8 ? p.in[1][bb * 1024 + k] : p.in[3][k];
                sc[i] = cv / (1.f + expf(-cv));
            }
            have_sc = true;
        }
        __syncthreads();
        const int layer = it / 96, n0 = (it % 96) * 64;
        const int col = tid & 63, ks = tid >> 6;
        const float* W = p.in[4] + (size_t)layer * 1024 * 6144 + n0 + col;
        float acc[9];
#pragma unroll
        for (int b = 0; b < 9; ++b) acc[b] = 0.f;
        for (int k0 = ks * 128; k0 < ks * 128 + 128; k0 += 32) {
            float w[32];
#pragma unroll
            for (int kk = 0; kk < 32; ++kk) w[kk] = W[(size_t)(k0 + kk) * 6144];
#pragma unroll
            for (int kk = 0; kk < 32; ++kk)
#pragma unroll
                for (int b = 0; b < 9; ++b) acc[b] += sc[b * 1024 + k0 + kk] * w[kk];
        }
#pragma unroll
        for (int b = 0; b < 9; ++b) red[(ks * 9 + b) * 64 + col] = acc[b];
        __syncthreads();
        for (int i = tid; i < 576; i += NTHREADS) {
            const int b = i >> 6, c2 = i & 63; float s = 0.f;
#pragma unroll
            for (int k2 = 0; k2 < 8; ++k2) s += red[(k2 * 9 + b) * 64 + c2];
            s += p.in[5][layer * 6144 + n0 + c2];
            ((float*)(p.ws + WS_MOD))[(size_t)(layer * 9 + b) * 6144 + n0 + c2] = s;
        }
        __syncthreads();
    }
    __syncthreads();
#ifdef ALL_W_EARLY
    weight_transposes<TD_EARLY | TD_LATE>(p, lds, blockIdx.x * NWAVES + wave, G * NWAVES);
#else
    weight_transposes<TD_EARLY>(p, lds, blockIdx.x * NWAVES + wave, G * NWAVES);
#endif
    if (blockIdx.x == G - 1) {
        float2* t16 = (float2*)(p.ws + WS_ROPE16); float2* t8 = (float2*)(p.ws + WS_ROPE8);
        for (int i = tid; i < 1024; i += NTHREADS) {
            const float invf = exp2f(-(float)(i & 15) * (13.287712379549449f / 16.f));
            float sn, cs; sincosf((float)(i >> 4) * invf, &sn, &cs); t16[i] = make_float2(cs, sn);
        }
        {
            const int i = tid;
            const float invf8[8] = {1.f, 0.31622776601683794f, 0.1f, 0.031622776601683794f, 0.01f, 0.0031622776601683794f, 0.001f, 0.00031622776601683794f};
            float iv = invf8[0];
#pragma unroll
            for (int e = 1; e < 8; ++e) iv = ((i & 7) == e) ? invf8[e] : iv;
            float sn, cs; sincosf((float)(i >> 3) * iv, &sn, &cs); t8[i] = make_float2(cs, sn);
        }
    }
    {
        u32x4* z = (u32x4*)(p.ws + WS_WIN0 + (size_t)2496 * 1024 * 2);
        const u32x4 zero = {0u, 0u, 0u, 0u};
        for (int i = blockIdx.x * NTHREADS + tid; i < 64 * 1024 * 2 / 16; i += G * NTHREADS) z[i] = zero;
    }
}

DI void ld8f(const float* p, float* f) { const f32x4 a = *(const f32x4*)p, b2 = *(const f32x4*)(p + 4); f[0] = a.x; f[1] = a.y; f[2] = a.z; f[3] = a.w; f[4] = b2.x; f[5] = b2.y; f[6] = b2.z; f[7] = b2.w; }
DI void st8f(float* p, const float* f) { *(f32x4*)p = (f32x4){f[0], f[1], f[2], f[3]}; *(f32x4*)(p + 4) = (f32x4){f[4], f[5], f[6], f[7]}; }

DI void wave_pair_range(int npairs, int gw, int NGW, int& p0, int& np) {
    const int base = npairs / NGW, rem = npairs % NGW;
    np = base + (gw < rem ? 1 : 0); p0 = gw * base + (gw < rem ? gw : rem);
}
DI void phase_modnorm0(const KParams& p) {
    const int tid_ = tid_fresh(); const int lane = tid_ & 63, wave = tid_ >> 6;
    const int gw = blockIdx.x * NWAVES + wave, NGW = gridDim.x * NWAVES;
    const float* g = p.in[6];
    bf16* U = (bf16*)(p.ws + WS_U);
    float gg[2][8], sh[2][8], scl[2][8];
#pragma unroll
    for (int j = 0; j < 2; ++j) ld8f(g + 8 * lane + 512 * j, gg[j]);
    int p0, np; wave_pair_range(MT / 2, gw, NGW, p0, np);
    int cur_b = -1;
    for (int i = 0; i < np; ++i) {
        const int m0 = 2 * (p0 + i);
        float v[2][2][8];
#pragma unroll
        for (int r = 0; r < 2; ++r) {
            const int m = m0 + r;
            const float* src = m < ML ? p.in[0] + (size_t)m * DM : p.in[2] + (size_t)(m - ML) * DM;
#pragma unroll
            for (int j = 0; j < 2; ++j) ld8f(src + 8 * lane + 512 * j, v[r][j]);
        }
        const int bb = batch_of(m0);
        if (bb != cur_b) {
            cur_b = bb; const float* md = modp(p, 0, m0);
#pragma unroll
            for (int j = 0; j < 2; ++j) { ld8f(md + 8 * lane + 512 * j, sh[j]); ld8f(md + 1024 + 8 * lane + 512 * j, scl[j]); }
        }
#pragma unroll
        for (int r = 0; r < 2; ++r) {
            const int m = m0 + r;
            float ss = 0.f;
#pragma unroll
            for (int j = 0; j < 2; ++j)
#pragma unroll
                for (int e = 0; e < 8; ++e) ss += v[r][j][e] * v[r][j][e];
            const float rstd = rsqrtf(wave_sum(ss) * (1.f / DM) + EPS);
#pragma unroll
            for (int j = 0; j < 2; ++j) {
                float o[8];
#pragma unroll
                for (int e = 0; e < 8; ++e) o[e] = (v[r][j][e] * rstd * gg[j][e]) * (1.f + scl[j][e]) + sh[j][e];
                *(u32x4*)(U + (size_t)m * DM + 8 * lane + 512 * j) = pack8(o);
            }
        }
    }
}

DI void phase_post(const KParams& p, int row0, int rows, const bf16* Y, int first_layer_input, int layer, int gate_chunk,
                   const float* gpost, const float* g2, int nlayer, int nshift_chunk, bf16* Udst, int wg0, int nwg, const bf16* Y2 = nullptr) {
    const int tid_ = tid_fresh(); const int lane = tid_ & 63, wave = tid_ >> 6;
    const int gw = ((int)blockIdx.x - wg0) * NWAVES + wave, NGW = nwg * NWAVES;
    bf16* HB = (bf16*)(p.ws + WS_HB);
    float gp[2][8], gg[2][8], gt[2][8], sh[2][8], scl[2][8];
#pragma unroll
    for (int j = 0; j < 2; ++j) {
        ld8f(gpost + 8 * lane + 512 * j, gp[j]);
        if (Udst) ld8f(g2 + 8 * lane + 512 * j, gg[j]);
    }
    int p0, np; wave_pair_range((rows - row0) / 2, gw, NGW, p0, np);
    int cur_b = -1;
    u32x4 yn[2][2], y2n[2][2], hn4[2][4];
    auto fetch = [&](int m0) __attribute__((always_inline)) {
#pragma unroll
        for (int r = 0; r < 2; ++r) {
            const int m = m0 + r;
#pragma unroll
            for (int j = 0; j < 2; ++j) yn[r][j] = *(const u32x4*)(Y + (size_t)m * DM + 8 * lane + 512 * j);
            if (Y2) {
#pragma unroll
                for (int j = 0; j < 2; ++j) y2n[r][j] = *(const u32x4*)(Y2 + (size_t)m * DM + 8 * lane + 512 * j);
            }
            if (first_layer_input) {
                const float* hsrc = m < ML ? p.in[0] + (size_t)m * DM : p.in[2] + (size_t)(m - ML) * DM;
#pragma unroll
                for (int j = 0; j < 2; ++j) { hn4[r][2 * j] = *(const u32x4*)(hsrc + 8 * lane + 512 * j); hn4[r][2 * j + 1] = *(const u32x4*)(hsrc + 8 * lane + 512 * j + 4); }
            } else {
#pragma unroll
                for (int j = 0; j < 2; ++j) hn4[r][2 * j] = *(const u32x4*)(HB + (size_t)m * DM + 8 * lane + 512 * j);
            }
        }
    };
    if (np > 0) fetch(row0 + 2 * p0);
    for (int i = 0; i < np; ++i) {
        const int m0 = row0 + 2 * (p0 + i);
        u32x4 yw[2][2], y2w[2][2]; float hv[2][2][8];
#pragma unroll
        for (int r = 0; r < 2; ++r)
#pragma unroll
            for (int j = 0; j < 2; ++j) {
                yw[r][j] = yn[r][j]; if (Y2) y2w[r][j] = y2n[r][j];
                if (first_layer_input) {
                    const u32x4 a = hn4[r][2 * j], b2 = hn4[r][2 * j + 1];
                    hv[r][j][0] = __uint_as_float(a.x); hv[r][j][1] = __uint_as_float(a.y); hv[r][j][2] = __uint_as_float(a.z); hv[r][j][3] = __uint_as_float(a.w);
                    hv[r][j][4] = __uint_as_float(b2.x); hv[r][j][5] = __uint_as_float(b2.y); hv[r][j][6] = __uint_as_float(b2.z); hv[r][j][7] = __uint_as_float(b2.w);
                } else unpack8(hn4[r][2 * j], hv[r][j]);
            }
        if (i + 1 < np) fetch(m0 + 2);
        const int bb = batch_of(m0);
        if (bb != cur_b) {
            cur_b = bb; const float* md = modp(p, layer, m0); const float* md2 = modp(p, nlayer, m0);
#pragma unroll
            for (int j = 0; j < 2; ++j) {
                ld8f(md + gate_chunk * 1024 + 8 * lane + 512 * j, gt[j]);
                if (Udst) { ld8f(md2 + nshift_chunk * 1024 + 8 * lane + 512 * j, sh[j]); ld8f(md2 + (nshift_chunk + 1) * 1024 + 8 * lane + 512 * j, scl[j]); }
            }
        }
#pragma unroll
        for (int r = 0; r < 2; ++r) {
            const int m = m0 + r;
            float yy[2][8]; float ss = 0.f;
#pragma unroll
            for (int j = 0; j < 2; ++j) {
                unpack8(yw[r][j], yy[j]);
                if (Y2) { float y2[8]; unpack8(y2w[r][j], y2);
#pragma unroll
                    for (int e = 0; e < 8; ++e) yy[j][e] += y2[e]; }
#pragma unroll
                for (int e = 0; e < 8; ++e) ss += yy[j][e] * yy[j][e];
            }
            const float rstd = rsqrtf(wave_sum(ss) * (1.f / DM) + EPS);
            float hn[2][8]; float ss2 = 0.f;
#pragma unroll
            for (int j = 0; j < 2; ++j) {
                const int c = 8 * lane + 512 * j;
#pragma unroll
                for (int e = 0; e < 8; ++e) { hn[j][e] = hv[r][j][e] + gt[j][e] * (yy[j][e] * rstd * gp[j][e]); ss2 += hn[j][e] * hn[j][e]; }
                if (Udst) *(u32x4*)(HB + (size_t)m * DM + c) = pack8(hn[j]);
                else st8f(p.out + (size_t)m * DM + c, hn[j]);
            }
            if (Udst) {
                const float rstd2 = rsqrtf(wave_sum(ss2) * (1.f / DM) + EPS);
#pragma unroll
                for (int j = 0; j < 2; ++j) {
                    float o[8];
#pragma unroll
                    for (int e = 0; e < 8; ++e) o[e] = (hn[j][e] * rstd2 * gg[j][e]) * (1.f + scl[j][e]) + sh[j][e];
                    *(u32x4*)(Udst + (size_t)m * DM + 8 * lane + 512 * j) = pack8(o);
                }
            }
        }
    }
}

struct EpiSwiglu {
    static constexpr bool PERM = true, AFTER_DRAIN = false;
    bf16* O; int ldc;
    __device__ __forceinline__ void operator()(const pg8::f32x4 (&acc)[2][2][4][2], const pg8::Unit& u, int wr, int wc, int fr, int fq) const {
        const int row0 = u.pm * 256 + wr * 64 + fr; const int col0 = u.pn * 128 + wc * 32 + 8 * fq;
#pragma unroll
        for (int ai = 0; ai < 2; ++ai)
#pragma unroll
            for (int m = 0; m < 4; ++m) {
                bf16* rowp = O + (size_t)(row0 + ai * 128 + m * 16) * ldc + col0;
                const pg8::f32x4 g0 = acc[ai][0][m][0], g1 = acc[ai][0][m][1], u0 = acc[ai][1][m][0], u1 = acc[ai][1][m][1];
                u32x4 w;
                w.x = pk2(silu_f(g0[0]) * u0[0], silu_f(g0[1]) * u0[1]); w.y = pk2(silu_f(g0[2]) * u0[2], silu_f(g0[3]) * u0[3]);
                w.z = pk2(silu_f(g1[0]) * u1[0], silu_f(g1[1]) * u1[1]); w.w = pk2(silu_f(g1[2]) * u1[2], silu_f(g1[3]) * u1[3]);
                *(u32x4*)rowp = w;
            }
    }
};

DI void gemm_store_sub(unsigned char* lds, const bf16* A, const bf16* Bt, int M, int N, int K, bf16* O, int ldc, int wg0, int nwg) {
    pg8::Gemm g{A, Bt, M, N, K}; pg8::StaticOrder S; S.init(M, N, nwg, (int)blockIdx.x - wg0);
    pg8::EpiBf16<0> E{O, ldc, nullptr, 0, 0, 1.f};
    pg8::gemm_phase<pg8::EpiBf16<0>, pg8::StaticOrder, true, true>((PG8_LAS unsigned char*)lds, g, S, E);
}
DI void gemm_store(unsigned char* lds, const bf16* A, const bf16* Bt, int M, int N, int K, bf16* O, int ldc) {
    gemm_store_sub(lds, A, Bt, M, N, K, O, ldc, 0, (int)gridDim.x);
}
DI void gemm_store_sub_kslice(unsigned char* lds, const bf16* A, const bf16* Bt, int M, int N, int K, int k0, int Ks, bf16* O, int ldc, int wg0, int nwg) {
    pg8::Gemm g{A + k0, Bt + k0, M, N, Ks, K}; pg8::StaticOrder S; S.init(M, N, nwg, (int)blockIdx.x - wg0);
    pg8::EpiBf16<0> E{O, ldc, nullptr, 0, 0, 1.f};
    pg8::gemm_phase<pg8::EpiBf16<0>, pg8::StaticOrder, true, true>((PG8_LAS unsigned char*)lds, g, S, E);
}
DI void gemm_store_rot(unsigned char* lds, const bf16* A, const bf16* Bt, int M, int N, int K, bf16* O, int ldc, int rot) {
    const int G = (int)gridDim.x;
    pg8::Gemm g{A, Bt, M, N, K}; pg8::StaticOrder S; S.init(M, N, G, ((int)blockIdx.x - rot % G + G) % G);
    pg8::EpiBf16<0> E{O, ldc, nullptr, 0, 0, 1.f};
    pg8::gemm_phase<pg8::EpiBf16<0>, pg8::StaticOrder, true, true>((PG8_LAS unsigned char*)lds, g, S, E);
}
DI void sub_barrier(unsigned* cnt, unsigned n) {
    asm volatile("s_waitcnt vmcnt(0)" ::: "memory");
    __syncthreads();
    if (threadIdx.x == 0) {
        __threadfence();
        __hip_atomic_fetch_add(cnt, 1u, __ATOMIC_RELAXED, __HIP_MEMORY_SCOPE_AGENT);
        unsigned spins = 0;
        while (__hip_atomic_load(cnt, __ATOMIC_RELAXED, __HIP_MEMORY_SCOPE_AGENT) < n) { __builtin_amdgcn_s_sleep(2); if (++spins > (1u << 22)) break; }
        __threadfence();
        asm volatile("s_waitcnt vmcnt(0)" ::: "memory");
    }
    __syncthreads();
}
DI void gemm_swiglu(unsigned char* lds, const bf16* A, const bf16* Bt, int M, bf16* O) {
    pg8::Gemm g{A, Bt, M, 2 * DFF, DM}; pg8::StaticOrder S; S.init(M, 2 * DFF, (int)gridDim.x, (int)blockIdx.x);
    EpiSwiglu E{O, DFF};
    pg8::gemm_phase<EpiSwiglu, pg8::StaticOrder, true, true>((PG8_LAS unsigned char*)lds, g, S, E);
}

DI void phase_prep0(const KParams& p) {
    const int tid_ = tid_fresh(); const int lane = tid_ & 63, wave = tid_ >> 6;
    const int gw = blockIdx.x * NWAVES + wave, NGW = gridDim.x * NWAVES;
    const bf16* Z = (const bf16*)(p.ws + WS_Z);
    bf16* QKVC = (bf16*)p.out;
    float* GB = (float*)(p.ws + WS_GB);
    bf16* QN = (bf16*)(p.ws + WS_QN); bf16* KVN = (bf16*)(p.ws + WS_KVN); bf16* KPE = (bf16*)(p.ws + WS_KPE);
    const float* convw = p.in[15];
    const int rows_per_wave = (MT + NGW - 1) / NGW;
#pragma unroll 1
    for (int i = 0; i < 3; ++i) {
        float cw[5][8];
#pragma unroll
        for (int j = 0; j < 5; ++j)
#pragma unroll
            for (int e = 0; e < 8; ++e) cw[j][e] = convw[j * 1536 + 8 * (lane + 64 * i) + e];
        u32x4 wv[5], wn[3];
        for (int ri = 0; ri < rows_per_wave; ++ri) {
            const int m = gw * rows_per_wave + ri;
            if (m >= MT) break;
            int base, L, t;
            if (m < ML) { base = m & ~4095; L = 4096; t = m & 4095; } else { base = ML + ((m - ML) & ~255); L = 256; t = (m - ML) & 255; }
            const bf16* zc = Z + ZQKV + 8 * (lane + 64 * i);
            auto ldrow = [&](int pos) -> u32x4 { pos = pos < 0 ? 0 : (pos > L - 1 ? L - 1 : pos); return *(const u32x4*)(zc + (size_t)(base + pos) * NZ0); };
            if (ri == 0 || t == 0) {
#pragma unroll
                for (int j = 0; j < 5; ++j) wv[j] = ldrow(t + j - 2);
                wn[0] = ldrow(t + 3); wn[1] = ldrow(t + 4); wn[2] = ldrow(t + 5);
            } else {
#pragma unroll
                for (int j = 0; j < 4; ++j) wv[j] = wv[j + 1];
                wv[4] = wn[0]; wn[0] = wn[1]; wn[1] = wn[2];
                wn[2] = ldrow(t + 5);
            }
            float acc[8];
#pragma unroll
            for (int e = 0; e < 8; ++e) acc[e] = 0.f;
            if (t >= 2 && t < L - 2) {
#pragma unroll
                for (int j = 0; j < 5; ++j) {
                    float f[8]; unpack8(wv[j], f);
#pragma unroll
                    for (int e = 0; e < 8; ++e) acc[e] += cw[j][e] * f[e];
                }
            } else {
#pragma unroll
                for (int j = 0; j < 5; ++j) {
                    const int pos = t + j - 2;
                    const float valid = (pos >= 0 && pos < L) ? 1.f : 0.f;
                    float f[8]; unpack8(wv[j], f);
#pragma unroll
                    for (int e = 0; e < 8; ++e) acc[e] += (cw[j][e] * valid) * f[e];
                }
            }
            float ss = 0.f;
#pragma unroll
            for (int e = 0; e < 8; ++e) { acc[e] = acc[e] * __builtin_amdgcn_rcpf(1.f + __expf(-acc[e])); ss += acc[e] * acc[e]; }
            if (i < 2) {
                ss += __shfl_xor(ss, 1); ss += __shfl_xor(ss, 2); ss += __shfl_xor(ss, 4);
                const float inv = rsqrtf(ss + EPS) * (i == 0 ? 0.125f : 1.f);
#pragma unroll
                for (int e = 0; e < 8; ++e) acc[e] *= inv;
            }
            *(u32x4*)(QKVC + (size_t)m * 1536 + 8 * (lane + 64 * i)) = pack8(acc);
        }
    }
    {
        float nrm[8];
#pragma unroll
        for (int e = 0; e < 8; ++e) nrm[e] = lane < 32 ? p.in[19][8 * lane + e] : (lane < 48 ? p.in[21][8 * (lane - 32) + e] : 0.f);
        const float negA = lane < 16 ? -expf(p.in[16][lane]) : 0.f, dtb = lane < 16 ? p.in[17][lane] : 0.f;
        const int col1 = lane < 32 ? ZQD + 8 * lane : (lane < 48 ? ZKVD + 8 * (lane - 32) : ZKPE + 8 * (lane & 1));
        const int col2 = ZKPE + 16 + 8 * (lane & 1);
        const int colg = lane < 16 ? lane : 0;
        u32x4 d1n, d2n; bf16 zan, zbn;
        auto fetch = [&](int m) { const bf16* zr = Z + (size_t)m * NZ0; d1n = *(const u32x4*)(zr + col1); d2n = *(const u32x4*)(zr + col2); zan = zr[ZA + colg]; zbn = zr[ZBT + colg]; };
        const int mfirst = gw * rows_per_wave;
        if (mfirst < MT) fetch(mfirst);
        for (int ri = 0; ri < rows_per_wave; ++ri) {
            const int m = mfirst + ri;
            if (m >= MT) break;
            const int t = m < ML ? (m & 4095) : ((m - ML) & 255);
            const u32x4 d1 = d1n, d2 = d2n; const bf16 za = zan, zb = zbn;
            if (ri + 1 < rows_per_wave && m + 1 < MT) fetch(m + 1);
            if (lane < 16) {
                GB[(size_t)m * 32 + lane] = negA * softplus_f(bf2f(za) + dtb);
                GB[(size_t)m * 32 + 16 + lane] = __builtin_amdgcn_rcpf(1.f + __expf(-bf2f(zb)));
            }
            float f[8]; unpack8(d1, f);
            float ss = 0.f;
#pragma unroll
            for (int e = 0; e < 8; ++e) ss += f[e] * f[e];
            const float sq = wave_sum(lane < 32 ? ss : 0.f), skv = wave_sum((lane >= 32 && lane < 48) ? ss : 0.f);
            if (lane < 48) {
                const float r = lane < 32 ? rsqrtf(sq * (1.f / 256.f) + EPS) : rsqrtf(skv * (1.f / 128.f) + EPS);
#pragma unroll
                for (int e = 0; e < 8; ++e) f[e] = f[e] * r * nrm[e];
                if (lane < 32) *(u32x4*)(QN + (size_t)m * 256 + 8 * lane) = pack8(f);
                else *(u32x4*)(KVN + (size_t)m * 128 + 8 * (lane - 32)) = pack8(f);
            } else if (lane < 50) {
                const int hh = lane - 48;
                float x2[8]; unpack8(d2, x2);
                if (m < ML) {
                    const float2* rt = (const float2*)(p.ws + WS_ROPE8) + (hh ? (t & 63) : (t >> 6)) * 8;
#pragma unroll
                    for (int e = 0; e < 8; ++e) {
                        const float2 cssn = rt[e]; const float cs = cssn.x, sn = cssn.y;
                        const float a = f[e], b2 = x2[e];
                        f[e] = a * cs - b2 * sn; x2[e] = b2 * cs + a * sn;
                    }
                }
                *(u32x4*)(KPE + (size_t)m * 32 + 8 * hh) = pack8(f);
                *(u32x4*)(KPE + (size_t)m * 32 + 16 + 8 * hh) = pack8(x2);
            }
        }
    }
}

DI void phase_prep1(const KParams& p) {
    const int tid_ = tid_fresh(); const int lane = tid_ & 63, wave = tid_ >> 6;
    const int gw = blockIdx.x * NWAVES + wave, NGW = gridDim.x * NWAVES;
    const bf16* Z = (const bf16*)(p.ws + WS_Z);
    bf16* GKV = (bf16*)(p.ws + WS_GKV);
    const float* kn = p.in[27];
    const int l32 = lane & 31, l16 = lane & 15, q8 = lane & 7, rsub = lane >> 5;
    const bool isv = l32 >= 16;
    const int fbase = (8 * (q8 & 3)) & 15;
    const bool use_col = (q8 & 3) >= 2;
    float gk[8];
#pragma unroll
    for (int e = 0; e < 8; ++e) gk[e] = kn[8 * q8 + e];
    for (int m0 = 2 * gw; m0 < MT; m0 += 2 * NGW) {
        const int m = m0 + rsub;
        const bool lat = m < ML;
        const int t = m & 4095;
        const u32x4 raw = *(const u32x4*)(Z + (size_t)m * NZ1 + (isv ? Z1_GV : Z1_GK) + 8 * l16);
        float f[8]; unpack8(raw, f);
        float ss = 0.f;
#pragma unroll
        for (int e = 0; e < 8; ++e) ss += f[e] * f[e];
        ss += __shfl_xor(ss, 1); ss += __shfl_xor(ss, 2); ss += __shfl_xor(ss, 4);
        const float r = rsqrtf(ss * (1.f / 64.f) + EPS);
#pragma unroll
        for (int e = 0; e < 8; ++e) f[e] = f[e] * r * gk[e];
        float o[8];
        const float2* rt = (const float2*)(p.ws + WS_ROPE16) + (use_col ? (t & 63) : (t >> 6)) * 16 + fbase;
#pragma unroll
        for (int e = 0; e < 8; ++e) {
            const float other = __shfl_xor(f[e], 4);
            const float2 v = rt[e];
            o[e] = (q8 < 4) ? f[e] * v.x - other * v.y : f[e] * v.x + other * v.y;
        }
        if (lat) {
#pragma unroll
            for (int e = 0; e < 8; ++e) f[e] = o[e];
        }
        *(u32x4*)(GKV + (size_t)m * 256 + 8 * l32) = isv ? raw : pack8(f);
    }
}

DI void gdn_combine_run(const KParams& p, int p0, int np) {
    const int tid_ = tid_fresh(); const int lane = tid_ & 63;
    const bf16* Z = (const bf16*)(p.ws + WS_Z);
    bf16* MIX = (bf16*)(p.ws + WS_U);
    float on[8];
#pragma unroll
    for (int e = 0; e < 8; ++e) on[e] = p.in[18][8 * (lane & 7) + e];
    u32x4 wa[2], wb[2], wg[2], na[2], nb[2], ng[2];
    auto fetch = [&](int m0, u32x4 (&xa)[2], u32x4 (&xb)[2], u32x4 (&xg)[2]) __attribute__((always_inline)) {
#pragma unroll
        for (int r = 0; r < 2; ++r) {
            const int m = m0 + r;
            const bf16* obp = m < OB_SPLIT ? (const bf16*)((const unsigned char*)p.out + OUT_OBLO) + (size_t)m * 512 : (const bf16*)(p.ws + WS_OBHI) + (size_t)(m - OB_SPLIT) * 512;
            xa[r] = *(const u32x4*)(MIX + (size_t)m * DM + 8 * lane);
            xb[r] = *(const u32x4*)(obp + 8 * lane);
            xg[r] = *(const u32x4*)(Z + (size_t)m * NZ0 + ZGATE + 8 * lane);
        }
    };
    if (np > 0) fetch(2 * p0, na, nb, ng);
    for (int i = 0; i < np; ++i) {
        const int m0 = 2 * (p0 + i);
#pragma unroll
        for (int r = 0; r < 2; ++r) { wa[r] = na[r]; wb[r] = nb[r]; wg[r] = ng[r]; }
        if (i + 1 < np) fetch(m0 + 2, na, nb, ng);
#pragma unroll
        for (int r = 0; r < 2; ++r) {
            const int m = m0 + r;
            float a[8], b2[8], g[8];
            unpack8(wa[r], a); unpack8(wb[r], b2); unpack8(wg[r], g);
            float ss = 0.f;
#pragma unroll
            for (int e = 0; e < 8; ++e) { a[e] += b2[e]; ss += a[e] * a[e]; }
            ss += __shfl_xor(ss, 1); ss += __shfl_xor(ss, 2); ss += __shfl_xor(ss, 4);
            const float rr = rsqrtf(ss * (1.f / 64.f) + EPS);
#pragma unroll
            for (int e = 0; e < 8; ++e) a[e] = a[e] * rr * on[e] * (g[e] * __builtin_amdgcn_rcpf(1.f + __expf(-g[e])));
            *(u32x4*)(MIX + (size_t)m * DM + 8 * lane) = pack8(a);
        }
    }
}
DI void phase_gdn_combine(const KParams& p) {
    const int tid_ = tid_fresh(); const int wave = tid_ >> 6;
    int p0, np; wave_pair_range(MT / 2, blockIdx.x * NWAVES + wave, gridDim.x * NWAVES, p0, np);
    gdn_combine_run(p, p0, np);
}

DI int gdn_row(int b, int dir, int ci, int i) {
    if (ci < 4) { int s = 64 * ci + i; if (dir) s = 255 - s; return ML + b * 256 + s; }
    int t = 64 * (ci - 4) + i; if (dir) t = 4095 - t; return b * 4096 + t;
}
DI float wave_incl_scan(float x, int lane) {
#pragma unroll
    for (int off = 1; off < 64; off <<= 1) { const float v = __shfl_up(x, off); if (lane >= off) x += v; }
    return x;
}


constexpr int tinv_segidx(int i, int sg) { return ((i <= 33) ? i : 33 + 2 * (i - 33)) + sg; }
constexpr int tinv_nseg(int i) { return (i > 32) ? 2 : 1; }
template <int I>
DI void tinv_step(float (&acc)[64], const float* Mt) {
    if constexpr (I < 63) {
        typedef float f32x2p __attribute__((ext_vector_type(2)));
        const float ti = acc[I];
        const f32x2p nt2 = {-ti, -ti};
#pragma unroll
        for (int jq = (I + 1) / 4; jq < 16; ++jq) {
            const f32x4 mv = *(const f32x4*)(Mt + I * 64 + 4 * jq);
            const int r0 = 4 * jq;
            if (r0 > I) {
                f32x2p a01 = {acc[r0], acc[r0 + 1]}, a23 = {acc[r0 + 2], acc[r0 + 3]};
                a01 = __builtin_elementwise_fma((f32x2p){mv.x, mv.y}, nt2, a01);
                a23 = __builtin_elementwise_fma((f32x2p){mv.z, mv.w}, nt2, a23);
                acc[r0] = a01.x; acc[r0 + 1] = a01.y; acc[r0 + 2] = a23.x; acc[r0 + 3] = a23.y;
            } else {
                if (r0 + 1 > I) acc[r0 + 1] -= mv.y * ti;
                if (r0 + 2 > I) acc[r0 + 2] -= mv.z * ti;
                if (r0 + 3 > I) acc[r0 + 3] -= mv.w * ti;
            }
        }
        tinv_step<I + 1>(acc, Mt);
    }
}

template <int I>
DI void tinv32_step(float (&acc)[32], const float* blk) {
    if constexpr (I < 31) {
        typedef float f32x2p __attribute__((ext_vector_type(2)));
        const float ti = acc[I];
        const f32x2p nt2 = {-ti, -ti};
#pragma unroll
        for (int jq = (I + 1) / 4; jq < 8; ++jq) {
            const f32x4 mv = *(const f32x4*)(blk + I * 32 + 4 * jq);
            const int r0 = 4 * jq;
            if (r0 > I) {
                f32x2p a01 = {acc[r0], acc[r0 + 1]}, a23 = {acc[r0 + 2], acc[r0 + 3]};
                a01 = __builtin_elementwise_fma((f32x2p){mv.x, mv.y}, nt2, a01);
                a23 = __builtin_elementwise_fma((f32x2p){mv.z, mv.w}, nt2, a23);
                acc[r0] = a01.x; acc[r0 + 1] = a01.y; acc[r0 + 2] = a23.x; acc[r0 + 3] = a23.y;
            } else {
                if (r0 + 1 > I) acc[r0 + 1] -= mv.y * ti;
                if (r0 + 2 > I) acc[r0 + 2] -= mv.z * ti;
                if (r0 + 3 > I) acc[r0 + 3] -= mv.w * ti;
            }
        }
        tinv32_step<I + 1>(acc, blk);
    }
}

DI void phase_tinv(const KParams& p, unsigned char* lds, bool dry = false) {
    const int tid_ = tid_fresh(); const int lane = tid_ & 63, wave = tid_ >> 6, r32 = lane & 31, hi = lane >> 5;
    const int gw = blockIdx.x * NWAVES + wave, NGW = gridDim.x * NWAVES;
    float* Mw = (float*)(lds + wave * 17408);
    float* gcs = Mw + 4096; float* bts = gcs + 64;
    const bf16* QKVC = (const bf16*)p.out;
    const float* GB = (const float*)(p.ws + WS_GB);
    bf16* TINV = (bf16*)(p.ws + WS_TINV);
    unsigned* lctr = (unsigned*)(lds + NWAVES * 17408);
    if (threadIdx.x == 0) *lctr = 0u;
    __syncthreads();
    const int per_wg = (8704 + (int)gridDim.x - 1) / (int)gridDim.x;
    auto grab = [&]() -> int {
        int li = 0;
        if (lane == 0) li = (int)__hip_atomic_fetch_add(lctr, 1u, __ATOMIC_RELAXED, __HIP_MEMORY_SCOPE_WORKGROUP);
        li = __builtin_amdgcn_readfirstlane(li);
        const int inst = (int)blockIdx.x * per_wg + li;
        return (li < per_wg && inst < 8704) ? inst : -1;
    };
    bf16x8 kfN[2][4]; float giN = 0.f, biN = 0.f;
    auto issue = [&](int inst) __attribute__((always_inline)) {
        const int ci = inst % 68, bhd = inst / 68, dir = bhd & 1, h = (bhd >> 1) & 7, b = bhd >> 4;
        const int mi = gdn_row(b, dir, ci, lane);
        giN = GB[(size_t)mi * 32 + dir * 8 + h]; biN = GB[(size_t)mi * 32 + 16 + dir * 8 + h];
#pragma unroll
        for (int a = 0; a < 2; ++a) {
            const int mt = gdn_row(b, dir, ci, 32 * a + r32);
#pragma unroll
            for (int s = 0; s < 4; ++s) kfN[a][s] = *(const bf16x8*)(QKVC + (size_t)mt * 1536 + 512 + h * 64 + 16 * s + 8 * hi);
        }
    };
    int inst = grab();
    if (inst >= 0) issue(inst);
    while (inst >= 0) {
        const int ci = inst % 68, bhd = inst / 68, dir = bhd & 1, h = (bhd >> 1) & 7, b = bhd >> 4;
        const int mi = gdn_row(b, dir, ci, lane);
        const float gi = giN, bi = biN;
        const float gc = wave_incl_scan(gi, lane);
        gcs[lane] = gc; bts[lane] = bi;
        if (!dry) ((float*)(p.ws + WS_GB))[(size_t)mi * 32 + dir * 8 + h] = gc;
        bf16x8 kf[2][4];
#pragma unroll
        for (int a = 0; a < 2; ++a)
#pragma unroll
            for (int s = 0; s < 4; ++s) kf[a][s] = kfN[a][s];
        f32x16 g00, g10, g11;
#pragma unroll
        for (int r = 0; r < 16; ++r) { g00[r] = 0.f; g10[r] = 0.f; g11[r] = 0.f; }
#pragma unroll
        for (int s = 0; s < 4; ++s) {
            g00 = __builtin_amdgcn_mfma_f32_32x32x16_bf16(kf[0][s], kf[0][s], g00, 0, 0, 0);
            g10 = __builtin_amdgcn_mfma_f32_32x32x16_bf16(kf[0][s], kf[1][s], g10, 0, 0, 0);
            g11 = __builtin_amdgcn_mfma_f32_32x32x16_bf16(kf[1][s], kf[1][s], g11, 0, 0, 0);
        }
        const int inst_next = grab();
        if (inst_next >= 0) issue(inst_next);
        asm volatile("s_waitcnt lgkmcnt(0)" ::: "memory");
        float* blk11 = Mw; float* blk22 = Mw + 1024;
        unsigned char* m21img = (unsigned char*)(Mw + 2048);
        unsigned char* t11img = m21img + 2560;
        {
            const int i0 = r32, i1 = 32 + r32;
            const float b0 = bts[i0], b1 = bts[i1], gc0 = gcs[i0], gc1 = gcs[i1];
#pragma unroll
            for (int r = 0; r < 16; ++r) {
                const int j0 = crow(r, hi), j1 = 32 + j0;
                blk11[j0 * 32 + r32] = (i0 > j0) ? b0 * g00[r] * __expf(gc0 - gcs[j0]) : 0.f;
                blk22[j0 * 32 + r32] = (i1 > j1) ? b1 * g11[r] * __expf(gc1 - gcs[j1]) : 0.f;
                *(bf16*)(m21img + r32 * 80 + j0 * 2) = f2bf(b1 * g10[r] * __expf(gc1 - gcs[j0]));
            }
        }
        asm volatile("s_waitcnt lgkmcnt(0)" ::: "memory");
        float T[32];
#pragma unroll
        for (int r = 0; r < 32; ++r) T[r] = (r32 == r) ? 1.f : 0.f;
        tinv32_step<0>(T, hi ? blk22 : blk11);
        if (hi == 0) {
#pragma unroll
            for (int q = 0; q < 4; ++q) *(u32x4*)(t11img + r32 * 80 + q * 16) = pack8(&T[8 * q]);
        }
        asm volatile("s_waitcnt lgkmcnt(0)" ::: "memory");
        f32x16 X;
#pragma unroll
        for (int r = 0; r < 16; ++r) X[r] = 0.f;
#pragma unroll
        for (int s = 0; s < 2; ++s) {
            const bf16x8 af = *(const bf16x8*)(m21img + r32 * 80 + (16 * s + 8 * hi) * 2);
            const bf16x8 bfr = *(const bf16x8*)(t11img + r32 * 80 + (16 * s + 8 * hi) * 2);
            X = __builtin_amdgcn_mfma_f32_32x32x16_bf16(af, bfr, X, 0, 0, 0);
        }
        bf16* Tb = (bf16*)Mw;
#pragma unroll
        for (int r = 0; r < 32; ++r) Tb[(32 * hi + r) * 64 + 32 * hi + r32] = f2bf(T[r]);
        {
            const u32x4 z4 = {0u, 0u, 0u, 0u};
#pragma unroll
            for (int q = 0; q < 2; ++q) { const int idx = q * 64 + lane; *(u32x4*)(Tb + (idx >> 2) * 64 + 32 + (idx & 3) * 8) = z4; }
        }
        asm volatile("s_waitcnt lgkmcnt(0)" ::: "memory");
        f32x16 Y;
#pragma unroll
        for (int r = 0; r < 16; ++r) Y[r] = 0.f;
#pragma unroll
        for (int s = 0; s < 2; ++s) {
            const bf16* trow = Tb + (32 + r32) * 64 + 32 + 16 * s + 4 * hi;
            const u32x2 a_lo = *(const u32x2*)(trow), a_hi = *(const u32x2*)(trow + 8);
            const u32x4 aw = {a_lo.x, a_lo.y, a_hi.x, a_hi.y};
            const u32x4 bw = {pk2(X[8 * s + 0], X[8 * s + 1]), pk2(X[8 * s + 2], X[8 * s + 3]), pk2(X[8 * s + 4], X[8 * s + 5]), pk2(X[8 * s + 6], X[8 * s + 7])};
            Y = __builtin_amdgcn_mfma_f32_32x32x16_bf16(__builtin_bit_cast(bf16x8, aw), __builtin_bit_cast(bf16x8, bw), Y, 0, 0, 0);
        }
#pragma unroll
        for (int r = 0; r < 16; ++r) Tb[(32 + crow(r, hi)) * 64 + r32] = f2bf(-Y[r]);
        asm volatile("s_waitcnt lgkmcnt(0)" ::: "memory");
#pragma unroll
        for (int q = 0; q < 8; ++q) {
            const u32x4 v = *(const u32x4*)(Tb + (q * 64 + lane) * 8);
            if (!dry) *(u32x4*)(TINV + (size_t)inst * 4096 + (q * 64 + lane) * 8) = v; else asm volatile("" :: "v"(v));
        }
        asm volatile("s_waitcnt lgkmcnt(0)" ::: "memory");
        inst = inst_next;
    }
}

constexpr int GP = 144;
constexpr int GIMG = 64 * GP;
constexpr int G_CB = 5 * GIMG;
constexpr int G_QK = 0, G_KDT = GIMG, G_T = 2 * GIMG, G_KBGT = 3 * GIMG, G_VBT = 4 * GIMG;
constexpr int G_Q = 2 * G_CB;
constexpr int G_K = G_Q + GIMG;
constexpr int G_ARR = G_K + GIMG;
static_assert(G_ARR + 2 * 1024 <= LDS_BYTES - 64, "GDN scan LDS map");

#define LDS_BAR() do { asm volatile("s_waitcnt lgkmcnt(0)" ::: "memory"); __builtin_amdgcn_s_barrier(); asm volatile("" ::: "memory"); } while (0)
DI bf16x8 ldsfrag(const unsigned char* base, int row, int colbyte) { return *(const bf16x8*)(base + row * GP + colbyte); }
typedef short gv4i16_t __attribute__((ext_vector_type(4)));
DI bf16x8 trfrag(const unsigned char* img, int k0, int k1, int n0, int l15) {
    const int q = l15 >> 2, pp = l15 & 3;
    const unsigned char* a = img + (k0 + q) * GP + (n0 + 4 * pp) * 2;
    const unsigned char* b2 = img + (k1 + q) * GP + (n0 + 4 * pp) * 2;
    const s16x4 lo = __builtin_bit_cast(s16x4, __builtin_amdgcn_ds_read_tr16_b64_v4i16((__attribute__((address_space(3))) gv4i16_t*)a));
    const s16x4 hi4 = __builtin_bit_cast(s16x4, __builtin_amdgcn_ds_read_tr16_b64_v4i16((__attribute__((address_space(3))) gv4i16_t*)b2));
    const bf16x8 r = {lo[0], lo[1], lo[2], lo[3], hi4[0], hi4[1], hi4[2], hi4[3]};
    return r;
}
DI bf16x8 ldsfrag_perm(const unsigned char* base, int row, int c0) {
    const u32x2 a = *(const u32x2*)(base + row * GP + c0 * 2), b2 = *(const u32x2*)(base + row * GP + (c0 + 16) * 2);
    const u32x4 w = {a.x, a.y, b2.x, b2.y};
    return __builtin_bit_cast(bf16x8, w);
}
typedef float f32x4v __attribute__((ext_vector_type(4)));
DI bf16x8 pack_b(const f32x4v& lo, const f32x4v& hi4) {
    const u32x4 w = {pk2(lo[0], lo[1]), pk2(lo[2], lo[3]), pk2(hi4[0], hi4[1]), pk2(hi4[2], hi4[3])};
    return __builtin_bit_cast(bf16x8, w);
}

#ifdef SCAN_PROBE_A
#define SCAN_REP_A(x) do { asm volatile("" ::: "memory"); x; } while (0)
#else
#define SCAN_REP_A(x) do { } while (0)
#endif
#ifdef SCAN_PROBE_B
#define SCAN_REP_B(x) do { asm volatile("" ::: "memory"); x; } while (0)
#else
#define SCAN_REP_B(x) do { } while (0)
#endif
DI void gdn_scan_unit(const KParams& p, int b, int h, int dir, unsigned char* lds) {
    const int tid = tid_fresh(), lane = tid & 63, wid = tid >> 6, l15 = lane & 15, lq = lane >> 4;
    const bf16* QKVC = (const bf16*)p.out;
    const float* GB = (const float*)(p.ws + WS_GB);
    const bf16* TINV = (const bf16*)(p.ws + WS_TINV);
    const size_t inst0 = (size_t)((b * 8 + h) * 2 + dir) * 68;
    __syncthreads();
    if (wid >= 4) {
        const int ptid = tid - 256, pw = wid - 4;
        struct PF { u32x4 rq[2], rk[2], rv[2], rt[2]; float rg, rb; };
        PF RA, RB;
        auto prefetch = [&](int ci, PF& R) __attribute__((always_inline)) {
#pragma unroll
            for (int e = 0; e < 2; ++e) {
                const int pi = ptid + 256 * e, sj = pi >> 3, sp = pi & 7;
                const int mj = gdn_row(b, dir, ci, sj);
                const bf16* src = QKVC + (size_t)mj * 1536 + h * 64 + 8 * sp;
                R.rq[e] = *(const u32x4*)(src); R.rk[e] = *(const u32x4*)(src + 512); R.rv[e] = *(const u32x4*)(src + 1024);
                R.rt[e] = *(const u32x4*)(TINV + (inst0 + ci) * 4096 + sj * 64 + 8 * sp);
            }
            const int mi = gdn_row(b, dir, ci, lane);
            R.rg = GB[(size_t)mi * 32 + dir * 8 + h]; R.rb = GB[(size_t)mi * 32 + 16 + dir * 8 + h];
        };
        auto stage = [&](int ci, const PF& R) __attribute__((always_inline)) {
            unsigned char* cb = lds + (ci & 1) * G_CB;
            float* gcA = (float*)(lds + G_ARR + (ci & 1) * 1024); float* btA = gcA + 64; float* egA = btA + 64;
            const float gsc = R.rg;
            const float gcl = __shfl(gsc, 63);
#pragma unroll
            for (int e = 0; e < 2; ++e) {
                const int pi = ptid + 256 * e, sj = pi >> 3, sp = pi & 7;
                const float gcj = __shfl(gsc, sj), btj = __shfl(R.rb, sj);
                *(u32x4*)(lds + G_Q + sj * GP + sp * 16) = R.rq[e];
                *(u32x4*)(lds + G_K + sj * GP + sp * 16) = R.rk[e];
                *(u32x4*)(cb + G_T + sj * GP + sp * 16) = R.rt[e];
                float kf8[8], vf8[8], kb8[8], kd8[8]; unpack8(R.rk[e], kf8); unpack8(R.rv[e], vf8);
                const float ekb = btj * __expf(gcj), ekd = __expf(gcl - gcj);
#pragma unroll
                for (int x = 0; x < 8; ++x) { kb8[x] = -(kf8[x] * ekb); kd8[x] = kf8[x] * ekd; vf8[x] *= btj; }
                *(u32x4*)(cb + G_KBGT + sj * GP + sp * 16) = pack8(kb8);
                *(u32x4*)(cb + G_KDT + sj * GP + sp * 16) = pack8(kd8);
                *(u32x4*)(cb + G_VBT + sj * GP + sp * 16) = pack8(vf8);
            }
            if (pw == 0) { gcA[lane] = gsc; btA[lane] = R.rb; egA[lane] = __expf(gsc); }
        };
        auto mma_step = [&](int ci) {
            unsigned char* cb = lds + (ci & 1) * G_CB;
            const float* gcA = (const float*)(lds + G_ARR + (ci & 1) * 1024);
            const int mt = pw;
            const bf16x8 qb0 = ldsfrag(lds + G_Q, 16 * mt + l15, 16 * lq), qb1 = ldsfrag(lds + G_Q, 16 * mt + l15, 64 + 16 * lq);
            const int icol = 16 * mt + l15;
            const float gci = gcA[icol];
#pragma unroll
            for (int nt = 0; nt < 4; ++nt) {
                f32x4v acc = {0.f, 0.f, 0.f, 0.f};
                if (nt <= mt) {
                    const bf16x8 a0 = ldsfrag(lds + G_K, 16 * nt + l15, 16 * lq), a1 = ldsfrag(lds + G_K, 16 * nt + l15, 64 + 16 * lq);
                    acc = __builtin_amdgcn_mfma_f32_16x16x32_bf16(a0, qb0, acc, 0, 0, 0);
                    acc = __builtin_amdgcn_mfma_f32_16x16x32_bf16(a1, qb1, acc, 0, 0, 0);
                }
                float v[4];
#pragma unroll
                for (int r = 0; r < 4; ++r) { const int j = 16 * nt + 4 * lq + r; v[r] = (icol >= j) ? acc[r] * __expf(gci - gcA[j]) : 0.f; }
                u32x2 w; w.x = pk2(v[0], v[1]); w.y = pk2(v[2], v[3]);
                *(u32x2*)(cb + G_QK + icol * GP + (16 * nt + 4 * lq) * 2) = w;
            }
        };
        prefetch(0, RA); prefetch(1, RB);
        stage(0, RA);
        prefetch(2, RA);
        LDS_BAR();
        mma_step(0);
        LDS_BAR();
        for (int k = 0; k < 68; k += 2) {
            stage(k + 1, RB); SCAN_REP_A(stage(k + 1, RB)); if (k + 3 < 68) prefetch(k + 3, RB);
            LDS_BAR();
            mma_step(k + 1); SCAN_REP_B(mma_step(k + 1));
            LDS_BAR();
            if (k + 2 < 68) { stage(k + 2, RA); SCAN_REP_A(stage(k + 2, RA)); if (k + 4 < 68) prefetch(k + 4, RA); }
            LDS_BAR();
            if (k + 2 < 68) { mma_step(k + 2); SCAN_REP_B(mma_step(k + 2)); }
            LDS_BAR();
        }
    } else {
        f32x4v sacc[4];
#pragma unroll
        for (int mt = 0; mt < 4; ++mt) sacc[mt] = (f32x4v){0.f, 0.f, 0.f, 0.f};
        const int rstep = dir ? -1 : 1;
        bf16x8 qfr[4][2];
        auto load_q = [&]() {
#pragma unroll
            for (int mt = 0; mt < 4; ++mt)
#pragma unroll
                for (int ks = 0; ks < 2; ++ks) qfr[mt][ks] = ldsfrag_perm(lds + G_Q, 16 * mt + l15, 32 * ks + 4 * lq);
        };
        LDS_BAR();
        LDS_BAR();
        load_q();
        for (int k = 0; k < 68; ++k) {
            const unsigned char* cb = lds + (k & 1) * G_CB;
            const float* gcA = (const float*)(lds + G_ARR + (k & 1) * 1024); const float* egA = gcA + 128;
            const float gl = __expf(gcA[63]);
            const bf16x8 sb0 = pack_b(sacc[0], sacc[1]), sb1 = pack_b(sacc[2], sacc[3]);
            f32x4v rr[4], vn[4];
#pragma unroll
            for (int mt = 0; mt < 4; ++mt) {
                const int q = l15 >> 2, pp = l15 & 3;
                const s16x4 vw = __builtin_bit_cast(s16x4, __builtin_amdgcn_ds_read_tr16_b64_v4i16((__attribute__((address_space(3))) gv4i16_t*)(cb + G_VBT + (16 * mt + 4 * lq + q) * GP + (16 * wid + 4 * pp) * 2)));
                f32x4v acc = {bf2f((bf16)vw[0]), bf2f((bf16)vw[1]), bf2f((bf16)vw[2]), bf2f((bf16)vw[3])};
                acc = __builtin_amdgcn_mfma_f32_16x16x32_bf16(ldsfrag_perm(cb + G_KBGT, 16 * mt + l15, 4 * lq), sb0, acc, 0, 0, 0);
                acc = __builtin_amdgcn_mfma_f32_16x16x32_bf16(ldsfrag_perm(cb + G_KBGT, 16 * mt + l15, 32 + 4 * lq), sb1, acc, 0, 0, 0);
                rr[mt] = acc;
            }
            const bf16x8 rb0 = pack_b(rr[0], rr[1]), rb1 = pack_b(rr[2], rr[3]);
#pragma unroll
            for (int mt = 0; mt < 4; ++mt) {
                f32x4v acc = {0.f, 0.f, 0.f, 0.f};
                acc = __builtin_amdgcn_mfma_f32_16x16x32_bf16(ldsfrag_perm(cb + G_T, 16 * mt + l15, 4 * lq), rb0, acc, 0, 0, 0);
                acc = __builtin_amdgcn_mfma_f32_16x16x32_bf16(ldsfrag_perm(cb + G_T, 16 * mt + l15, 32 + 4 * lq), rb1, acc, 0, 0, 0);
                vn[mt] = acc;
            }
            const bf16x8 vb0 = pack_b(vn[0], vn[1]), vb1 = pack_b(vn[2], vn[3]);
#pragma unroll
            for (int mt = 0; mt < 4; ++mt) {
                f32x4v sn = sacc[mt] * gl;
                sn = __builtin_amdgcn_mfma_f32_16x16x32_bf16(trfrag(cb + G_KDT, 4 * lq, 16 + 4 * lq, 16 * mt, l15), vb0, sn, 0, 0, 0);
                sn = __builtin_amdgcn_mfma_f32_16x16x32_bf16(trfrag(cb + G_KDT, 32 + 4 * lq, 48 + 4 * lq, 16 * mt, l15), vb1, sn, 0, 0, 0);
                sacc[mt] = sn;
            }
            f32x4v oo[4];
#pragma unroll
            for (int mt = 0; mt < 4; ++mt) {
                f32x4v o = {0.f, 0.f, 0.f, 0.f};
                o = __builtin_amdgcn_mfma_f32_16x16x32_bf16(qfr[mt][0], sb0, o, 0, 0, 0);
                o = __builtin_amdgcn_mfma_f32_16x16x32_bf16(qfr[mt][1], sb1, o, 0, 0, 0);
#pragma unroll
                for (int r = 0; r < 4; ++r) o[r] *= egA[16 * mt + 4 * lq + r];
                o = __builtin_amdgcn_mfma_f32_16x16x32_bf16(ldsfrag_perm(cb + G_QK, 16 * mt + l15, 4 * lq), vb0, o, 0, 0, 0);
                o = __builtin_amdgcn_mfma_f32_16x16x32_bf16(ldsfrag_perm(cb + G_QK, 16 * mt + l15, 32 + 4 * lq), vb1, o, 0, 0, 0);
                oo[mt] = o;
            }
            LDS_BAR();
            if (k + 1 < 68) load_q();
            {
                const int m0 = gdn_row(b, dir, k, 0);
                bf16* ob; long pitch;
                if (dir == 0) { ob = (bf16*)(p.ws + WS_U) + (long)m0 * 1024; pitch = 1024; }
                else if (m0 < OB_SPLIT) { ob = (bf16*)((unsigned char*)p.out + OUT_OBLO) + (long)m0 * 512; pitch = 512; }
                else { ob = (bf16*)(p.ws + WS_OBHI) + (long)(m0 - OB_SPLIT) * 512; pitch = 512; }
                bf16* op = ob + (long)rstep * (4 * lq) * pitch + h * 64 + 16 * wid + l15;
                const long rsp = (long)rstep * pitch;
#pragma unroll
                for (int mt = 0; mt < 4; ++mt)
#pragma unroll
                    for (int r = 0; r < 4; ++r) op[rsp * (16 * mt + r)] = f2bf(oo[mt][r]);
#ifdef SCAN_PROBE_D
                asm volatile("" ::: "memory");
#pragma unroll
                for (int mt = 0; mt < 4; ++mt)
#pragma unroll
                    for (int r = 0; r < 4; ++r) op[rsp * (16 * mt + r)] = f2bf(oo[mt][r]);
#endif
            }
            LDS_BAR();
        }
    }
}


template <int MODE> struct AttnCfg { static constexpr int DQK = (MODE <= 1) ? 96 : 64; };
typedef short v4i16_t __attribute__((ext_vector_type(4)));
DI s16x4 lds_tr16(const unsigned char* p) { return __builtin_bit_cast(s16x4, __builtin_amdgcn_ds_read_tr16_b64_v4i16((__attribute__((address_space(3))) v4i16_t*)p)); }
DI float fmax3(float a, float b, float c) { return __builtin_fmaxf(__builtin_fmaxf(a, b), c); }
#ifndef ATT_THR_VAL
#define ATT_THR_VAL 8.f
#endif
constexpr float ATT_THR = ATT_THR_VAL;

template <int MODE>
DI void attn_unit(const KParams& p, int b, int h, int qb, unsigned char* lds) {
    constexpr int DQK = AttnCfg<MODE>::DQK, NS = DQK / 16;
    constexpr int KP = DQK * 2 + 16;
    constexpr int VP = 64 * 2 + 16;
    constexpr int KBUF = 64 * KP, VBUF = 64 * VP, BUF = KBUF + VBUF;
    constexpr int KCH = DQK / 8;
    const int tid = tid_fresh(), lane = tid & 63, wid = tid >> 6, r32 = lane & 31, hi = lane >> 5;
    float* rpbL = (float*)(lds + 3 * BUF);

    int mq;
    int qr = 0, qc = 0;
    if (MODE == 0 || MODE == 2) mq = b * 4096 + qb * 256 + wid * 32 + r32;
    else if (MODE == 1) mq = ML + b * 256 + wid * 32 + r32;
    else { qr = 4 * qb + (wid >> 1); qc = 32 * (wid & 1) + r32; mq = b * 4096 + qr * 64 + qc; }
    const bf16* Qp; float sl2;
    if (MODE <= 1) { Qp = (const bf16*)(p.ws + WS_QMLA) + (size_t)mq * 768 + h * 96; sl2 = 0.10206207261596577f * LOG2E; }
    else if (MODE == 2) { Qp = (const bf16*)(p.ws + WS_Z) + (size_t)mq * NZ1 + Z1_GQ + h * 64; sl2 = 0.125f * LOG2E; }
    else { Qp = (const bf16*)(p.ws + WS_Z) + (size_t)mq * NZ1 + Z1_NAQ + h * 64; sl2 = 0.125f * LOG2E; }
    u32x4 qraw[NS];
#pragma unroll
    for (int s = 0; s < NS; ++s) qraw[s] = *(const u32x4*)(Qp + 16 * s + 8 * hi);
    bf16x8 qf[NS];
    int NT, kr_lo = 0;
    if (MODE == 0 || MODE == 2) NT = 68; else if (MODE == 1) NT = 4;
    else { kr_lo = 4 * qb - 4; if (kr_lo < 0) kr_lo = 0; int last = 4 * qb - 1; if (last < 0) last = 0; if (last > 56) last = 56; NT = 4 + (last + 7 - kr_lo + 1); }
    int rs = 0, cs0 = 0;
    if (MODE == 3) {
        rs = qr - 4; if (rs < 0) rs = 0; if (rs > 56) rs = 56;
        cs0 = qc - 8; if (cs0 < 0) cs0 = 0; if (cs0 > 48) cs0 = 48;
        for (int i = tid; i < 15 * 31; i += NTHREADS) rpbL[i] = p.in[25][h * 465 + i] * LOG2E;
    }
    unsigned cmask = 0u; const float* rpbB = rpbL;
    if (MODE == 3) {
#pragma unroll
        for (int r = 0; r < 16; ++r) {
            const int kc0 = crow(r, hi), kc1 = 32 + kc0;
            if (kc0 >= cs0 && kc0 <= cs0 + 15) cmask |= 1u << r;
            if (kc1 >= cs0 && kc1 <= cs0 + 15) cmask |= 1u << (16 + r);
        }
        rpbB = rpbL + (4 * hi - qc + 15);
    }
    const int kkey0 = tid / KCH, kpart0 = tid % KCH;
    const int kkey1 = (tid + 512) / KCH, kpart1 = (tid + 512) % KCH;
    const bool k1act = (KCH == 12) && (tid + 512 < 64 * KCH);
    const int vkey = tid >> 3, vpart = tid & 7;
    auto keyrow = [&](int t, int i) -> int {
        if (t < 4) return ML + b * 256 + 64 * t + i;
        if (MODE == 3) return b * 4096 + (kr_lo + t - 4) * 64 + i;
        return b * 4096 + 64 * (t - 4) + i;
    };
    auto kchunk = [&](int row, int part) -> u32x4 {
        if (MODE <= 1) {
            if (part < 8) return *(const u32x4*)((const bf16*)(p.ws + WS_KVMLA) + (size_t)row * 1024 + h * 128 + 8 * part);
            return *(const u32x4*)((const bf16*)(p.ws + WS_KPE) + (size_t)row * 32 + 8 * (part - 8));
        } else if (MODE == 2) return *(const u32x4*)((const bf16*)(p.ws + WS_GKV) + (size_t)row * 256 + (h >> 2) * 64 + 8 * part);
        else return *(const u32x4*)((const bf16*)(p.ws + WS_Z) + (size_t)row * NZ1 + Z1_NAK + h * 64 + 8 * part);
    };
    auto vchunk = [&](int row, int part) -> u32x4 {
        if (MODE <= 1) return *(const u32x4*)((const bf16*)(p.ws + WS_KVMLA) + (size_t)row * 1024 + h * 128 + 64 + 8 * part);
        else if (MODE == 2) return *(const u32x4*)((const bf16*)(p.ws + WS_GKV) + (size_t)row * 256 + 128 + (h >> 2) * 64 + 8 * part);
        else return *(const u32x4*)((const bf16*)(p.ws + WS_Z) + (size_t)row * NZ1 + Z1_NAV + h * 64 + 8 * part);
    };
    u32x4 rk0, rk1 = {0u, 0u, 0u, 0u}, rv;
    auto load_tile = [&](int t) {
        rk0 = kchunk(keyrow(t, kkey0), kpart0);
        if (k1act) rk1 = kchunk(keyrow(t, kkey1), kpart1);
        rv = vchunk(keyrow(t, vkey), vpart);
    };
    auto write_tile = [&](int buf) {
        unsigned char* kb = lds + buf * BUF; unsigned char* vb = kb + KBUF;
        *(u32x4*)(kb + kkey0 * KP + kpart0 * 16) = rk0;
        if (k1act) *(u32x4*)(kb + kkey1 * KP + kpart1 * 16) = rk1;
        *(u32x4*)(vb + vkey * VP + vpart * 16) = rv;
    };
    const int vtr_base = (4 * hi + ((lane & 15) >> 2)) * VP + (16 * ((lane >> 4) & 1) + 4 * (lane & 3)) * 2;
    f32x16 o0, o1, ol, negm;
#pragma unroll
    for (int r = 0; r < 16; ++r) { o0[r] = 0.f; o1[r] = 0.f; ol[r] = 0.f; negm[r] = 0.f; }
    asm volatile("" : "+v"(negm));
    const bf16x8 ones = {(short)0x3F80, (short)0x3F80, (short)0x3F80, (short)0x3F80, (short)0x3F80, (short)0x3F80, (short)0x3F80, (short)0x3F80};
    float m_run = 0.f;
    auto tile_active = [&](int t) -> bool { if (MODE != 3 || t < 4) return true; const int kr = kr_lo + t - 4; return (kr >= rs) && (kr <= rs + 7); };
    auto qk_tile = [&](int slot, f32x16& s0, f32x16& s1) __attribute__((always_inline)) {
        const unsigned char* kb = lds + slot * BUF;
#pragma unroll
        for (int s = 0; s < NS; ++s) {
            const bf16x8 k0 = *(const bf16x8*)(kb + r32 * KP + (16 * s + 8 * hi) * 2);
            const bf16x8 k1 = *(const bf16x8*)(kb + (32 + r32) * KP + (16 * s + 8 * hi) * 2);
            s0 = __builtin_amdgcn_mfma_f32_32x32x16_bf16(k0, qf[s], s == 0 ? negm : s0, 0, 0, 0);
            s1 = __builtin_amdgcn_mfma_f32_32x32x16_bf16(k1, qf[s], s == 0 ? negm : s1, 0, 0, 0);
        }
    };
    int slot = 0;
    auto step = [&](const bool first, int t, f32x16& c0, f32x16& c1, f32x16& n0, f32x16& n1) __attribute__((always_inline)) {
        const int slot1 = (slot == 2) ? 0 : slot + 1, slot2 = (slot1 == 2) ? 0 : slot1 + 1;
        if (t + 2 < NT) load_tile(t + 2);
        const bool act_n = (t + 1 < NT) && tile_active(t + 1);
        if (act_n) qk_tile(slot1, n0, n1);
        if (tile_active(t)) {
            const unsigned char* vb = lds + slot * BUF + KBUF;
            if (MODE == 3 && t >= 4) {
                const int kr = kr_lo + t - 4;
                const float* bp = rpbB + (kr - qr + 7) * 31;
#pragma unroll
                for (int r = 0; r < 16; ++r) {
                    const float b0 = bp[(r & 3) + 8 * (r >> 2)], b1 = bp[32 + (r & 3) + 8 * (r >> 2)];
                    c0[r] = ((cmask >> r) & 1u) ? c0[r] + b0 : -INFINITY;
                    c1[r] = ((cmask >> (16 + r)) & 1u) ? c1[r] + b1 : -INFINITY;
                }
            }
            float mloc;
            {
                float a = fmax3(c0[0], c0[1], c1[0]), c2 = fmax3(c0[2], c0[3], c1[1]);
                a = fmax3(a, c1[2], c1[3]);
#pragma unroll
                for (int r = 4; r < 16; r += 4) { a = fmax3(a, c0[r], c0[r + 1]); c2 = fmax3(c2, c0[r + 2], c0[r + 3]); a = fmax3(a, c1[r], c1[r + 1]); c2 = fmax3(c2, c1[r + 2], c1[r + 3]); }
                mloc = __builtin_fmaxf(a, c2);
                auto rr = __builtin_amdgcn_permlane32_swap(__float_as_uint(mloc), __float_as_uint(mloc), false, false);
                mloc = __builtin_fmaxf(__uint_as_float(rr[0]), __uint_as_float(rr[1]));
            }
            if (first || __builtin_expect(__any(mloc > ATT_THR), 0)) {
                float dl = first ? mloc : __builtin_fmaxf(mloc, 0.f);
                asm volatile("" : "+v"(dl));
                m_run += dl;
#pragma unroll
                for (int r = 0; r < 16; ++r) { c0[r] -= dl; c1[r] -= dl; negm[r] = -m_run; }
                asm volatile("" : "+v"(negm));
                if (act_n) {
#pragma unroll
                    for (int r = 0; r < 16; ++r) { n0[r] -= dl; n1[r] -= dl; }
                }
                if (!first) {
                    const float alpha = __builtin_amdgcn_exp2f(-dl);
#pragma unroll
                    for (int r = 0; r < 16; ++r) { o0[r] *= alpha; o1[r] *= alpha; ol[r] *= alpha; }
                }
            }
#pragma unroll
            for (int r = 0; r < 16; ++r) { c0[r] = __builtin_amdgcn_exp2f(c0[r]); c1[r] = __builtin_amdgcn_exp2f(c1[r]); }
#pragma unroll
            for (int kt = 0; kt < 2; ++kt)
#pragma unroll
                for (int s = 0; s < 2; ++s) {
                    const f32x16& pp = kt ? c1 : c0;
                    u32x4 pw;
                    pw.x = pk2(pp[8 * s + 0], pp[8 * s + 1]); pw.y = pk2(pp[8 * s + 2], pp[8 * s + 3]);
                    pw.z = pk2(pp[8 * s + 4], pp[8 * s + 5]); pw.w = pk2(pp[8 * s + 6], pp[8 * s + 7]);
                    const bf16x8 pf = __builtin_bit_cast(bf16x8, pw);
                    const unsigned char* vp = vb + vtr_base + (32 * kt + 16 * s) * VP;
                    const s16x4 a0 = lds_tr16(vp), a1 = lds_tr16(vp + 8 * VP);
                    const s16x4 e0 = lds_tr16(vp + 64), e1 = lds_tr16(vp + 8 * VP + 64);
                    const bf16x8 va = {a0[0], a0[1], a0[2], a0[3], a1[0], a1[1], a1[2], a1[3]};
                    const bf16x8 vc = {e0[0], e0[1], e0[2], e0[3], e1[0], e1[1], e1[2], e1[3]};
                    o0 = __builtin_amdgcn_mfma_f32_32x32x16_bf16(va, pf, o0, 0, 0, 0);
                    o1 = __builtin_amdgcn_mfma_f32_32x32x16_bf16(vc, pf, o1, 0, 0, 0);
                    ol = __builtin_amdgcn_mfma_f32_32x32x16_bf16(ones, pf, ol, 0, 0, 0);
                }
        }
#ifdef ATT_SGB
#pragma unroll
        for (int i = 0; i < 2 * NS + 12; ++i) {
            __builtin_amdgcn_sched_group_barrier(0x8, 1, 0);
            __builtin_amdgcn_sched_group_barrier(0x100, 1, 0);
            __builtin_amdgcn_sched_group_barrier(0x2, ATT_SGB, 0);
        }
#endif
        if (t + 2 < NT) write_tile(slot2);
        slot = slot1;
        __syncthreads();
    };

    load_tile(0);
    const u32x4 t0a = rk0, t0b = rk1, t0c = rv;
    load_tile(1);
    const u32x4 t1a = rk0, t1b = rk1, t1c = rv;
    {
        float qx[NS][8];
#pragma unroll
        for (int s = 0; s < NS; ++s) unpack8(qraw[s], qx[s]);
        if (MODE == 0) {
            const int t = mq & 4095; const float2* rt = (const float2*)(p.ws + WS_ROPE8) + (hi ? (t & 63) : (t >> 6)) * 8;
#pragma unroll
            for (int e = 0; e < 8; ++e) { const float2 v = rt[e]; const float cs = v.x, sn = v.y; const float a = qx[4][e], c2 = qx[5][e]; qx[4][e] = a * cs - c2 * sn; qx[5][e] = c2 * cs + a * sn; }
        }
        if (MODE == 2) {
            float ss = 0.f;
#pragma unroll
            for (int s = 0; s < NS; ++s)
#pragma unroll
                for (int e = 0; e < 8; ++e) ss += qx[s][e] * qx[s][e];
            ss += __shfl_xor(ss, 32);
            const float r = rsqrtf(ss * (1.f / 64.f) + EPS);
            const float* qn = p.in[26];
#pragma unroll
            for (int s = 0; s < NS; ++s)
#pragma unroll
                for (int e = 0; e < 8; ++e) qx[s][e] *= r * qn[16 * s + 8 * hi + e];
            const int t = mq & 4095;
#pragma unroll
            for (int s = 0; s < 2; ++s) {
                const float2* rt = (const float2*)(p.ws + WS_ROPE16) + (s ? (t & 63) : (t >> 6)) * 16 + 8 * hi;
#pragma unroll
                for (int e = 0; e < 8; ++e) { const float2 v = rt[e]; const float a1 = qx[s][e], a2 = qx[s + 2][e]; qx[s][e] = a1 * v.x - a2 * v.y; qx[s + 2][e] = a2 * v.x + a1 * v.y; }
            }
        }
#pragma unroll
        for (int s = 0; s < NS; ++s) {
#pragma unroll
            for (int e = 0; e < 8; ++e) qx[s][e] *= sl2;
            qf[s] = __builtin_bit_cast(bf16x8, pack8(qx[s]));
        }
    }
    __syncthreads();
    rk0 = t0a; rk1 = t0b; rv = t0c; write_tile(0);
    rk0 = t1a; rk1 = t1b; rv = t1c; write_tile(1);
    __syncthreads();
    f32x16 sA0, sA1, sB0, sB1;
    qk_tile(0, sA0, sA1);
    step(true, 0, sA0, sA1, sB0, sB1);
    int t = 1;
    for (; t + 1 < NT; t += 2) {
        step(false, t, sB0, sB1, sA0, sA1);
        step(false, t + 1, sA0, sA1, sB0, sB1);
    }
    if (t < NT) step(false, t, sB0, sB1, sA0, sA1);
    const float l_run = ol[0];
    const float il = 1.f / l_run;
    bf16* Ob;
    {
        const int mq0 = mq - r32;
        if (MODE == 3) Ob = (bf16*)(p.ws + WS_U) + (size_t)mq0 * DM + h * 64;
        else Ob = (bf16*)(p.ws + WS_U) + (size_t)mq0 * DM + 512 + h * 64;
    }
    unsigned char* stg = lds + 3 * BUF + 2048 + wid * (32 * 144);
#pragma unroll
    for (int g = 0; g < 4; ++g) {
        u32x2 w0, w1;
        w0.x = pk2(o0[4 * g] * il, o0[4 * g + 1] * il); w0.y = pk2(o0[4 * g + 2] * il, o0[4 * g + 3] * il);
        w1.x = pk2(o1[4 * g] * il, o1[4 * g + 1] * il); w1.y = pk2(o1[4 * g + 2] * il, o1[4 * g + 3] * il);
        *(u32x2*)(stg + r32 * 144 + (8 * g + 4 * hi) * 2) = w0;
        *(u32x2*)(stg + r32 * 144 + (32 + 8 * g + 4 * hi) * 2) = w1;
    }
    asm volatile("s_waitcnt lgkmcnt(0)" ::: "memory");
#pragma unroll
    for (int i = 0; i < 4; ++i) {
        const int row = 8 * i + (lane >> 3), ch = lane & 7;
        const u32x4 v = *(const u32x4*)(stg + row * 144 + ch * 16);
        *(u32x4*)(Ob + (size_t)row * DM + ch * 8) = v;
    }
}

template <int MODE> DI void attn_unit3(const KParams& p, int b, int h, int qb, unsigned char* lds);
#ifdef ATT_PIPE3
#define ATTN_FN attn_unit3
#else
#define ATTN_FN attn_unit
#endif
DI void phase_scan_attn0(const KParams& p, unsigned char* lds) {
    unsigned* ctl2 = (unsigned*)(p.ws + WS_CTL2);
    for (int su = blockIdx.x; su < 128; su += gridDim.x) {
        gdn_scan_unit(p, su >> 4, (su >> 1) & 7, su & 1, lds);
#ifndef COMBINE_PHASE
        asm volatile("s_waitcnt vmcnt(0)" ::: "memory"); __syncthreads();
        if (threadIdx.x == 0) { __builtin_amdgcn_fence(__ATOMIC_RELEASE, "agent"); asm volatile("s_waitcnt vmcnt(0)" ::: "memory"); (void)xb_add(ctl2, 1u); }
#endif
    }
    unsigned* qbase = (unsigned*)(p.ws + WS_QCTR);
    volatile int* nxt = (volatile int*)(lds + LDS_BYTES - 128);
    const int x0 = (int)(xb_xcc_id() & 7u);
    int tries = 0;
    for (;;) {
        __syncthreads();
        if (threadIdx.x == 0) {
            int t = tries, li = 0;
            for (; t < 8; ++t) {
                li = (int)__hip_atomic_fetch_add(qbase + 64 * ((x0 + t) & 7), 1u, __ATOMIC_RELAXED, __HIP_MEMORY_SCOPE_AGENT);
                if (li < 136) break;
            }
            nxt[0] = t; nxt[1] = li;
        }
        __syncthreads();
        tries = nxt[0];
        if (tries >= 8) break;
        const int li = nxt[1], x = (x0 + tries) & 7;
        if (li < 128) { const int bh = (li >> 4) * 8 + x, j = li & 15; ATTN_FN<0>(p, bh >> 3, bh & 7, j, lds); }
        else { const int bh = (li - 128) * 8 + x; ATTN_FN<1>(p, bh >> 3, bh & 7, 0, lds); }
    }
#ifndef COMBINE_PHASE
    __syncthreads();
    if (threadIdx.x == 0) {
        unsigned* bar = (unsigned*)(p.ws + WS_CTL);
        XB_SPIN(xb_ld(ctl2) < 128u, bar);
        __builtin_amdgcn_fence(__ATOMIC_ACQUIRE, "agent"); asm volatile("s_waitcnt vmcnt(0)" ::: "memory");
    }
    for (;;) {
        __syncthreads();
        if (threadIdx.x == 0) nxt[0] = (int)__hip_atomic_fetch_add(ctl2 + 64, 1u, __ATOMIC_RELAXED, __HIP_MEMORY_SCOPE_AGENT);
        __syncthreads();
        const int it = nxt[0];
        if (it >= MT / 128) break;
        gdn_combine_run(p, it * 64 + (int)(tid_fresh() >> 6) * 8, 8);
    }
#endif
}
template <int MODE>
DI void attn_unit3(const KParams& p, int b, int h, int qb, unsigned char* lds) {
    static_assert(MODE <= 2, "attn_unit3: MLA / GQA only");
    constexpr int DQK = AttnCfg<MODE>::DQK, NS = DQK / 16;
    constexpr int KP = DQK * 2 + 16, VP = 64 * 2 + 16, KBUF = 64 * KP, VBUF = 64 * VP, BUF = KBUF + VBUF, KCH = DQK / 8;
    const int tid = tid_fresh(), lane = tid & 63, wid = tid >> 6, r32 = lane & 31, hi = lane >> 5;
    int mq;
    if (MODE == 0 || MODE == 2) mq = b * 4096 + qb * 256 + wid * 32 + r32; else mq = ML + b * 256 + wid * 32 + r32;
    const bf16* Qp; float sl2;
    if (MODE <= 1) { Qp = (const bf16*)(p.ws + WS_QMLA) + (size_t)mq * 768 + h * 96; sl2 = 0.10206207261596577f * LOG2E; }
    else { Qp = (const bf16*)(p.ws + WS_Z) + (size_t)mq * NZ1 + Z1_GQ + h * 64; sl2 = 0.125f * LOG2E; }
    u32x4 qraw[NS];
#pragma unroll
    for (int s = 0; s < NS; ++s) qraw[s] = *(const u32x4*)(Qp + 16 * s + 8 * hi);
    bf16x8 qf[NS];
    const int NT = (MODE == 1) ? 4 : 68;
    const int kkey0 = tid / KCH, kpart0 = tid % KCH;
    const int kkey1 = (tid + 512) / KCH, kpart1 = (tid + 512) % KCH;
    const bool k1act = (KCH == 12) && (tid + 512 < 64 * KCH);
    const int vkey = tid >> 3, vpart = tid & 7;
    auto keyrow = [&](int t, int i) -> int { return t < 4 ? ML + b * 256 + 64 * t + i : b * 4096 + 64 * (t - 4) + i; };
    auto kchunk = [&](int row, int part) -> u32x4 {
        if (MODE <= 1) {
            if (part < 8) return *(const u32x4*)((const bf16*)(p.ws + WS_KVMLA) + (size_t)row * 1024 + h * 128 + 8 * part);
            return *(const u32x4*)((const bf16*)(p.ws + WS_KPE) + (size_t)row * 32 + 8 * (part - 8));
        } else return *(const u32x4*)((const bf16*)(p.ws + WS_GKV) + (size_t)row * 256 + (h >> 2) * 64 + 8 * part);
    };
    auto vchunk = [&](int row, int part) -> u32x4 {
        if (MODE <= 1) return *(const u32x4*)((const bf16*)(p.ws + WS_KVMLA) + (size_t)row * 1024 + h * 128 + 64 + 8 * part);
        else return *(const u32x4*)((const bf16*)(p.ws + WS_GKV) + (size_t)row * 256 + 128 + (h >> 2) * 64 + 8 * part);
    };
    u32x4 rk0, rk1 = {0u, 0u, 0u, 0u}, rv;
    auto load_tile = [&](int t) { rk0 = kchunk(keyrow(t, kkey0), kpart0); if (k1act) rk1 = kchunk(keyrow(t, kkey1), kpart1); rv = vchunk(keyrow(t, vkey), vpart); };
    auto write_tile = [&](int sl) {
        unsigned char* kb = lds + sl * BUF; unsigned char* vb = kb + KBUF;
        *(u32x4*)(kb + kkey0 * KP + kpart0 * 16) = rk0;
        if (k1act) *(u32x4*)(kb + kkey1 * KP + kpart1 * 16) = rk1;
        *(u32x4*)(vb + vkey * VP + vpart * 16) = rv;
    };
    const int vtr_base = (4 * hi + ((lane & 15) >> 2)) * VP + (16 * ((lane >> 4) & 1) + 4 * (lane & 3)) * 2;
    f32x16 o0, o1, ol, negm;
    {
        float zf = 0.f; asm volatile("" : "+v"(zf));
#pragma unroll
        for (int r = 0; r < 16; ++r) { o0[r] = zf; o1[r] = zf; ol[r] = zf; negm[r] = zf; }
    }
    asm volatile("" : "+v"(negm));
    const bf16x8 ones = {(short)0x3F80, (short)0x3F80, (short)0x3F80, (short)0x3F80, (short)0x3F80, (short)0x3F80, (short)0x3F80, (short)0x3F80};
    float m_run = 0.f;
    auto qk_tile = [&](int sl, f32x16& s0, f32x16& s1) __attribute__((always_inline)) {
        const unsigned char* kb = lds + sl * BUF;
#pragma unroll
        for (int s = 0; s < NS; ++s) {
            const bf16x8 k0 = *(const bf16x8*)(kb + r32 * KP + (16 * s + 8 * hi) * 2);
            const bf16x8 k1 = *(const bf16x8*)(kb + (32 + r32) * KP + (16 * s + 8 * hi) * 2);
            s0 = __builtin_amdgcn_mfma_f32_32x32x16_bf16(k0, qf[s], s == 0 ? negm : s0, 0, 0, 0);
            s1 = __builtin_amdgcn_mfma_f32_32x32x16_bf16(k1, qf[s], s == 0 ? negm : s1, 0, 0, 0);
        }
    };
    auto pv_tile = [&](int sl, const bf16x8 (&pk)[4]) __attribute__((always_inline)) {
        const unsigned char* vb = lds + sl * BUF + KBUF + vtr_base;
#pragma unroll
        for (int c = 0; c < 4; ++c) {
            const unsigned char* vp = vb + (16 * c) * VP;
            const s16x4 a0 = lds_tr16(vp), a1 = lds_tr16(vp + 8 * VP), e0 = lds_tr16(vp + 64), e1 = lds_tr16(vp + 8 * VP + 64);
            const bf16x8 va = {a0[0], a0[1], a0[2], a0[3], a1[0], a1[1], a1[2], a1[3]};
            const bf16x8 vc = {e0[0], e0[1], e0[2], e0[3], e1[0], e1[1], e1[2], e1[3]};
            o0 = __builtin_amdgcn_mfma_f32_32x32x16_bf16(va, pk[c], o0, 0, 0, 0);
            o1 = __builtin_amdgcn_mfma_f32_32x32x16_bf16(vc, pk[c], o1, 0, 0, 0);
            ol = __builtin_amdgcn_mfma_f32_32x32x16_bf16(ones, pk[c], ol, 0, 0, 0);
        }
    };
    auto step = [&](const bool first, int t, f32x16& c0, f32x16& c1, f32x16& n0, f32x16& n1, const bf16x8 (&pprev)[4], bf16x8 (&pcur)[4]) __attribute__((always_inline)) {
        if (t + 2 < NT) load_tile(t + 2);
        const bool has_n = t + 1 < NT;
        if (has_n) qk_tile((t + 1) & 3, n0, n1);
        if (!first) pv_tile((t - 1) & 3, pprev);
        float mloc;
        {
            float a = fmax3(c0[0], c0[1], c1[0]), c2 = fmax3(c0[2], c0[3], c1[1]);
            a = fmax3(a, c1[2], c1[3]);
#pragma unroll
            for (int r = 4; r < 16; r += 4) { a = fmax3(a, c0[r], c0[r + 1]); c2 = fmax3(c2, c0[r + 2], c0[r + 3]); a = fmax3(a, c1[r], c1[r + 1]); c2 = fmax3(c2, c1[r + 2], c1[r + 3]); }
            mloc = __builtin_fmaxf(a, c2);
            auto rr = __builtin_amdgcn_permlane32_swap(__float_as_uint(mloc), __float_as_uint(mloc), false, false);
            mloc = __builtin_fmaxf(__uint_as_float(rr[0]), __uint_as_float(rr[1]));
        }
        if (first || __builtin_expect(__any(mloc > ATT_THR), 0)) {
            float dl = first ? mloc : __builtin_fmaxf(mloc, 0.f);
            asm volatile("" : "+v"(dl));
            m_run += dl;
#pragma unroll
            for (int r = 0; r < 16; ++r) { c0[r] -= dl; c1[r] -= dl; negm[r] = -m_run; }
            asm volatile("" : "+v"(negm));
            if (has_n) {
#pragma unroll
                for (int r = 0; r < 16; ++r) { n0[r] -= dl; n1[r] -= dl; }
            }
            if (!first) {
                const float alpha = __builtin_amdgcn_exp2f(-dl);
#pragma unroll
                for (int r = 0; r < 16; ++r) { o0[r] *= alpha; o1[r] *= alpha; ol[r] *= alpha; }
            }
        }
#pragma unroll
        for (int r = 0; r < 16; ++r) { c0[r] = __builtin_amdgcn_exp2f(c0[r]); c1[r] = __builtin_amdgcn_exp2f(c1[r]); }
#pragma unroll
        for (int kt = 0; kt < 2; ++kt)
#pragma unroll
            for (int s = 0; s < 2; ++s) {
                const f32x16& pp = kt ? c1 : c0;
                u32x4 pw;
                pw.x = pk2(pp[8 * s + 0], pp[8 * s + 1]); pw.y = pk2(pp[8 * s + 2], pp[8 * s + 3]);
                pw.z = pk2(pp[8 * s + 4], pp[8 * s + 5]); pw.w = pk2(pp[8 * s + 6], pp[8 * s + 7]);
                pcur[2 * kt + s] = __builtin_bit_cast(bf16x8, pw);
            }
        if (t + 2 < NT) write_tile((t + 2) & 3);
        __syncthreads();
    };
    u32x4 t0a = {0u, 0u, 0u, 0u}, t0b = t0a, t0c = t0a, t1a = t0a, t1b = t0a, t1c = t0a;
    if (MODE != 2) { load_tile(0); t0a = rk0; t0b = rk1; t0c = rv; load_tile(1); t1a = rk0; t1b = rk1; t1c = rv; }
    {
        float qx[NS][8];
#pragma unroll
        for (int s = 0; s < NS; ++s) unpack8(qraw[s], qx[s]);
        if (MODE == 0) {
            const int t = mq & 4095; const float2* rt = (const float2*)(p.ws + WS_ROPE8) + (hi ? (t & 63) : (t >> 6)) * 8;
#pragma unroll
            for (int e = 0; e < 8; ++e) { const float2 v = rt[e]; const float cs = v.x, sn = v.y; const float a1 = qx[4][e], c2 = qx[5][e]; qx[4][e] = a1 * cs - c2 * sn; qx[5][e] = c2 * cs + a1 * sn; }
        }
        if (MODE == 2) {
            float ss = 0.f;
#pragma unroll
            for (int s = 0; s < NS; ++s)
#pragma unroll
                for (int e = 0; e < 8; ++e) ss += qx[s][e] * qx[s][e];
            ss += __shfl_xor(ss, 32);
            const float r = rsqrtf(ss * (1.f / 64.f) + EPS);
            const float* qn = p.in[26];
#pragma unroll
            for (int s = 0; s < NS; ++s)
#pragma unroll
                for (int e = 0; e < 8; ++e) qx[s][e] *= r * qn[16 * s + 8 * hi + e];
            const int t = mq & 4095;
#pragma unroll
            for (int s = 0; s < 2; ++s) {
                const float2* rt = (const float2*)(p.ws + WS_ROPE16) + (s ? (t & 63) : (t >> 6)) * 16 + 8 * hi;
#pragma unroll
                for (int e = 0; e < 8; ++e) { const float2 v = rt[e]; const float a1 = qx[s][e], a2 = qx[s + 2][e]; qx[s][e] = a1 * v.x - a2 * v.y; qx[s + 2][e] = a2 * v.x + a1 * v.y; }
            }
        }
#pragma unroll
        for (int s = 0; s < NS; ++s) {
#pragma unroll
            for (int e = 0; e < 8; ++e) qx[s][e] *= sl2;
            qf[s] = __builtin_bit_cast(bf16x8, pack8(qx[s]));
        }
    }
    if (MODE == 2) { load_tile(0); t0a = rk0; t0b = rk1; t0c = rv; load_tile(1); t1a = rk0; t1b = rk1; t1c = rv; }
    __syncthreads();
    rk0 = t0a; rk1 = t0b; rv = t0c; write_tile(0);
    rk0 = t1a; rk1 = t1b; rv = t1c; write_tile(1);
    __syncthreads();
    f32x16 sA0, sA1, sB0, sB1;
    bf16x8 pA[4], pB[4];
    qk_tile(0, sA0, sA1);
    step(true, 0, sA0, sA1, sB0, sB1, pB, pA);
    int t = 1;
    for (; t + 1 < NT; t += 2) {
        step(false, t, sB0, sB1, sA0, sA1, pA, pB);
        step(false, t + 1, sA0, sA1, sB0, sB1, pB, pA);
    }
    if (t < NT) { step(false, t, sB0, sB1, sA0, sA1, pA, pB); pv_tile((NT - 1) & 3, pB); }
    else pv_tile((NT - 1) & 3, pA);
    const float il = 1.f / ol[0];
    bf16* Ob = (bf16*)(p.ws + WS_U) + (size_t)(mq - r32) * DM + 512 + h * 64;
    unsigned char* stg = lds + 4 * BUF + wid * (32 * 144);
#pragma unroll
    for (int g = 0; g < 4; ++g) {
        u32x2 w0, w1;
        w0.x = pk2(o0[4 * g] * il, o0[4 * g + 1] * il); w0.y = pk2(o0[4 * g + 2] * il, o0[4 * g + 3] * il);
        w1.x = pk2(o1[4 * g] * il, o1[4 * g + 1] * il); w1.y = pk2(o1[4 * g + 2] * il, o1[4 * g + 3] * il);
        *(u32x2*)(stg + r32 * 144 + (8 * g + 4 * hi) * 2) = w0;
        *(u32x2*)(stg + r32 * 144 + (32 + 8 * g + 4 * hi) * 2) = w1;
    }
    asm volatile("s_waitcnt lgkmcnt(0)" ::: "memory");
#pragma unroll
    for (int i = 0; i < 4; ++i) {
        const int row = 8 * i + (lane >> 3), ch = lane & 7;
        const u32x4 v = *(const u32x4*)(stg + row * 144 + ch * 16);
        *(u32x4*)(Ob + (size_t)row * DM + ch * 8) = v;
    }
    __syncthreads();
}

DI void na_unit(const KParams& p, int b, int h, int qb, unsigned char* lds) {
    constexpr int KP = 144, VP = 144, KBUF = 64 * KP, BUF = 2 * KBUF;
    const int tid = tid_fresh(), lane = tid & 63, wid = tid >> 6, r32 = lane & 31, hi = lane >> 5;
    float* rpbL = (float*)(lds + 2 * BUF + 256);
    const int ra = 4 * qb + 2 * (wid >> 2), c0 = 16 * (wid & 3);
    const int qrow = ra + (r32 >> 4), qcol = c0 + (r32 & 15);
    const int mq = b * 4096 + qrow * 64 + qcol;
    const bf16* Z = (const bf16*)(p.ws + WS_Z);
    bf16x8 qf[4];
    {
        const bf16* Qp = Z + (size_t)mq * NZ1 + Z1_NAQ + h * 64;
#pragma unroll
        for (int s = 0; s < 4; ++s) {
            float qx[8]; unpack8(*(const u32x4*)(Qp + 16 * s + 8 * hi), qx);
#pragma unroll
            for (int e = 0; e < 8; ++e) qx[e] *= 0.125f * LOG2E;
            qf[s] = __builtin_bit_cast(bf16x8, pack8(qx));
        }
    }
    int rs_l = qrow - 4; rs_l = rs_l < 0 ? 0 : (rs_l > 56 ? 56 : rs_l);
    int cs_l = qcol - 8; cs_l = cs_l < 0 ? 0 : (cs_l > 48 ? 48 : cs_l);
    int start = c0 - 8; start = start < 0 ? 0 : start; start = start > 32 ? 32 : start;
    int wlo = ra - 4; wlo = wlo < 0 ? 0 : (wlo > 56 ? 56 : wlo);
    int whi = ra + 1 - 4; whi = whi < 0 ? 0 : (whi > 56 ? 56 : whi); whi += 7;
    int kr_lo = 4 * qb - 4; if (kr_lo < 0) kr_lo = 0;
    int last = 4 * qb - 1; if (last < 0) last = 0; if (last > 56) last = 56;
    const int NT = 4 + (last + 7 - kr_lo + 1);
    unsigned cmask = 0u;
#pragma unroll
    for (int r = 0; r < 16; ++r) { const int kc = start + crow(r, hi); if (kc >= cs_l && kc <= cs_l + 15) cmask |= 1u << r; }
    const float* rpbB = rpbL + (start + 4 * hi - qcol + 15);
    for (int i = tid; i < 15 * 31; i += NTHREADS) rpbL[i] = p.in[25][h * 465 + i] * LOG2E;
    const int skey = tid >> 3, spart = tid & 7;
    auto keyrow = [&](int t) -> int { return t < 4 ? ML + b * 256 + 64 * t + skey : b * 4096 + (kr_lo + t - 4) * 64 + skey; };
    u32x4 rk, rv;
    auto load_tile = [&](int t) { const bf16* src = Z + (size_t)keyrow(t) * NZ1 + h * 64 + 8 * spart; rk = *(const u32x4*)(src + Z1_NAK); rv = *(const u32x4*)(src + Z1_NAV); };
    auto write_tile = [&](int buf) { *(u32x4*)(lds + buf * BUF + skey * KP + spart * 16) = rk; *(u32x4*)(lds + buf * BUF + KBUF + skey * VP + spart * 16) = rv; };
    const int vtr_base = (4 * hi + ((lane & 15) >> 2)) * VP + (16 * ((lane >> 4) & 1) + 4 * (lane & 3)) * 2;
    f32x16 o0, o1, ol, negm;
#pragma unroll
    for (int r = 0; r < 16; ++r) { o0[r] = 0.f; o1[r] = 0.f; ol[r] = 0.f; negm[r] = 0.f; }
    asm volatile("" : "+v"(negm));
    const bf16x8 ones = {(short)0x3F80, (short)0x3F80, (short)0x3F80, (short)0x3F80, (short)0x3F80, (short)0x3F80, (short)0x3F80, (short)0x3F80};
    float m_run = 0.f;
    auto span = [&](const unsigned char* kb, const unsigned char* vb, int koff, bool first, bool local, int kr) __attribute__((always_inline)) {
        f32x16 sc;
#pragma unroll
        for (int s = 0; s < 4; ++s) {
            const bf16x8 kf = *(const bf16x8*)(kb + (koff + r32) * KP + (16 * s + 8 * hi) * 2);
            sc = __builtin_amdgcn_mfma_f32_32x32x16_bf16(kf, qf[s], s == 0 ? negm : sc, 0, 0, 0);
        }
        if (local) {
            const bool rowok = (kr >= rs_l) && (kr <= rs_l + 7);
            const float* bp = rpbB + (kr - qrow + 7) * 31;
#pragma unroll
            for (int r = 0; r < 16; ++r) { const float bv = bp[(r & 3) + 8 * (r >> 2)]; sc[r] = (rowok && ((cmask >> r) & 1u)) ? sc[r] + bv : -INFINITY; }
        }
        float mloc;
        {
            float a = fmax3(sc[0], sc[1], sc[2]), c2 = fmax3(sc[3], sc[4], sc[5]);
            a = fmax3(a, sc[6], sc[7]); c2 = fmax3(c2, sc[8], sc[9]); a = fmax3(a, sc[10], sc[11]); c2 = fmax3(c2, sc[12], sc[13]); a = fmax3(a, sc[14], sc[15]);
            mloc = __builtin_fmaxf(a, c2);
            auto rr = __builtin_amdgcn_permlane32_swap(__float_as_uint(mloc), __float_as_uint(mloc), false, false);
            mloc = __builtin_fmaxf(__uint_as_float(rr[0]), __uint_as_float(rr[1]));
        }
        if (first || __builtin_expect(__any(mloc > ATT_THR), 0)) {
            float dl = first ? mloc : __builtin_fmaxf(mloc, 0.f);
            asm volatile("" : "+v"(dl));
            m_run += dl;
#pragma unroll
            for (int r = 0; r < 16; ++r) { sc[r] -= dl; negm[r] = -m_run; }
            asm volatile("" : "+v"(negm));
            if (!first) {
                const float alpha = __builtin_amdgcn_exp2f(-dl);
#pragma unroll
                for (int r = 0; r < 16; ++r) { o0[r] *= alpha; o1[r] *= alpha; ol[r] *= alpha; }
            }
        }
#pragma unroll
        for (int r = 0; r < 16; ++r) sc[r] = __builtin_amdgcn_exp2f(sc[r]);
#pragma unroll
        for (int s = 0; s < 2; ++s) {
            u32x4 pw;
            pw.x = pk2(sc[8 * s + 0], sc[8 * s + 1]); pw.y = pk2(sc[8 * s + 2], sc[8 * s + 3]);
            pw.z = pk2(sc[8 * s + 4], sc[8 * s + 5]); pw.w = pk2(sc[8 * s + 6], sc[8 * s + 7]);
            const bf16x8 pf = __builtin_bit_cast(bf16x8, pw);
            const unsigned char* vp = vb + vtr_base + (koff + 16 * s) * VP;
            const s16x4 a0 = lds_tr16(vp), a1 = lds_tr16(vp + 8 * VP), e0 = lds_tr16(vp + 64), e1 = lds_tr16(vp + 8 * VP + 64);
            const bf16x8 va = {a0[0], a0[1], a0[2], a0[3], a1[0], a1[1], a1[2], a1[3]};
            const bf16x8 vc = {e0[0], e0[1], e0[2], e0[3], e1[0], e1[1], e1[2], e1[3]};
            o0 = __builtin_amdgcn_mfma_f32_32x32x16_bf16(va, pf, o0, 0, 0, 0);
            o1 = __builtin_amdgcn_mfma_f32_32x32x16_bf16(vc, pf, o1, 0, 0, 0);
            ol = __builtin_amdgcn_mfma_f32_32x32x16_bf16(ones, pf, ol, 0, 0, 0);
        }
    };
    __syncthreads();
    load_tile(0); write_tile(0);
    __syncthreads();
    for (int t = 0; t < NT; ++t) {
        const int buf = t & 1;
        if (t + 1 < NT) load_tile(t + 1);
        const unsigned char* kb = lds + buf * BUF; const unsigned char* vb = kb + KBUF;
        if (t < 4) { span(kb, vb, 0, t == 0, false, 0); span(kb, vb, 32, false, false, 0); }
        else { const int kr = kr_lo + t - 4; if (kr >= wlo && kr <= whi) span(kb, vb, start, false, true, kr); }
        if (t + 1 < NT) write_tile(buf ^ 1);
        __syncthreads();
    }
    const float il = 1.f / ol[0];
    unsigned char* stg = lds + 2 * BUF + 4096 + wid * (32 * 144);
#pragma unroll
    for (int g = 0; g < 4; ++g) {
        u32x2 w0, w1;
        w0.x = pk2(o0[4 * g] * il, o0[4 * g + 1] * il); w0.y = pk2(o0[4 * g + 2] * il, o0[4 * g + 3] * il);
        w1.x = pk2(o1[4 * g] * il, o1[4 * g + 1] * il); w1.y = pk2(o1[4 * g + 2] * il, o1[4 * g + 3] * il);
        *(u32x2*)(stg + r32 * 144 + (8 * g + 4 * hi) * 2) = w0;
        *(u32x2*)(stg + r32 * 144 + (32 + 8 * g + 4 * hi) * 2) = w1;
    }
    asm volatile("s_waitcnt lgkmcnt(0)" ::: "memory");
#pragma unroll
    for (int i = 0; i < 4; ++i) {
        const int row = 8 * i + (lane >> 3), ch = lane & 7;
        const u32x4 v = *(const u32x4*)(stg + row * 144 + ch * 16);
        const int mrow = b * 4096 + (ra + (row >> 4)) * 64 + c0 + (row & 15);
        *(u32x4*)((bf16*)(p.ws + WS_U) + (size_t)mrow * DM + h * 64 + ch * 8) = v;
    }
}

DI void phase_attn1(const KParams& p, unsigned char* lds) {
    const int G = gridDim.x; const int vcu = (G % 8 == 0) ? (blockIdx.x % 8) * (G / 8) + blockIdx.x / 8 : blockIdx.x;
#ifndef NO_GQA
    for (int u = vcu; u < 1024; u += G) { const int bh = u >> 4, j = u & 15; ATTN_FN<2>(p, bh >> 3, bh & 7, j, lds); }
#endif
#if defined(NO_NA)
#elif defined(NA_OLD)
    for (int u = vcu; u < 1024; u += G) { const int bh = u >> 4, j = u & 15; attn_unit<3>(p, bh >> 3, bh & 7, j, lds); }
#else
    for (int u = vcu; u < 1024; u += G) { const int bh = u >> 4, j = u & 15; na_unit(p, bh >> 3, bh & 7, j, lds); }
#endif
#ifdef NA_PROBE
    for (int u = vcu; u < 1024; u += G) { const int bh = u >> 4, j = u & 15; na_unit(p, bh >> 3, bh & 7, j, lds); }
#endif
}

#ifndef PHMASK
#define PHMASK 0xffffffffu
#endif
typedef const __attribute__((address_space(4))) KParams* KArgPtr;
DI KParams load_params(KArgPtr kp) {
    KParams p;
#pragma unroll
    for (int i = 0; i < 28; ++i) p.in[i] = kp->in[i];
    p.out = kp->out; p.ws = kp->ws; return p;
}
__global__ void __launch_bounds__(NTHREADS, 2) fwd_megakernel(KParams p_unused) {
    extern __shared__ __attribute__((aligned(16))) unsigned char lds[];
    cg::grid_group grid = cg::this_grid();
    KArgPtr kp0 = (KArgPtr)__builtin_amdgcn_kernarg_segment_ptr();
    volatile LAS unsigned* bst = (volatile LAS unsigned*)((LAS unsigned char*)lds + (LDS_BYTES - 64));
    if (threadIdx.x == 0) { bst[0] = 0u; bst[1] = 0u; }
    __syncthreads();
    const XcdBarrier bar = xcd_barrier_post((unsigned*)(kp0->ws + WS_CTL), bst);
#ifdef USE_CG_SYNC
#define SYNC() grid.sync()
#else
#define SYNC() xcd_barrier(bar)
#endif
    constexpr int NSUB = 32;
#define PH1(n, ...) { KArgPtr kp = kp0; asm volatile("" : "+s"(kp)); const KParams p = load_params(kp); unsigned char* ws = p.ws; \
        bf16* U = (bf16*)(ws + WS_U); bf16* Zb = (bf16*)(ws + WS_Z); bf16* Yb = (bf16*)(ws + WS_Y); (void)U; (void)Zb; (void)Yb; __VA_ARGS__; }
#ifndef PHREP
#define PHREP 0u
#endif
#define PH(n, ...) if ((PHMASK >> (n)) & 1u) { PH1(n, __VA_ARGS__) if ((PHREP >> (n)) & 1u) { SYNC(); PH1(n, __VA_ARGS__) } }

    PH(0, phase_prologue(p, lds))
    if (__builtin_expect(gridDim.x > 65535u, 0)) grid.sync();
    SYNC();
    PH(1, phase_modnorm0(p))
    SYNC();
#ifdef ALL_W_EARLY
    PH(2, gemm_store(lds, U, (const bf16*)(ws + WS_WIN0), MT, NZ0, DM, Zb, NZ0))
#else
    PH(2, { gemm_store(lds, U, (const bf16*)(ws + WS_WIN0), MT, NZ0, DM, Zb, NZ0); tail_weight_transposes<TD_LATE>(p, lds, (MT / 256) * (NZ0 / 256)); })
#endif
    SYNC();
    PH(3, phase_prep0(p))
    SYNC();
    PH(4, gemm_store(lds, (const bf16*)(ws + WS_QN), (const bf16*)(ws + WS_WQUP), MT, 768, 256, (bf16*)(ws + WS_QMLA), 768))
    PH(5, gemm_store_rot(lds, (const bf16*)(ws + WS_KVN), (const bf16*)(ws + WS_WKVUP), MT, 1024, 128, (bf16*)(ws + WS_KVMLA), 1024, (MT / 256) * 3))
    { asm volatile("s_waitcnt vmcnt(0) lgkmcnt(0)" ::: "memory"); __syncthreads(); }
    PH(7, phase_tinv(p, lds))
    SYNC();
#ifdef TINV_PROBE
    PH(7, phase_tinv(p, lds, true))
    SYNC();
#endif
    PH(6, phase_scan_attn0(p, lds))
    SYNC();
#ifdef COMBINE_PHASE
    PH(9, phase_gdn_combine(p))
    SYNC();
#endif
    PH(10, gemm_store(lds, U, (const bf16*)(ws + WS_WOUT0), ML, DM, DM, Yb, DM))
    SYNC();
    PH(11, { if (blockIdx.x < NSUB) { gemm_store_sub(lds, U + (size_t)ML * DM, (const bf16*)(ws + WS_WOUT0), MC, DM, DM, Yb + (size_t)ML * DM, DM, 0, NSUB);
                                      sub_barrier((unsigned*)(ws + WS_SUBCNT), NSUB);
                                      phase_post(p, ML, MT, Yb, 1, 0, 2, p.in[7], p.in[8], 0, 3, U, 0, NSUB); }
             else phase_post(p, 0, ML, Yb, 1, 0, 2, p.in[7], p.in[8], 0, 3, U, NSUB, (int)gridDim.x - NSUB); })
    SYNC();
#ifdef ALL_W_EARLY
    PH(12, gemm_swiglu(lds, U, (const bf16*)(ws + WS_WGU0), MT, Zb))
#else
    PH(12, gemm_swiglu(lds, U, (const bf16*)(ws + WS_WGU0), MT, Zb))
#endif
    SYNC();
    PH(13, gemm_store(lds, Zb, (const bf16*)(ws + WS_WDN0), ML, DM, DFF, Yb, DM))
    SYNC();
    PH(14, { constexpr int NS2 = 2 * NSUB;
             if (blockIdx.x < NS2) { const int sl = (int)blockIdx.x / NSUB;
                                     bf16* Y2c = (bf16*)(ws + WS_Y2C);
                                     gemm_store_sub_kslice(lds, Zb + (size_t)ML * DFF, (const bf16*)(ws + WS_WDN0), MC, DM, DFF, sl * (DFF / 2), DFF / 2,
                                                           sl ? Y2c : Yb + (size_t)ML * DM, DM, sl * NSUB, NSUB);
                                     sub_barrier((unsigned*)(ws + WS_SUBCNT) + 64, NS2);
                                     phase_post(p, ML, MT, Yb, 0, 0, 5, p.in[9], p.in[6] + 1024, 1, 0, U, 0, NS2, Y2c - (size_t)ML * DM); }
             else phase_post(p, 0, ML, Yb, 0, 0, 5, p.in[9], p.in[6] + 1024, 1, 0, U, NS2, (int)gridDim.x - NS2); })
    SYNC();
#ifdef ALL_W_EARLY
    PH(15, gemm_store(lds, U, (const bf16*)(ws + WS_WIN1), MT, NZ1, DM, Zb, NZ1))
#else
    PH(15, gemm_store(lds, U, (const bf16*)(ws + WS_WIN1), MT, NZ1, DM, Zb, NZ1))
#endif
    SYNC();
    PH(16, phase_prep1(p))
    SYNC();
    PH(17, phase_attn1(p, lds))
    SYNC();
    PH(18, gemm_store(lds, U, (const bf16*)(ws + WS_WOUT1), ML, DM, DM, Yb, DM))
    SYNC();
    PH(19, phase_post(p, 0, ML, Yb, 0, 1, 2, p.in[7] + 1024, p.in[8] + 1024, 1, 3, U, 0, (int)gridDim.x))
    SYNC();
    PH(20, gemm_swiglu(lds, U, (const bf16*)(ws + WS_WGU1), ML, Zb))
    SYNC();
    PH(21, gemm_store(lds, Zb, (const bf16*)(ws + WS_WDN1), ML, DM, DFF, Yb, DM))
    SYNC();
    PH(22, phase_post(p, 0, ML, Yb, 0, 1, 5, p.in[9] + 1024, nullptr, 1, 0, nullptr, 0, (int)gridDim.x))
#undef SYNC
#undef PH
#undef PH1
}

extern "C" void kernel_launch(void* const* d_in, const int* in_sizes, int n_in, void* d_out, int out_size,
                              void* d_ws, size_t ws_size, hipStream_t stream) {
    static int grid_blocks = 0;
    if (grid_blocks == 0) {
        int dev = 0, cus = 0, per_cu = 0;
        (void)hipGetDevice(&dev);
        (void)hipDeviceGetAttribute(&cus, hipDeviceAttributeMultiprocessorCount, dev);
        (void)hipFuncSetAttribute((const void*)fwd_megakernel, hipFuncAttributeMaxDynamicSharedMemorySize, LDS_BYTES);
        (void)hipOccupancyMaxActiveBlocksPerMultiprocessor(&per_cu, (const void*)fwd_megakernel, NTHREADS, LDS_BYTES);
        if (per_cu < 1) { fprintf(stderr, "kernel_launch: occupancy query says %d blocks/CU\n", per_cu); per_cu = 1; }
        grid_blocks = cus;
        if (n_in != 28 || ws_size < WS_END) fprintf(stderr, "kernel_launch: unexpected n_in %d / ws_size %zu (need %zu)\n", n_in, ws_size, (size_t)WS_END);
    }
    (void)hipMemsetAsync((unsigned char*)d_ws + WS_CTL, 0, 16384 + 1024, stream);
    KParams p{};
    for (int i = 0; i < 28; ++i) p.in[i] = (const float*)d_in[i];
    p.out = (float*)d_out; p.ws = (unsigned char*)d_ws;
    void* args[] = {&p};
    hipError_t e = hipLaunchCooperativeKernel((void*)fwd_megakernel, dim3(grid_blocks), dim3(NTHREADS), args, LDS_BYTES, stream);
    if (e != hipSuccess) fprintf(stderr, "cooperative launch failed: %s (grid %d)\n", hipGetErrorString(e), grid_blocks);
}
```
